# Optimizing an MI355X kernel written in HIP

```python
import math
import jax
import jax.numpy as jnp
from jax import lax
import numpy as np

D_MODEL = 1024
BATCH = 32
SEQ = 2048
DEPTH = 4

GRID_W = 64
CTX_LEN = 256

N_MIXERS = 3
N_A_LAYERS = (DEPTH + 2) // N_MIXERS
N_B_LAYERS = (DEPTH + 1) // N_MIXERS
N_C_LAYERS = DEPTH // N_MIXERS

BLOCK = 128
WINDOW = 128
BAND = BLOCK + 2 * WINDOW

A_HEAD_DIM = 64
A_HEADS = D_MODEL // A_HEAD_DIM
A_KV_HEADS = A_HEADS // 4
A_GROUP = A_HEADS // A_KV_HEADS
A_Q_DIM = A_HEADS * A_HEAD_DIM
A_KV_DIM = A_KV_HEADS * A_HEAD_DIM
A_QKV_DIM = A_Q_DIM + 2 * A_KV_DIM

CHUNK = 128
B_WIDTH = D_MODEL
B_GROUPS = 8
B_GROUP_W = B_WIDTH // B_GROUPS

C_HEAD_DIM = 128
C_HEADS = D_MODEL // C_HEAD_DIM
C_KV_HEADS = C_HEADS // 2
C_GROUP = C_HEADS // C_KV_HEADS
C_Q_DIM = C_HEADS * C_HEAD_DIM
C_KV_DIM = C_KV_HEADS * C_HEAD_DIM
C_QKV_DIM = C_Q_DIM + 2 * C_KV_DIM

FFN_HIDDEN = int(math.ceil(8 * D_MODEL / 3 / 256)) * 256

ROPE_THETA = 10000.0
RMS_EPS = 1e-6
LN_EPS = 1e-5
NEG_INF = -1e30

kernel_name = 'hybrid_interleaved_dit_prefix_ctx'


def rmsnorm(x, g):
    xf = x.astype(jnp.float32)
    y = xf * lax.rsqrt(jnp.mean(xf * xf, axis=-1, keepdims=True) + RMS_EPS)
    return (y * g.astype(jnp.float32)).astype(x.dtype)


def layernorm(x, g, b):
    xf = x.astype(jnp.float32)
    mu = jnp.mean(xf, axis=-1, keepdims=True)
    var = jnp.mean(jnp.square(xf - mu), axis=-1, keepdims=True)
    y = (xf - mu) * lax.rsqrt(var + LN_EPS)
    return (y * g.astype(jnp.float32) + b.astype(jnp.float32)).astype(x.dtype)


def modulate(h, shift, scale):
    return h * (1 + scale) + shift


def axial_rope_tables(n_tokens, head_dim):
    rows = n_tokens // GRID_W
    row_pos = jnp.repeat(jnp.arange(rows, dtype=jnp.float32), GRID_W)
    col_pos = jnp.tile(jnp.arange(GRID_W, dtype=jnp.float32), rows)
    n_freq = head_dim // 4
    inv_freq = ROPE_THETA ** (-jnp.arange(n_freq, dtype=jnp.float32) / n_freq)
    angles = jnp.concatenate([row_pos[:, None] * inv_freq, col_pos[:, None] * inv_freq], axis=-1)
    return jnp.cos(angles), jnp.sin(angles)


def apply_rope(x, cos, sin):
    xf = x.astype(jnp.float32)
    x1, x2 = jnp.split(xf, 2, axis=-1)
    c = cos[None, :, None, :]
    s = sin[None, :, None, :]
    return jnp.concatenate([x1 * c - x2 * s, x2 * c + x1 * s], axis=-1).astype(x.dtype)


def joint_softmax_attend(logit_parts, value_parts, sink=None):
    sizes = [p.shape[-1] for p in logit_parts]
    logits = jnp.concatenate([p.astype(jnp.float32) for p in logit_parts], axis=-1)
    if sink is not None:
        sink_col = jnp.broadcast_to(sink.astype(jnp.float32)[None, :, :, None, None], logits.shape[:-1] + (1,))
        logits = jnp.concatenate([logits, sink_col], axis=-1)
    probs = jax.nn.softmax(logits, axis=-1)
    out = None
    offset = 0
    for size, v in zip(sizes, value_parts):
        p = probs[..., offset:offset + size].astype(v.dtype)
        term = jnp.einsum('bhgqk,bkhd->bqhgd', p, v)
        out = term if out is None else out + term
        offset += size
    return out


def window_sink_mixer(h_lat, h_ctx, w_qkv, w_o, sink, cos, sin, ctx_out):
    bsz, n, _ = h_lat.shape
    n_ctx = h_ctx.shape[1]
    nb = n // BLOCK
    scale = A_HEAD_DIM ** -0.5
    q, k, v = jnp.split(h_lat @ w_qkv, [A_Q_DIM, A_Q_DIM + A_KV_DIM], axis=-1)
    q = apply_rope(q.reshape(bsz, n, A_HEADS, A_HEAD_DIM), cos, sin) * scale
    k = apply_rope(k.reshape(bsz, n, A_KV_HEADS, A_HEAD_DIM), cos, sin)
    v = v.reshape(bsz, n, A_KV_HEADS, A_HEAD_DIM)
    k_c, v_c = jnp.split(h_ctx @ w_qkv[:, A_Q_DIM:], 2, axis=-1)
    k_c = k_c.reshape(bsz, n_ctx, A_KV_HEADS, A_HEAD_DIM)
    v_c = v_c.reshape(bsz, n_ctx, A_KV_HEADS, A_HEAD_DIM)
    sink_g = sink.reshape(A_KV_HEADS, A_GROUP)

    qb = jnp.moveaxis(q.reshape(bsz, nb, BLOCK, A_KV_HEADS, A_GROUP, A_HEAD_DIM), 1, 0)
    pad = ((0, 0), (WINDOW, WINDOW), (0, 0), (0, 0))
    kp = jnp.pad(k, pad)
    vp = jnp.pad(v, pad)

    def attend_block(args):
        q_blk, blk = args
        start = blk * BLOCK
        k_band = lax.dynamic_slice_in_dim(kp, start, BAND, axis=1)
        v_band = lax.dynamic_slice_in_dim(vp, start, BAND, axis=1)
        qpos = start + jnp.arange(BLOCK)
        kpos = start - WINDOW + jnp.arange(BAND)
        mask = (jnp.abs(qpos[:, None] - kpos[None, :]) <= WINDOW) & (kpos[None, :] >= 0) & (kpos[None, :] < n)
        s_band = jnp.einsum('bqhgd,bkhd->bhgqk', q_blk, k_band).astype(jnp.float32)
        s_band = jnp.where(mask, s_band, NEG_INF)
        s_ctx = jnp.einsum('bqhgd,bkhd->bhgqk', q_blk, k_c)
        return joint_softmax_attend([s_band, s_ctx], [v_band, v_c], sink_g)

    o = lax.map(attend_block, (qb, jnp.arange(nb)))
    y_lat = jnp.moveaxis(o, 0, 1).reshape(bsz, n, A_Q_DIM) @ w_o
    y_ctx = None
    if ctx_out:
        q_c = (h_ctx @ w_qkv[:, :A_Q_DIM]).reshape(bsz, n_ctx, A_KV_HEADS, A_GROUP, A_HEAD_DIM) * scale
        s_cc = jnp.einsum('bqhgd,bkhd->bhgqk', q_c, k_c)
        y_ctx = joint_softmax_attend([s_cc], [v_c], sink_g).reshape(bsz, n_ctx, A_Q_DIM) @ w_o
    return y_lat, y_ctx


def chunk_gmlp(h, w_in, b_in, ln_g, ln_b, w_s, b_s, w_o):
    bsz, n, _ = h.shape
    z = jax.nn.gelu(h @ w_in + b_in, approximate=False)
    u, v = jnp.split(z, 2, axis=-1)
    v = layernorm(v, ln_g, ln_b).reshape(bsz, n // CHUNK, CHUNK, B_GROUPS, B_GROUP_W)
    mixed = jnp.einsum('gpq,bnqgc->bnpgc', w_s, v) + b_s.T[None, None, :, :, None]
    return (u * mixed.reshape(bsz, n, B_WIDTH)) @ w_o


def chunk_gmlp_mixer(h_lat, h_ctx, w_in, b_in, ln_g, ln_b, w_s, b_s, w_o, ctx_out):
    y_lat = chunk_gmlp(h_lat, w_in, b_in, ln_g, ln_b, w_s, b_s, w_o)
    y_ctx = chunk_gmlp(h_ctx, w_in, b_in, ln_g, ln_b, w_s, b_s, w_o) if ctx_out else None
    return y_lat, y_ctx


def global_qknorm_mixer(h_lat, h_ctx, w_qkv, w_o, q_g, k_g, cos, sin, ctx_out):
    bsz, n, _ = h_lat.shape
    n_ctx = h_ctx.shape[1]
    nb = n // BLOCK
    scale = C_HEAD_DIM ** -0.5
    q, k, v = jnp.split(h_lat @ w_qkv, [C_Q_DIM, C_Q_DIM + C_KV_DIM], axis=-1)
    q = apply_rope(rmsnorm(q.reshape(bsz, n, C_HEADS, C_HEAD_DIM), q_g), cos, sin) * scale
    k = apply_rope(rmsnorm(k.reshape(bsz, n, C_KV_HEADS, C_HEAD_DIM), k_g), cos, sin)
    v = v.reshape(bsz, n, C_KV_HEADS, C_HEAD_DIM)
    k_c, v_c = jnp.split(h_ctx @ w_qkv[:, C_Q_DIM:], 2, axis=-1)
    k_c = rmsnorm(k_c.reshape(bsz, n_ctx, C_KV_HEADS, C_HEAD_DIM), k_g)
    v_c = v_c.reshape(bsz, n_ctx, C_KV_HEADS, C_HEAD_DIM)

    qb = jnp.moveaxis(q.reshape(bsz, nb, BLOCK, C_KV_HEADS, C_GROUP, C_HEAD_DIM), 1, 0)

    def attend_block(q_blk):
        s_lat = jnp.einsum('bqhgd,bkhd->bhgqk', q_blk, k)
        s_ctx = jnp.einsum('bqhgd,bkhd->bhgqk', q_blk, k_c)
        return joint_softmax_attend([s_lat, s_ctx], [v, v_c])

    o = lax.map(attend_block, qb)
    y_lat = jnp.moveaxis(o, 0, 1).reshape(bsz, n, C_Q_DIM) @ w_o
    y_ctx = None
    if ctx_out:
        q_c = rmsnorm((h_ctx @ w_qkv[:, :C_Q_DIM]).reshape(bsz, n_ctx, C_HEADS, C_HEAD_DIM), q_g) * scale
        q_c = q_c.reshape(bsz, n_ctx, C_KV_HEADS, C_GROUP, C_HEAD_DIM)
        s_cc = jnp.einsum('bqhgd,bkhd->bhgqk', q_c, k_c)
        y_ctx = joint_softmax_attend([s_cc], [v_c]).reshape(bsz, n_ctx, C_Q_DIM) @ w_o
    return y_lat, y_ctx


def swiglu(h, w_in, w_out):
    gate, up = jnp.split(h @ w_in, 2, axis=-1)
    return (jax.nn.silu(gate) * up) @ w_out


def setup_inputs(seed: int = 0) -> dict:
    key = jax.random.key(seed)
    ks = jax.random.split(key, 24)

    def nrm(k, shape, scale):
        return jax.random.normal(k, shape, jnp.float32) * scale

    d = D_MODEL
    return {
        'x': nrm(ks[0], (BATCH, SEQ, d), 1.0),
        'c': nrm(ks[1], (BATCH, d), 1.0),
        'ctx': nrm(ks[2], (BATCH, CTX_LEN, d), 1.0),
        'c_ctx': nrm(ks[3], (d,), 1.0),
        'ada_w': nrm(ks[4], (DEPTH, d, 6 * d), 0.5 * d ** -0.5),
        'ada_b': nrm(ks[5], (DEPTH, 6 * d), 0.01),
        'norm_g': 1.0 + nrm(ks[6], (DEPTH, 4, d), 0.01),
        'ffn_w_in': nrm(ks[7], (DEPTH, d, 2 * FFN_HIDDEN), d ** -0.5),
        'ffn_w_out': nrm(ks[8], (DEPTH, FFN_HIDDEN, d), FFN_HIDDEN ** -0.5),
        'a_w_qkv': nrm(ks[9], (N_A_LAYERS, d, A_QKV_DIM), d ** -0.5),
        'a_w_o': nrm(ks[10], (N_A_LAYERS, A_Q_DIM, d), A_Q_DIM ** -0.5),
        'a_sink': nrm(ks[11], (N_A_LAYERS, A_HEADS), 0.5),
        'b_w_in': nrm(ks[12], (N_B_LAYERS, d, 2 * B_WIDTH), d ** -0.5),
        'b_b_in': nrm(ks[13], (N_B_LAYERS, 2 * B_WIDTH), 0.01),
        'b_ln_g': 1.0 + nrm(ks[14], (N_B_LAYERS, B_WIDTH), 0.01),
        'b_ln_b': nrm(ks[15], (N_B_LAYERS, B_WIDTH), 0.01),
        'b_w_s': nrm(ks[16], (N_B_LAYERS, B_GROUPS, CHUNK, CHUNK), CHUNK ** -0.5),
        'b_b_s': 1.0 + nrm(ks[17], (N_B_LAYERS, B_GROUPS, CHUNK), 0.02),
        'b_w_o': nrm(ks[18], (N_B_LAYERS, B_WIDTH, d), B_WIDTH ** -0.5),
        'c_w_qkv': nrm(ks[19], (N_C_LAYERS, d, C_QKV_DIM), d ** -0.5),
        'c_w_o': nrm(ks[20], (N_C_LAYERS, C_Q_DIM, d), C_Q_DIM ** -0.5),
        'c_q_g': 1.0 + nrm(ks[21], (N_C_LAYERS, C_HEAD_DIM), 0.01),
        'c_k_g': 1.0 + nrm(ks[22], (N_C_LAYERS, C_HEAD_DIM), 0.01),
    }


def reference(x, c, ctx, c_ctx, ada_w, ada_b, norm_g, ffn_w_in, ffn_w_out,
              a_w_qkv, a_w_o, a_sink,
              b_w_in, b_b_in, b_ln_g, b_ln_b, b_w_s, b_b_s, b_w_o,
              c_w_qkv, c_w_o, c_q_g, c_k_g):
    n = x.shape[1]
    cos_a, sin_a = axial_rope_tables(n, A_HEAD_DIM)
    cos_c, sin_c = axial_rope_tables(n, C_HEAD_DIM)
    silu_c = jax.nn.silu(c)
    silu_cc = jax.nn.silu(c_ctx)
    ctx_s = ctx
    for i in range(DEPTH):
        ctx_out = i < DEPTH - 1
        kind = i % N_MIXERS
        j = i // N_MIXERS
        mod_l = silu_c @ ada_w[i] + ada_b[i]
        mod_c = silu_cc @ ada_w[i] + ada_b[i]
        sh_ml, sc_ml, g_ml, sh_fl, sc_fl, g_fl = [m[:, None, :] for m in jnp.split(mod_l, 6, axis=-1)]
        sh_mc, sc_mc, g_mc, sh_fc, sc_fc, g_fc = jnp.split(mod_c, 6, axis=-1)

        h_l = modulate(rmsnorm(x, norm_g[i, 0]), sh_ml, sc_ml)
        h_c = modulate(rmsnorm(ctx_s, norm_g[i, 0]), sh_mc, sc_mc) if (ctx_out or kind != 1) else None
        if kind == 0:
            y_l, y_c = window_sink_mixer(h_l, h_c, a_w_qkv[j], a_w_o[j], a_sink[j], cos_a, sin_a, ctx_out)
        elif kind == 1:
            y_l, y_c = chunk_gmlp_mixer(h_l, h_c, b_w_in[j], b_b_in[j], b_ln_g[j], b_ln_b[j],
                                        b_w_s[j], b_b_s[j], b_w_o[j], ctx_out)
        else:
            y_l, y_c = global_qknorm_mixer(h_l, h_c, c_w_qkv[j], c_w_o[j], c_q_g[j], c_k_g[j],
                                           cos_c, sin_c, ctx_out)

        x = x + g_ml * rmsnorm(y_l, norm_g[i, 1])
        f_l = swiglu(modulate(rmsnorm(x, norm_g[i, 2]), sh_fl, sc_fl), ffn_w_in[i], ffn_w_out[i])
        x = x + g_fl * rmsnorm(f_l, norm_g[i, 3])

        if ctx_out:
            ctx_s = ctx_s + g_mc * rmsnorm(y_c, norm_g[i, 1])
            f_c = swiglu(modulate(rmsnorm(ctx_s, norm_g[i, 2]), sh_fc, sc_fc), ffn_w_in[i], ffn_w_out[i])
            ctx_s = ctx_s + g_fc * rmsnorm(f_c, norm_g[i, 3])
    return x
```

```cpp
#include <hip/hip_runtime.h>
#include <hip/hip_cooperative_groups.h>
#include <cstdio>
#include <cstdint>
namespace cg = cooperative_groups;
namespace pg8 {
#define PG8_LAS __attribute__((address_space(3)))
typedef unsigned short bf16_t;
typedef short bf16x8 __attribute__((ext_vector_type(8)));
typedef float f32x4 __attribute__((ext_vector_type(4)));
typedef unsigned u32x4 __attribute__((ext_vector_type(4)));
constexpr int BM = 256, BK = 64, HALF = 128, HTB = HALF * BK * 2  , STAGE_BYTES = 8 * HTB, NXCD = 8, WGM = 8;

__host__ __device__ __forceinline__ int lds_byte(int r, int c) { const int st = (r >> 4) * 2 + (c >> 5), rr = r & 15, cc = c & 31, ob = rr * 64 + cc * 2; return st * 1024 + (ob ^ (((ob >> 9) & 1) << 5)); }
__host__ __device__ __forceinline__ void stage_rc(int b, int& R, int& C) { const int st = b / 1024, sb = b % 1024, swz = sb ^ (((sb >> 9) & 1) << 5); R = (st >> 1) * 16 + swz / 64; C = (st & 1) * 32 + (swz % 64) / 2; }
__host__ __device__ __forceinline__ int perm32(int rho) { const int n = rho >> 4, i = rho & 15; return 8 * (i >> 2) + 4 * n + (i & 3); }

struct Unit { int pm, pn; };
struct Gemm { const bf16_t* A; const bf16_t* Bt; int M, N, K; };

struct StaticOrder {
    int nM, nN, nwg, G, c;
    __host__ __device__ void init(int M, int N, int G_, int c_) { nM = M / BM; nN = N / BM; nwg = nM * nN; G = G_; c = c_; }
    __host__ __device__ bool next(int i, Unit& u) const {
        const long L = (long)i * G + c; if (L >= nwg) return false;
        int wgid = (int)L; { const int q = nwg / NXCD, r = nwg % NXCD, xcd = wgid % NXCD, off = wgid / NXCD; wgid = (xcd < r ? xcd * (q + 1) : r * (q + 1) + (xcd - r) * q) + off; }
        const int nig = WGM * nN, gid = wgid / nig, fm = gid * WGM, gsz = (nM - fm) < WGM ? (nM - fm) : WGM;
        u.pm = fm + ((wgid % nig) % gsz); u.pn = (wgid % nig) / gsz; return true;
    }
    __device__ __forceinline__ void a_ready(const Unit&) const {}
    __device__ __forceinline__ void done(const Unit&) const {}
};

__device__ __forceinline__ unsigned cvt_pk_bf16(float lo, float hi) { unsigned r; asm volatile("v_cvt_pk_bf16_f32 %0, %1, %2" : "=v"(r) : "v"(lo), "v"(hi)); return r; }
typedef float f32x2 __attribute__((ext_vector_type(2)));
__device__ __forceinline__ f32x2 gelu_pk(f32x2 v) {
    const f32x2 av = __builtin_elementwise_abs(v), d = av * 0.2316418882f + 1.0f;
    f32x2 t; t.x = __builtin_amdgcn_rcpf(d.x); t.y = __builtin_amdgcn_rcpf(d.y);
    f32x2 q = t * 0.5307027145f + (-0.7265760135f); q = q * t + 0.7107068705f; q = q * t + (-0.142248368f); q = q * t + 0.127414796f; q = q * t;
    const f32x2 s = (v * v) * (-0.72134752044f);
    f32x2 e; e.x = __builtin_amdgcn_exp2f(s.x); e.y = __builtin_amdgcn_exp2f(s.y);
    const f32x2 m = v * (q * e), r = v - m;
    f32x2 o; o.x = v.x < 0.f ? m.x : r.x; o.y = v.y < 0.f ? m.y : r.y; return o;
}

#ifndef PG8_STMODE
#define PG8_STMODE 0
#endif
#if PG8_STMODE == 1
#define PG8_ST16(p, v) asm volatile("global_store_dwordx4 %0, %1, off sc1\n\ts_nop 1" :: "v"(p), "v"(v) : "memory")
#elif PG8_STMODE == 2
#define PG8_ST16(p, v) asm volatile("global_store_dwordx4 %0, %1, off nt\n\ts_nop 1" :: "v"(p), "v"(v) : "memory")
#elif PG8_STMODE == 4
#define PG8_ST16(p, v) asm volatile("global_store_dwordx4 %0, %1, off\n\ts_nop 1" :: "v"(p), "v"(v) : "memory")
#elif PG8_STMODE == 3
#define PG8_ST16(p, v) asm volatile("global_store_dwordx4 %0, %1, off sc0 sc1\n\ts_nop 1" :: "v"(p), "v"(v) : "memory")
#else
#define PG8_ST16(p, v) (*(u32x4*)(p) = (v))
#endif
template <int ACT  > struct EpiBf16 {
    static constexpr bool PERM = true, AFTER_DRAIN = false; static_assert(ACT == 0 || ACT == 1, "EpiBf16: ACT is 0 (none) or 1 (gelu_pk)");
    bf16_t* O; int ldc; const float* bias; int split_cols; size_t split_stride; float scale0; int skip;
    __device__ __forceinline__ void operator()(const f32x4 (&acc)[2][2][4][2], const Unit& u, int wr, int wc, int fr, int fq) const {
        if (skip) return;
        const int row0 = u.pm * BM + wr * 64 + fr; int colt = u.pn * BM; bf16_t* base = O;
        float sc = 1.f; if (split_cols) { const int t = colt / split_cols; base += (size_t)t * split_stride; colt -= t * split_cols; if (t == 0) sc = scale0; }
        const int col0 = colt + wc * 32 + 8 * fq, bcol0 = u.pn * BM + wc * 32 + 8 * fq;
        f32x4 bv[2][2];
#pragma unroll
        for (int bj = 0; bj < 2; ++bj)
#pragma unroll
            for (int n = 0; n < 2; ++n) bv[bj][n] = bias ? *(const f32x4*)(bias + bcol0 + bj * HALF + 4 * n) : (f32x4){0.f, 0.f, 0.f, 0.f};
#pragma unroll
        for (int ai = 0; ai < 2; ++ai)
#pragma unroll
            for (int m = 0; m < 4; ++m) { bf16_t* rowp = base + (size_t)(row0 + ai * HALF + m * 16) * ldc + col0;
#pragma unroll
                for (int bj = 0; bj < 2; ++bj) { f32x4 v0 = acc[ai][bj][m][0] + bv[bj][0], v1 = acc[ai][bj][m][1] + bv[bj][1];
                    if (ACT == 1) { f32x2 a = gelu_pk((f32x2){v0[0], v0[1]}), b = gelu_pk((f32x2){v0[2], v0[3]}), c = gelu_pk((f32x2){v1[0], v1[1]}), d = gelu_pk((f32x2){v1[2], v1[3]});
                        v0 = (f32x4){a.x, a.y, b.x, b.y}; v1 = (f32x4){c.x, c.y, d.x, d.y}; }
                    v0 = v0 * sc; v1 = v1 * sc; u32x4 w; w.x = cvt_pk_bf16(v0[0], v0[1]); w.y = cvt_pk_bf16(v0[2], v0[3]); w.z = cvt_pk_bf16(v1[0], v1[1]); w.w = cvt_pk_bf16(v1[2], v1[3]);
                    PG8_ST16(rowp + bj * HALF, w); } }
    }
};
template <class Epi, class Sched, bool ALIGN_EPI = false, bool SP2 = false>
__device__ __forceinline__ void gemm_phase(PG8_LAS unsigned char* lds, const Gemm g, const Sched& S, const Epi& E) {
    int tid = threadIdx.x; asm volatile("" : "+v"(tid));
    const int wid = __builtin_amdgcn_readfirstlane(tid >> 6), lane = tid & 63, wr = wid >> 2, wc = wid & 3, fr = lane & 15, fq = lane >> 4;
    const int K = g.K, nt = K / BK;
    unsigned voffA[2], voffB[2];
#pragma unroll
    for (int i = 0; i < 2; ++i) { int R, C; stage_rc(tid * 16 + i * 8192, R, C); const int Rb = Epi::PERM ? ((R & ~31) + perm32(R & 31)) : R;
        voffA[i] = (unsigned)(R * K + C) * 2u; voffB[i] = (unsigned)(Rb * K + C) * 2u; }
    const size_t kstep = (size_t)(BK * 2);
    const size_t hstep = (size_t)HALF * K * 2;
    const size_t tstep = 2 * hstep;
    const unsigned ldsw = (unsigned)wid * 1024u;
    const int aoff = lds_byte(wr * 64 + fr, fq * 8), boff = lds_byte(wc * 32 + fr, fq * 8);
#define PG8_SA(b, h) (((b) * 2 + (h)) * HTB)
#define PG8_SB(b, h) ((4 + (b) * 2 + (h)) * HTB)
#define PG8_STAGE(bufoff, gbase, voff) do { _Pragma("unroll") for (int _i = 0; _i < 2; ++_i) \
        __builtin_amdgcn_global_load_lds((const unsigned*)((const char*)(gbase) + (voff)[_i]), (PG8_LAS unsigned*)(lds + (bufoff) + ldsw + _i * 8192), 16, 0, 0); } while (0)
#define PG8_LDA(dst, b, h) do { _Pragma("unroll") for (int m = 0; m < 4; ++m) _Pragma("unroll") for (int k = 0; k < 2; ++k) dst[m][k] = *(const PG8_LAS bf16x8*)(lds + PG8_SA(b, h) + aoff + m * 2048 + k * 1024); } while (0)
#define PG8_LDB(dst, b, h) do { _Pragma("unroll") for (int n = 0; n < 2; ++n) _Pragma("unroll") for (int k = 0; k < 2; ++k) dst[n][k] = *(const PG8_LAS bf16x8*)(lds + PG8_SB(b, h) + boff + n * 2048 + k * 1024); } while (0)
#define PG8_MMA(ai, bj, At, Bt) do { __builtin_amdgcn_s_setprio(1); _Pragma("unroll") for (int m = 0; m < 4; ++m) _Pragma("unroll") for (int n = 0; n < 2; ++n) _Pragma("unroll") for (int k = 0; k < 2; ++k) \
        acc[ai][bj][m][n] = __builtin_amdgcn_mfma_f32_16x16x32_bf16(Bt[n][k], At[m][k], acc[ai][bj][m][n], 0, 0, 0); __builtin_amdgcn_s_setprio(0); } while (0)
#define PG8_WAIT_V(n) asm volatile("s_waitcnt vmcnt(" #n ")" ::: "memory")
#define PG8_WAIT_L(n) asm volatile("s_waitcnt lgkmcnt(" #n ")" ::: "memory")
#define PG8_BAR __builtin_amdgcn_s_barrier()
#define PG8_SCHED __builtin_amdgcn_sched_barrier(0)
    Unit cur, nxt; int ui = 0;
    if (!S.next(0, cur)) return;
    f32x4 acc[2][2][4][2];
#pragma unroll
    for (int a = 0; a < 2; ++a)
#pragma unroll
        for (int b = 0; b < 2; ++b)
#pragma unroll
            for (int m = 0; m < 4; ++m)
#pragma unroll
                for (int n = 0; n < 2; ++n) acc[a][b][m][n] = (f32x4){0.f, 0.f, 0.f, 0.f};
    bf16x8 At[4][2], B0[2][2], B1[2][2];
    const char* cA = (const char*)g.A + (size_t)cur.pm * tstep; const char* cB = (const char*)g.Bt + (size_t)cur.pn * tstep;
    S.a_ready(cur);
    if constexpr (SP2) {
        PG8_STAGE(PG8_SB(0, 0), cB, voffB); PG8_STAGE(PG8_SB(0, 1), cB + hstep, voffB); PG8_STAGE(PG8_SA(0, 0), cA, voffA); PG8_STAGE(PG8_SA(0, 1), cA + hstep, voffA);
        if (wr == 1) PG8_BAR;
        PG8_WAIT_V(2); PG8_BAR;
        PG8_STAGE(PG8_SB(1, 0), cB + kstep, voffB); PG8_STAGE(PG8_SA(1, 0), cA + kstep, voffA); PG8_STAGE(PG8_SB(1, 1), cB + hstep + kstep, voffB);
        PG8_WAIT_V(6); PG8_BAR;
    } else {
        PG8_STAGE(PG8_SB(0, 0), cB, voffB); PG8_STAGE(PG8_SA(0, 0), cA, voffA); PG8_STAGE(PG8_SB(0, 1), cB + hstep, voffB); PG8_STAGE(PG8_SA(0, 1), cA + hstep, voffA);
        if (wr == 1) PG8_BAR;
        PG8_WAIT_V(4); PG8_BAR;
        PG8_STAGE(PG8_SB(1, 0), cB + kstep, voffB); PG8_STAGE(PG8_SA(1, 0), cA + kstep, voffA); PG8_STAGE(PG8_SB(1, 1), cB + hstep + kstep, voffB);
        PG8_WAIT_V(6); PG8_BAR;
    }
    for (;;) {
        const bool has_next = S.next(ui + 1, nxt);
        const char* nA = has_next ? (const char*)g.A + (size_t)nxt.pm * tstep : cA; const char* nB = has_next ? (const char*)g.Bt + (size_t)nxt.pn * tstep : cB;
        for (int t = 0; t < nt; t += 2) {
            const bool last = (t == nt - 2);
            const char* a1 = cA + (size_t)(t + 1) * kstep;
            const char* a2 = last ? nA : cA + (size_t)(t + 2) * kstep; const char* b2 = last ? nB : cB + (size_t)(t + 2) * kstep;
            const char* a3 = a2 + kstep; const char* b3 = b2 + kstep;
            if (last && has_next) S.a_ready(nxt);
            if constexpr (SP2) {
            PG8_LDB(B0, 0, 0); PG8_LDB(B1, 0, 1); PG8_SCHED; PG8_LDA(At, 0, 0); PG8_STAGE(PG8_SA(1, 1), a1 + hstep, voffA);
            PG8_WAIT_V(8); PG8_WAIT_L(0); PG8_BAR; PG8_MMA(0, 0, At, B0); PG8_MMA(0, 1, At, B1); PG8_BAR; PG8_SCHED;
            PG8_LDA(At, 0, 1); PG8_STAGE(PG8_SB(0, 0), b2, voffB); PG8_STAGE(PG8_SB(0, 1), b2 + hstep, voffB); PG8_STAGE(PG8_SA(0, 0), a2, voffA);
            PG8_WAIT_V(8); PG8_WAIT_L(0); PG8_BAR; PG8_MMA(1, 0, At, B0); PG8_MMA(1, 1, At, B1); PG8_BAR; PG8_SCHED;
            PG8_LDB(B0, 1, 0); PG8_LDB(B1, 1, 1); PG8_SCHED; PG8_LDA(At, 1, 0); PG8_STAGE(PG8_SA(0, 1), a2 + hstep, voffA);
            PG8_WAIT_V(8); PG8_WAIT_L(0); PG8_BAR; PG8_MMA(0, 0, At, B0); PG8_MMA(0, 1, At, B1); PG8_BAR; PG8_SCHED;
            PG8_LDA(At, 1, 1); PG8_STAGE(PG8_SB(1, 0), b3, voffB); PG8_STAGE(PG8_SB(1, 1), b3 + hstep, voffB); PG8_STAGE(PG8_SA(1, 0), a3, voffA);
            PG8_WAIT_V(8); PG8_WAIT_L(0); PG8_BAR; PG8_MMA(1, 0, At, B0); PG8_MMA(1, 1, At, B1); PG8_BAR; PG8_SCHED;
            } else {
            PG8_LDB(B0, 0, 0); PG8_SCHED; PG8_LDA(At, 0, 0); PG8_STAGE(PG8_SA(1, 1), a1 + hstep, voffA);
            PG8_WAIT_L(8); PG8_BAR; PG8_WAIT_L(0); PG8_MMA(0, 0, At, B0); PG8_BAR; PG8_SCHED;
            PG8_LDB(B1, 0, 1); PG8_STAGE(PG8_SB(0, 0), b2, voffB);
            PG8_BAR; PG8_WAIT_L(0); PG8_MMA(0, 1, At, B1); PG8_BAR;
            PG8_LDA(At, 0, 1); PG8_STAGE(PG8_SA(0, 0), a2, voffA);
            PG8_BAR; PG8_WAIT_L(0); PG8_MMA(1, 0, At, B0); PG8_BAR; PG8_SCHED;
            PG8_STAGE(PG8_SB(0, 1), b2 + hstep, voffB);
            PG8_WAIT_V(6); PG8_BAR; PG8_MMA(1, 1, At, B1); PG8_BAR;
            PG8_LDB(B0, 1, 0); PG8_SCHED; PG8_LDA(At, 1, 0); PG8_STAGE(PG8_SA(0, 1), a2 + hstep, voffA);
            PG8_WAIT_L(8); PG8_BAR; PG8_WAIT_L(0); PG8_MMA(0, 0, At, B0); PG8_BAR; PG8_SCHED;
            PG8_LDB(B1, 1, 1); PG8_STAGE(PG8_SB(1, 0), b3, voffB);
            PG8_BAR; PG8_WAIT_L(0); PG8_MMA(0, 1, At, B1); PG8_BAR;
            PG8_LDA(At, 1, 1); PG8_STAGE(PG8_SA(1, 0), a3, voffA);
            PG8_BAR; PG8_WAIT_L(0); PG8_MMA(1, 0, At, B0); PG8_BAR; PG8_SCHED;
            PG8_STAGE(PG8_SB(1, 1), b3 + hstep, voffB);
            PG8_WAIT_V(6); PG8_BAR; PG8_MMA(1, 1, At, B1); PG8_BAR;
            }
        }
        if constexpr (ALIGN_EPI) { if (wr == 0) PG8_BAR; }
        if constexpr (!Epi::AFTER_DRAIN) { E(acc, cur, wr, wc, fr, fq); S.done(cur); }
        if (!has_next) break;
#pragma unroll
        for (int a = 0; a < 2; ++a)
#pragma unroll
            for (int b = 0; b < 2; ++b)
#pragma unroll
                for (int m = 0; m < 4; ++m)
#pragma unroll
                    for (int n = 0; n < 2; ++n) acc[a][b][m][n] = (f32x4){0.f, 0.f, 0.f, 0.f};
        cur = nxt; cA = nA; cB = nB; ++ui;
        if constexpr (ALIGN_EPI) { if (wr == 1) PG8_BAR; }
    }
    PG8_WAIT_V(0);
    if constexpr (!ALIGN_EPI) { if (wr == 0) PG8_BAR; }
    PG8_BAR;
    if constexpr (Epi::AFTER_DRAIN) { E.fused(acc, cur, wr, wc, fr, fq, lds, wid, lane); S.done(cur); }
#undef PG8_SA
#undef PG8_SB
#undef PG8_STAGE
#undef PG8_LDA
#undef PG8_LDB
#undef PG8_MMA
#undef PG8_WAIT_V
#undef PG8_WAIT_L
#undef PG8_BAR
#undef PG8_SCHED
}
}
namespace pg8 {
struct EpiSwiglu {
    static constexpr bool PERM = true, AFTER_DRAIN = false;
    bf16_t* O; int ldc;
    __device__ __forceinline__ void operator()(const f32x4 (&acc)[2][2][4][2], const Unit& u, int wr, int wc, int fr, int fq) const {
        const int row0 = u.pm * BM + wr * 64 + fr; const int col0 = u.pn * HALF + wc * 32 + 8 * fq;
#pragma unroll
        for (int ai = 0; ai < 2; ++ai)
#pragma unroll
            for (int m = 0; m < 4; ++m) { bf16_t* rowp = O + (size_t)(row0 + ai * HALF + m * 16) * ldc + col0;
                float o[8];
#pragma unroll
                for (int n = 0; n < 2; ++n)
#pragma unroll
                    for (int e = 0; e < 4; ++e) { const float g = acc[ai][0][m][n][e], up = acc[ai][1][m][n][e];
                        o[n * 4 + e] = g * __builtin_amdgcn_rcpf(1.0f + __expf(-g)) * up; }
                u32x4 w; w.x = cvt_pk_bf16(o[0], o[1]); w.y = cvt_pk_bf16(o[2], o[3]); w.z = cvt_pk_bf16(o[4], o[5]); w.w = cvt_pk_bf16(o[6], o[7]);
                PG8_ST16(rowp, w); }
    }
};
}

constexpr int DM = 1024, NBATCH = 32, SEQ = 2048, CTXL = 256, MLAT = NBATCH * SEQ, MCTX = NBATCH * CTXL, MTOT = MLAT + MCTX, FFH = 2816, DEPTH = 4;
constexpr int NMODROW = 33, MODW = 6 * DM;
constexpr int LDS_BYTES = 147456;
constexpr size_t MiB = 1u << 20;
constexpr size_t OFF_MODP = 0;
constexpr size_t OFF_MODS = 26 * MiB;
constexpr size_t OFF_ROPE = 30 * MiB;
constexpr size_t OFF_WS = 32 * MiB;
constexpr size_t OFF_W = 33 * MiB;
constexpr size_t W_FI = 0, W_FO = 44 * MiB, W_AQ = 66 * MiB, W_AO = 72 * MiB, W_BI = 76 * MiB, W_BO = 80 * MiB, W_CQ = 82 * MiB, W_CO = 86 * MiB;
constexpr size_t OFF_XC = 121 * MiB;
constexpr size_t OFF_H = 153 * MiB;
constexpr size_t OFF_Y = 297 * MiB;
constexpr size_t OFF_BIG = 441 * MiB;
constexpr size_t OFF_O = OFF_BIG + 288 * MiB;
constexpr size_t OFF_CTL = OFF_BIG + 432 * MiB;
constexpr size_t CTL_BYTES = 65536;
constexpr size_t WS_END = OFF_CTL + 1 * MiB;
constexpr int LDS_XB = LDS_BYTES - 64;

typedef unsigned short bf16;
typedef short bf16x8 __attribute__((ext_vector_type(8)));
typedef short s16x4 __attribute__((ext_vector_type(4)));
typedef float f32x16 __attribute__((ext_vector_type(16)));
typedef float f32x4 __attribute__((ext_vector_type(4)));
typedef float f32x2 __attribute__((ext_vector_type(2)));
typedef unsigned u32x4 __attribute__((ext_vector_type(4)));
typedef unsigned u32x2 __attribute__((ext_vector_type(2)));
#define LAS __attribute__((address_space(3)))

__device__ __forceinline__ unsigned cvtpk(float lo, float hi) { unsigned r; asm volatile("v_cvt_pk_bf16_f32 %0, %1, %2" : "=v"(r) : "v"(lo), "v"(hi)); return r; }
__device__ __forceinline__ float bf2f(short s) { return __uint_as_float(((unsigned)(unsigned short)s) << 16); }
__device__ __forceinline__ float bflo(unsigned w) { return __uint_as_float(w << 16); }
__device__ __forceinline__ float bfhi(unsigned w) { return __uint_as_float(w & 0xffff0000u); }
__device__ __forceinline__ float wave_sum(float v) {
#pragma unroll
    for (int o = 1; o < 64; o <<= 1) v += __shfl_xor(v, o);
    return v;
}

namespace att {
#define SBAR() __builtin_amdgcn_sched_barrier(0)
__device__ __forceinline__ int crow(int r, int hi) { return (r & 3) + 8 * (r >> 2) + 4 * hi; }
template <int DH> __device__ __forceinline__ int kswz(int row, int colB) { return row * (DH * 2) + (colB ^ ((row & 7) << 4)); }
template <int DH> __device__ __forceinline__ int v_st(int k, int c) { const int kk = (k & ~0xC) | ((k & 4) << 1) | ((k & 8) >> 1); return ((kk >> 3) * (DH / 32) + (c >> 5)) * 512 + ((kk & 7) * 32 + (c & 31)) * 2; }
__device__ __forceinline__ int v_rd_base(int lane) { return ((lane & 3) << 3) | (((lane >> 2) & 3) << 6) | (((lane >> 4) & 1) << 5) | (((lane >> 5) & 1) << 8); }
template <int DH> constexpr int v_rd_off(int d0, int ks, int half) { return d0 * 512 + ks * (DH / 32) * 1024 + half * (DH / 32) * 512; }
template <int OFF> __device__ __forceinline__ s16x4 tr_read(int vb) { s16x4 r; asm volatile("ds_read_b64_tr_b16 %0, %1 offset:%2" : "=&v"(r) : "v"(vb), "i"(OFF) : "memory"); return r; }
template <int DH, int D0> __device__ __forceinline__ void pv_one(f32x16& od, int vb, bf16x8 pa0, bf16x8 pa1, bf16x8 pa2, bf16x8 pa3) {
  const s16x4 l0 = tr_read<v_rd_off<DH>(D0, 0, 0)>(vb), h0 = tr_read<v_rd_off<DH>(D0, 0, 1)>(vb), l1 = tr_read<v_rd_off<DH>(D0, 1, 0)>(vb), h1 = tr_read<v_rd_off<DH>(D0, 1, 1)>(vb);
  const s16x4 l2 = tr_read<v_rd_off<DH>(D0, 2, 0)>(vb), h2 = tr_read<v_rd_off<DH>(D0, 2, 1)>(vb), l3 = tr_read<v_rd_off<DH>(D0, 3, 0)>(vb), h3 = tr_read<v_rd_off<DH>(D0, 3, 1)>(vb);
  asm volatile("s_waitcnt lgkmcnt(0)" ::: "memory"); SBAR();
#define PK(L, H) (bf16x8){L[0], L[1], L[2], L[3], H[0], H[1], H[2], H[3]}
  od = __builtin_amdgcn_mfma_f32_32x32x16_bf16(pa0, PK(l0, h0), od, 0, 0, 0);
  od = __builtin_amdgcn_mfma_f32_32x32x16_bf16(pa1, PK(l1, h1), od, 0, 0, 0);
  od = __builtin_amdgcn_mfma_f32_32x32x16_bf16(pa2, PK(l2, h2), od, 0, 0, 0);
  od = __builtin_amdgcn_mfma_f32_32x32x16_bf16(pa3, PK(l3, h3), od, 0, 0, 0);
#undef PK
}
template <int DH> __device__ __forceinline__ void pv_all(f32x16* o, int vb, bf16x8 pa0, bf16x8 pa1, bf16x8 pa2, bf16x8 pa3) {
  pv_one<DH, 0>(o[0], vb, pa0, pa1, pa2, pa3); pv_one<DH, 1>(o[1], vb, pa0, pa1, pa2, pa3);
  if constexpr (DH == 128) { pv_one<DH, 2>(o[2], vb, pa0, pa1, pa2, pa3); pv_one<DH, 3>(o[3], vb, pa0, pa1, pa2, pa3); }
}
template <int DH> struct SC { static constexpr float SCALE = DH == 128 ? 0.088388347648318440f : 0.125f; static constexpr float C = SCALE * 1.4426950408889634f; static constexpr float THRS = 8.f / SCALE; };
template <int DH> __device__ __forceinline__ void partialSM(f32x16& p0, f32x16& p1, float& m_reg, float& mn, float& alpha) {
  constexpr float C = SC<DH>::C;
  float pmax = p0[0];
#pragma unroll
  for (int r = 1; r < 16; ++r) pmax = fmaxf(pmax, p0[r]);
#pragma unroll
  for (int r = 0; r < 16; ++r) pmax = fmaxf(pmax, p1[r]);
  { auto rr = __builtin_amdgcn_permlane32_swap(__float_as_uint(pmax), __float_as_uint(pmax), false, false);
    pmax = fmaxf(__uint_as_float(rr[0]), __uint_as_float(rr[1])); }
  if (__builtin_expect(__all(pmax - m_reg <= SC<DH>::THRS), 1)) { mn = m_reg; alpha = 1.f; }
  else { mn = fmaxf(m_reg, pmax); alpha = __builtin_amdgcn_exp2f((m_reg - mn) * C); m_reg = mn; }
  const float mnC = -mn * C;
#pragma unroll
  for (int r = 0; r < 16; ++r) p0[r] = fmaf(p0[r], C, mnC);
#pragma unroll
  for (int r = 0; r < 16; ++r) p1[r] = fmaf(p1[r], C, mnC);
#pragma unroll
  for (int r = 0; r < 16; ++r) p0[r] = __builtin_amdgcn_exp2f(p0[r]);
}
__device__ __forceinline__ void finishSM(f32x16& p0, f32x16& p1, float alpha, float& l_reg, bf16x8& pa0, bf16x8& pa1, bf16x8& pa2, bf16x8& pa3) {
#pragma unroll
  for (int r = 0; r < 16; ++r) p1[r] = __builtin_amdgcn_exp2f(p1[r]);
  float ps = 0;
#pragma unroll
  for (int r = 0; r < 16; ++r) ps += p0[r];
#pragma unroll
  for (int r = 0; r < 16; ++r) ps += p1[r];
  { auto rr = __builtin_amdgcn_permlane32_swap(__float_as_uint(ps), __float_as_uint(ps), false, false);
    ps = __uint_as_float(rr[0]) + __uint_as_float(rr[1]); }
  l_reg = l_reg * alpha + ps;
#define PK4(P, BASE, OUT) do { unsigned a0 = cvtpk(P[BASE + 0], P[BASE + 1]), a1 = cvtpk(P[BASE + 2], P[BASE + 3]);   \
    unsigned b0 = cvtpk(P[BASE + 4], P[BASE + 5]), b1 = cvtpk(P[BASE + 6], P[BASE + 7]);                              \
    auto r0 = __builtin_amdgcn_permlane32_swap(a0, b0, false, false); auto r1 = __builtin_amdgcn_permlane32_swap(a1, b1, false, false); \
    u32x4 w = {r0[0], r1[0], r0[1], r1[1]}; OUT = *reinterpret_cast<bf16x8*>(&w); } while (0)
  PK4(p0, 0, pa0); PK4(p0, 8, pa1); PK4(p1, 0, pa2); PK4(p1, 8, pa3);
#undef PK4
}
template <int DH> __device__ __forceinline__ void qkt(f32x16& p0, f32x16& p1, const char* Ks, const bf16x8* qr, int r32, int hi) {
  p0 = f32x16{}; p1 = f32x16{};
#pragma unroll
  for (int d0 = 0; d0 < DH / 16; ++d0) { const int cb = (d0 * 16 + hi * 8) * 2;
    const bf16x8 b0 = *reinterpret_cast<const bf16x8*>(Ks + kswz<DH>(r32, cb));
    const bf16x8 b1 = *reinterpret_cast<const bf16x8*>(Ks + kswz<DH>(32 + r32, cb));
    p0 = __builtin_amdgcn_mfma_f32_32x32x16_bf16(b0, qr[d0], p0, 0, 0, 0);
    p1 = __builtin_amdgcn_mfma_f32_32x32x16_bf16(b1, qr[d0], p1, 0, 0, 0); }
}
__device__ __forceinline__ void wmask(f32x16& p0, f32x16& p1, int kp0, int qp, int hi) {
  const int d0 = kp0 + 4 * hi - qp;
#pragma unroll
  for (int r = 0; r < 16; ++r) { const int d = d0 + (r & 3) + 8 * (r >> 2); if (d > 128 || d < -128) p0[r] = -1e30f; if (d + 32 > 128 || d + 32 < -128) p1[r] = -1e30f; }
}
struct UnitDesc {
  const bf16* Q; const bf16* Kc; const bf16* Vc; bf16* O;
  long ctx_row0, lat_row0; int nctx, band_kp0, NT, qpos0;
  const float* cosT; const float* sinT; const float* qg; float sink_l2;
};
template <int DH, int PITCH, bool QKNORM, bool MASK>
__device__ __forceinline__ void attn_unit(const UnitDesc& u, char* lds) {
  constexpr int NB = DH / 16, NO = DH / 32, TB = 64 * DH * 2, NLD = DH / 64, SDEPTH = DH == 128 ? 1 : 2;
  int tid = threadIdx.x; asm volatile("" : "+v"(tid));
  const int wid = tid >> 6, lane = tid & 63, r32 = lane & 31, hi = lane >> 5;
  char* V_lds = lds; char* K_lds = lds + 2 * TB;
  float* ws = (float*)(lds + 4 * TB) + wid * 64; float* li_l = ws; float* al_l = ws + 32;
  float m_reg = -1e30f, l_reg = 0; f32x16 o[NO];
#pragma unroll
  for (int d = 0; d < NO; ++d) o[d] = f32x16{};
  bf16x8 qr[NB];
  {
    const bf16* Qw = u.Q + (long)(wid * 32 + r32) * PITCH + hi * 8;
    float qf[NB][8];
#pragma unroll
    for (int d0 = 0; d0 < NB; ++d0) { const bf16x8 raw = *reinterpret_cast<const bf16x8*>(Qw + d0 * 16);
#pragma unroll
      for (int j = 0; j < 8; ++j) qf[d0][j] = bf2f(raw[j]); }
    if constexpr (QKNORM) {
      float ss = 0.f;
#pragma unroll
      for (int d0 = 0; d0 < NB; ++d0)
#pragma unroll
        for (int j = 0; j < 8; ++j) ss += qf[d0][j] * qf[d0][j];
      ss += __shfl_xor(ss, 32);
      const float rstd = rsqrtf(ss * (1.0f / DH) + 1e-6f);
#pragma unroll
      for (int d0 = 0; d0 < NB; ++d0) { const f32x4 g0 = *(const f32x4*)(u.qg + d0 * 16 + hi * 8), g1 = *(const f32x4*)(u.qg + d0 * 16 + hi * 8 + 4);
#pragma unroll
        for (int j = 0; j < 4; ++j) { qf[d0][j] *= rstd * g0[j]; qf[d0][4 + j] *= rstd * g1[j]; } }
    }
    if (u.qpos0 >= 0) {
      const int pos = u.qpos0 + wid * 32 + r32;
      const float* cp = u.cosT + (long)pos * (DH / 2) + hi * 8; const float* sp = u.sinT + (long)pos * (DH / 2) + hi * 8;
#pragma unroll
      for (int d0 = 0; d0 < NB / 2; ++d0) {
        const f32x4 c0 = *(const f32x4*)(cp + d0 * 16), c1 = *(const f32x4*)(cp + d0 * 16 + 4), s0 = *(const f32x4*)(sp + d0 * 16), s1 = *(const f32x4*)(sp + d0 * 16 + 4);
#pragma unroll
        for (int j = 0; j < 8; ++j) { const float c = j < 4 ? c0[j & 3] : c1[j & 3], s = j < 4 ? s0[j & 3] : s1[j & 3];
          const float x1 = qf[d0][j], x2 = qf[d0 + NB / 2][j]; qf[d0][j] = x1 * c - x2 * s; qf[d0 + NB / 2][j] = x2 * c + x1 * s; }
      }
    }
#pragma unroll
    for (int d0 = 0; d0 < NB; ++d0) { u32x4 w = {cvtpk(qf[d0][0], qf[d0][1]), cvtpk(qf[d0][2], qf[d0][3]), cvtpk(qf[d0][4], qf[d0][5]), cvtpk(qf[d0][6], qf[d0][7])}; qr[d0] = *reinterpret_cast<bf16x8*>(&w); }
  }
  const int sr = DH == 128 ? (tid >> 4) : (tid >> 3), sc = DH == 128 ? (tid & 15) * 8 : (tid & 7) * 8;
  const int vb0 = (int)(uintptr_t)V_lds + v_rd_base(lane);
  struct { bf16x8 v[NLD], k[NLD]; } st_[SDEPTH];
  const int qp = u.qpos0 + wid * 32 + r32;
#define TROW(t) ((t) < u.nctx ? u.ctx_row0 + 64 * (t) : u.lat_row0 + u.band_kp0 + 64 * ((t) - u.nctx))
#define TKP(t) (u.band_kp0 + 64 * ((t) - u.nctx))
#define SLOAD(i, t) do { const long row_ = TROW(t); _Pragma("unroll") for (int l_ = 0; l_ < NLD; ++l_) { \
    st_[i].v[l_] = *reinterpret_cast<const bf16x8*>(u.Vc + (row_ + sr + 32 * l_) * PITCH + sc); st_[i].k[l_] = *reinterpret_cast<const bf16x8*>(u.Kc + (row_ + sr + 32 * l_) * PITCH + sc); } } while (0)
#define SWRITE(b, i) do { _Pragma("unroll") for (int l_ = 0; l_ < NLD; ++l_) { *(bf16x8*)(V_lds + (b) * TB + v_st<DH>(sr + 32 * l_, sc)) = st_[i].v[l_]; \
    *(bf16x8*)(K_lds + (b) * TB + kswz<DH>(sr + 32 * l_, sc * 2)) = st_[i].k[l_]; } } while (0)
#define SWAIT() do { if constexpr (SDEPTH == 1) asm volatile("s_waitcnt vmcnt(0)" ::: "memory"); else if constexpr (NLD == 2) asm volatile("s_waitcnt vmcnt(4)" ::: "memory"); else asm volatile("s_waitcnt vmcnt(2)" ::: "memory"); } while (0)
#define RESC(a) do { if (__any((a) < 1.f)) { if (hi == 0) al_l[r32] = (a); asm volatile("s_waitcnt lgkmcnt(0)" ::: "memory"); \
    _Pragma("unroll") for (int d = 0; d < NO; ++d) _Pragma("unroll") for (int r = 0; r < 16; ++r) o[d][r] *= al_l[crow(r, hi)]; } } while (0)
#define AMASK(P0, P1, t) do { if constexpr (MASK) { if ((t) >= u.nctx && (TKP(t) < qw - 97 || TKP(t) + 63 > qw + 128)) wmask(P0, P1, TKP(t), qp, hi); } } while (0)
  f32x16 pA0, pA1, pB0, pB1; float mnA, mnB, alA, alB; bf16x8 pa0, pa1, pa2, pa3; const int NT = u.NT;
  constexpr int SE = 0, SO = SDEPTH - 1;
  const int qw = __builtin_amdgcn_readfirstlane(u.qpos0 + wid * 32);
#define ACT(t) (!MASK || (t) < u.nctx || (TKP(t) <= qw + 159 && TKP(t) + 63 >= qw - 128))
  bool actA = true, actB = true;
  SLOAD(SE, 0); asm volatile("s_waitcnt vmcnt(0)" ::: "memory"); SWRITE(0, SE); __syncthreads();
  qkt<DH>(pA0, pA1, K_lds, qr, r32, hi); AMASK(pA0, pA1, 0); partialSM<DH>(pA0, pA1, m_reg, mnA, alA);
  SLOAD(SO, 1); if constexpr (SDEPTH == 2) { if (2 < NT) SLOAD(SE, 2); }
  SWAIT(); SWRITE(1, SO); __syncthreads();
  for (int j = 1; j + 1 < NT; j += 2) {
    actB = ACT(j);
    SBAR(); if (actB) { qkt<DH>(pB0, pB1, K_lds + TB, qr, r32, hi); AMASK(pB0, pB1, j); }
    if (actA) finishSM(pA0, pA1, alA, l_reg, pa0, pa1, pa2, pa3); SBAR();
    SLOAD(SO, j + SDEPTH); SBAR();
    if (actA) pv_all<DH>(o, vb0, pa0, pa1, pa2, pa3);
    if (actB) partialSM<DH>(pB0, pB1, m_reg, mnB, alB); else alB = 1.f;
    __syncthreads(); SWAIT(); SWRITE(0, SE);
    RESC(alB); __syncthreads();
    actA = ACT(j + 1);
    SBAR(); if (actA) { qkt<DH>(pA0, pA1, K_lds, qr, r32, hi); AMASK(pA0, pA1, j + 1); }
    if (actB) finishSM(pB0, pB1, alB, l_reg, pa0, pa1, pa2, pa3); SBAR();
    if (SDEPTH == 1 || j + 3 < NT) SLOAD(SE, j + 1 + SDEPTH); SBAR();
    if (actB) pv_all<DH>(o, vb0 + TB, pa0, pa1, pa2, pa3);
    if (actA) partialSM<DH>(pA0, pA1, m_reg, mnA, alA); else alA = 1.f;
    __syncthreads(); SWAIT(); SWRITE(1, SO);
    RESC(alA); __syncthreads();
  }
  actB = ACT(NT - 1);
  SBAR(); if (actB) { qkt<DH>(pB0, pB1, K_lds + TB, qr, r32, hi); AMASK(pB0, pB1, NT - 1); }
  if (actA) finishSM(pA0, pA1, alA, l_reg, pa0, pa1, pa2, pa3); SBAR();
  if (actA) pv_all<DH>(o, vb0, pa0, pa1, pa2, pa3);
  if (actB) partialSM<DH>(pB0, pB1, m_reg, mnB, alB); else alB = 1.f;
  __syncthreads(); RESC(alB);
  if (actB) { finishSM(pB0, pB1, alB, l_reg, pa0, pa1, pa2, pa3); SBAR();
    pv_all<DH>(o, vb0 + TB, pa0, pa1, pa2, pa3); }
#undef ACT
  l_reg += __builtin_amdgcn_exp2f(u.sink_l2 - m_reg * SC<DH>::C);
  if (hi == 0) li_l[r32] = l_reg; asm volatile("s_waitcnt lgkmcnt(0)" ::: "memory");
  float rli[16];
#pragma unroll
  for (int r = 0; r < 16; ++r) rli[r] = __builtin_amdgcn_rcpf(li_l[crow(r, hi)]);
  { bf16* stg = (bf16*)(lds + 4 * TB + 2048) + wid * (32 * DH);
#pragma unroll
    for (int r = 0; r < 16; ++r) { const int orow = crow(r, hi);
#pragma unroll
      for (int d0 = 0; d0 < NO; ++d0) { const float v = o[d0][r] * rli[r]; const unsigned w = cvtpk(v, v); stg[orow * DH + d0 * 32 + r32] = (bf16)(w & 0xffffu); } }
    asm volatile("s_waitcnt lgkmcnt(0)" ::: "memory");
    constexpr int CPR = DH / 8, RPI = 64 / CPR;
    bf16* Ow = u.O + (long)(wid * 32) * DM;
#pragma unroll
    for (int i = 0; i < 32 / RPI; ++i) { const int row = i * RPI + lane / CPR, ch = lane % CPR; const u32x4 v = *(const u32x4*)(stg + row * DH + ch * 8); *(u32x4*)(Ow + (long)row * DM + ch * 8) = v; } }
  __syncthreads();
#undef TROW
#undef TKP
#undef SLOAD
#undef SWRITE
#undef SWAIT
#undef RESC
#undef AMASK
}
}

__device__ __forceinline__ void transpose_item(const float* W, int K, int N, bf16* WT, int k0, int n0, int drow0, LAS float* scr, int lane) {
    float tv[32];
#pragma unroll
    for (int i = 0; i < 32; ++i) tv[i] = W[(size_t)(k0 + 2 * i + (lane >> 5)) * N + n0 + (lane & 31)];
#pragma unroll
    for (int i = 0; i < 32; ++i) scr[(2 * i + (lane >> 5)) * 33 + (lane & 31)] = tv[i];
    asm volatile("s_waitcnt lgkmcnt(0)" ::: "memory");
    const int c = lane & 7;
#pragma unroll
    for (int j = 0; j < 4; ++j) { const int n = (lane >> 3) + 8 * j; const LAS float* s = scr + (8 * c) * 33 + n;
        u32x4 o; o.x = cvtpk(s[0 * 33], s[1 * 33]); o.y = cvtpk(s[2 * 33], s[3 * 33]); o.z = cvtpk(s[4 * 33], s[5 * 33]); o.w = cvtpk(s[6 * 33], s[7 * 33]);
        *(u32x4*)(WT + (size_t)(drow0 + n) * K + k0 + 8 * c) = o; }
    asm volatile("s_waitcnt lgkmcnt(0)" ::: "memory");
}
__device__ __forceinline__ int ffn_in_row(int n0) { return n0 < FFH ? 256 * (n0 >> 7) + (n0 & 127) : 256 * ((n0 - FFH) >> 7) + 128 + ((n0 - FFH) & 127); }

struct RowJob { const float* xin; const bf16* y; float* xout; bf16* h; const float* gate; const float* sh; const float* sc; };
template <int NR, bool HASY, bool HASH>
__device__ __forceinline__ void combine_rows(const RowJob (&J)[NR], const float* npost, const float* npre, int lane, float gmul) {
    f32x4 xv[NR][4]; u32x2 yv[NR][4];
#pragma unroll
    for (int q = 0; q < NR; ++q)
#pragma unroll
        for (int j = 0; j < 4; ++j) { xv[q][j] = ((const f32x4*)J[q].xin)[lane + 64 * j]; if constexpr (HASY) yv[q][j] = ((const u32x2*)J[q].y)[lane + 64 * j]; }
    if constexpr (HASY) {
        float rstd[NR];
#pragma unroll
        for (int q = 0; q < NR; ++q) { float ss = 0.f;
#pragma unroll
            for (int j = 0; j < 4; ++j) { const float a = bflo(yv[q][j].x), b = bfhi(yv[q][j].x), c = bflo(yv[q][j].y), d = bfhi(yv[q][j].y); ss += (a * a + b * b) + (c * c + d * d); }
            rstd[q] = rsqrtf(wave_sum(ss) * (1.0f / DM) + 1e-6f) * gmul; }
#pragma unroll
        for (int j = 0; j < 4; ++j) { const f32x4 n4 = ((const f32x4*)npost)[lane + 64 * j];
#pragma unroll
            for (int q = 0; q < NR; ++q) { const f32x4 g4 = ((const f32x4*)J[q].gate)[lane + 64 * j];
                const f32x4 yf = {bflo(yv[q][j].x), bfhi(yv[q][j].x), bflo(yv[q][j].y), bfhi(yv[q][j].y)};
                xv[q][j] = xv[q][j] + g4 * (yf * rstd[q] * n4);
                ((f32x4*)J[q].xout)[lane + 64 * j] = xv[q][j]; } }
    }
    if constexpr (HASH) {
        float rstd[NR];
#pragma unroll
        for (int q = 0; q < NR; ++q) { float ss = 0.f;
#pragma unroll
            for (int j = 0; j < 4; ++j) ss += (xv[q][j].x * xv[q][j].x + xv[q][j].y * xv[q][j].y) + (xv[q][j].z * xv[q][j].z + xv[q][j].w * xv[q][j].w);
            rstd[q] = rsqrtf(wave_sum(ss) * (1.0f / DM) + 1e-6f); }
#pragma unroll
        for (int j = 0; j < 4; ++j) { const f32x4 n4 = ((const f32x4*)npre)[lane + 64 * j];
#pragma unroll
            for (int q = 0; q < NR; ++q) { const f32x4 s4 = ((const f32x4*)J[q].sc)[lane + 64 * j], b4 = ((const f32x4*)J[q].sh)[lane + 64 * j];
                const f32x4 hv = (xv[q][j] * rstd[q] * n4) * (s4 + 1.0f) + b4;
                u32x2 w; w.x = cvtpk(hv.x, hv.y); w.y = cvtpk(hv.z, hv.w); ((u32x2*)J[q].h)[lane + 64 * j] = w; } }
    }
}

template <bool HASY, bool HASH>
__device__ __forceinline__ void combine_span(int mb, int me, const float* xin_lat, const float* xin_ctx, float* xout_lat, float* xout_ctx, const bf16* Y, bf16* H,
                                             const float* gate0, const float* npost, const float* sh0, const float* sc0, const float* npre, int lane, float gmul) {
    int cur_r = -1; f32x4 A1[4], A2[4], B2[4];
    for (int m = mb; m < me;) {
        const int r = m < MLAT ? (m >> 11) : 32;
        if (r != cur_r) { cur_r = r;
#pragma unroll
            for (int j = 0; j < 4; ++j) {
                if constexpr (HASY) A1[j] = ((const f32x4*)(gate0 + (size_t)r * MODW))[lane + 64 * j] * ((const f32x4*)npost)[lane + 64 * j] * gmul;
                if constexpr (HASH) { A2[j] = ((const f32x4*)npre)[lane + 64 * j] * (((const f32x4*)(sc0 + (size_t)r * MODW))[lane + 64 * j] + 1.0f); B2[j] = ((const f32x4*)(sh0 + (size_t)r * MODW))[lane + 64 * j]; } } }
        const int mn = m + 1; const bool two = mn < me && (mn < MLAT ? (mn >> 11) : 32) == r;
        const int mq[2] = {m, two ? mn : m};
        f32x4 xv[2][4]; u32x2 yv[2][4];
#pragma unroll
        for (int q = 0; q < 2; ++q) { const int mm = mq[q]; const float* xi = mm < MLAT ? xin_lat + (size_t)mm * DM : xin_ctx + (size_t)(mm - MLAT) * DM;
#pragma unroll
            for (int j = 0; j < 4; ++j) { xv[q][j] = ((const f32x4*)xi)[lane + 64 * j]; if constexpr (HASY) yv[q][j] = ((const u32x2*)(Y + (size_t)mm * DM))[lane + 64 * j]; } }
        if constexpr (HASY) {
            float rstd[2];
#pragma unroll
            for (int q = 0; q < 2; ++q) { float ss = 0.f;
#pragma unroll
                for (int j = 0; j < 4; ++j) { const float a = bflo(yv[q][j].x), b = bfhi(yv[q][j].x), c = bflo(yv[q][j].y), d = bfhi(yv[q][j].y); ss += (a * a + b * b) + (c * c + d * d); }
                rstd[q] = rsqrtf(wave_sum(ss) * (1.0f / DM) + 1e-6f); }
#pragma unroll
            for (int q = 0; q < 2; ++q) { const int mm = mq[q]; float* xo = mm < MLAT ? xout_lat + (size_t)mm * DM : xout_ctx + (size_t)(mm - MLAT) * DM;
#pragma unroll
                for (int j = 0; j < 4; ++j) { const f32x4 yf = {bflo(yv[q][j].x), bfhi(yv[q][j].x), bflo(yv[q][j].y), bfhi(yv[q][j].y)};
                    xv[q][j] = xv[q][j] + A1[j] * (yf * rstd[q]); ((f32x4*)xo)[lane + 64 * j] = xv[q][j]; } }
        }
        if constexpr (HASH) {
            float rstd[2];
#pragma unroll
            for (int q = 0; q < 2; ++q) { float ss = 0.f;
#pragma unroll
                for (int j = 0; j < 4; ++j) ss += (xv[q][j].x * xv[q][j].x + xv[q][j].y * xv[q][j].y) + (xv[q][j].z * xv[q][j].z + xv[q][j].w * xv[q][j].w);
                rstd[q] = rsqrtf(wave_sum(ss) * (1.0f / DM) + 1e-6f); }
#pragma unroll
            for (int q = 0; q < 2; ++q) { const int mm = mq[q];
#pragma unroll
                for (int j = 0; j < 4; ++j) { const f32x4 hv = (xv[q][j] * rstd[q]) * A2[j] + B2[j];
                    u32x2 w; w.x = cvtpk(hv.x, hv.y); w.y = cvtpk(hv.z, hv.w); ((u32x2*)(H + (size_t)mm * DM))[lane + 64 * j] = w; } }
        }
        m += two ? 2 : 1;
    }
}

#define XB_TMO      128
#define XB_XCNT(j)  (256  + 64 * (j))
#define XB_XSUB(j)  (1280 + 64 * (j))
#define XB_XGEN(j)  (2304 + 64 * (j))
#define XB_TOP      3328
#define XB_TOPGEN   3392
#define XCD_BAR_WORDS 3456
#define XB_SPIN_CAP (1u << 18)

__device__ __forceinline__ unsigned xb_ld(unsigned* p)              { return __hip_atomic_load(p, __ATOMIC_RELAXED, __HIP_MEMORY_SCOPE_AGENT); }
__device__ __forceinline__ unsigned xb_add(unsigned* p, unsigned v) { return __hip_atomic_fetch_add(p, v, __ATOMIC_RELAXED, __HIP_MEMORY_SCOPE_AGENT); }
__device__ __forceinline__ unsigned xb_xcc_id() { return (unsigned)__builtin_amdgcn_s_getreg((3 << 11) | 20) & 0xFu; }
#define XB_SPIN(cond, bar) do { unsigned _sp = 0; while (cond) { __builtin_amdgcn_s_sleep(1); \
    if ((++_sp & 255u) == 0u) { if (xb_ld(&(bar)[XB_TMO])) break; if (_sp > XB_SPIN_CAP) { atomicAdd(&(bar)[XB_TMO], 1u); break; } } } } while (0)

struct XcdBarrier {
    unsigned* bar; unsigned x;
    volatile LAS unsigned* st;
};

__device__ __forceinline__ XcdBarrier xcd_barrier_post(unsigned* bar, volatile LAS unsigned* st) {
    XcdBarrier b; b.bar = bar; b.x = xb_xcc_id(); b.st = st;
    if (threadIdx.x == 0) (void)xb_add(&bar[XB_XCNT(b.x)], 1u);
    return b;
}
__device__ __forceinline__ void xcd_barrier_complete(unsigned* bar, unsigned x, unsigned& nloc, unsigned& nx) {
    const unsigned G = gridDim.x * gridDim.y * gridDim.z;
    unsigned sum, cnt, mine, sp = 0u;
    for (;;) {
        sum = 0u; cnt = 0u; mine = 0u;
#pragma unroll
        for (unsigned j = 0; j < 16; ++j) { const unsigned c = xb_ld(&bar[XB_XCNT(j)]); sum += c; cnt += (c > 0u) ? 1u : 0u; mine = (j == x) ? c : mine; }
        if (sum == G) break;
        __builtin_amdgcn_s_sleep(1);
        if ((++sp & 255u) == 0u) { if (xb_ld(&bar[XB_TMO])) break; if (sp > XB_SPIN_CAP) { atomicAdd(&bar[XB_TMO], 1u); break; } }
    }
    nloc = mine > 0u ? mine : 1u; nx = cnt > 0u ? cnt : 1u;
}

__device__ __forceinline__ void xcd_barrier(const XcdBarrier& b) {
    asm volatile("s_waitcnt vmcnt(0)" ::: "memory");
    __syncthreads();
    if (threadIdx.x == 0) {
        unsigned* bar = b.bar;
        __builtin_amdgcn_s_waitcnt(0);
        unsigned nloc = b.st[0], nx = b.st[1];
        if (nloc == 0u) { xcd_barrier_complete(bar, b.x, nloc, nx); b.st[0] = nloc; b.st[1] = nx; }
        const unsigned old = xb_add(&bar[XB_XSUB(b.x)], 1u);
        const unsigned gen = old / nloc;
        if (old + 1u == (gen + 1u) * nloc) {
            __builtin_amdgcn_fence(__ATOMIC_RELEASE, "agent");
            asm volatile("s_waitcnt vmcnt(0)" ::: "memory");
            const unsigned og = xb_add(&bar[XB_TOP], 1u);
            const unsigned tg = og / nx;
            if (og + 1u == (tg + 1u) * nx) xb_add(&bar[XB_TOPGEN], 1u);
            else XB_SPIN(xb_ld(&bar[XB_TOPGEN]) == tg, bar);
            __builtin_amdgcn_fence(__ATOMIC_ACQUIRE, "agent");
            xb_add(&bar[XB_XGEN(b.x)], 1u);
            asm volatile("s_waitcnt vmcnt(0)" ::: "memory");
        } else {
            XB_SPIN(xb_ld(&bar[XB_XGEN(b.x)]) == gen, bar);
            __builtin_amdgcn_fence(__ATOMIC_ACQUIRE, "agent");
            asm volatile("s_waitcnt vmcnt(0)" ::: "memory");
        }
    }
    __syncthreads();
}

struct Args { const float* in[23]; float* out; unsigned char* ws; int ph_lo, ph_hi; };

__global__ void __launch_bounds__(512, 2) mega(Args args) {
    extern __shared__ __attribute__((aligned(16))) unsigned char lds[];
    cg::grid_group grid = cg::this_grid();
    const int G = gridDim.x, bx = blockIdx.x;
    const int vcu = (G % 8 == 0) ? (bx % 8) * (G / 8) + bx / 8 : bx;
    const int NGW = G * 8;
    const int lo = args.ph_lo, hi = args.ph_hi;
    unsigned char* ws = args.ws;
    const float* x_in = args.in[0]; const float* c_in = args.in[1]; const float* ctx_in = args.in[2]; const float* cctx_in = args.in[3];
    const float* ada_w = args.in[4]; const float* ada_b = args.in[5]; const float* norm_g = args.in[6];
    float* modp = (float*)(ws + OFF_MODP); float* mods = (float*)(ws + OFF_MODS);
    float* cosA = (float*)(ws + OFF_ROPE); float* sinA = cosA + 2048 * 32; float* cosC = sinA + 2048 * 32; float* sinC = cosC + 2048 * 64;
    bf16* Wsb = (bf16*)(ws + OFF_WS);
    unsigned char* Wb = ws + OFF_W;
    float* XC = (float*)(ws + OFF_XC); float* XL = args.out;
    bf16* Hb = (bf16*)(ws + OFF_H); bf16* Yb = (bf16*)(ws + OFF_Y); bf16* QKV = (bf16*)(ws + OFF_BIG); bf16* Ob = (bf16*)(ws + OFF_O); bf16* HID = (bf16*)(ws + OFF_BIG);
    if (threadIdx.x < 16) ((LAS unsigned*)((LAS unsigned char*)lds + LDS_XB))[threadIdx.x] = 0u;
    __syncthreads();
    const XcdBarrier xbar = xcd_barrier_post((unsigned*)(ws + OFF_CTL), (volatile LAS unsigned*)((LAS unsigned char*)lds + LDS_XB));
    bool first_seam = true;
    int ph = 0;
#define GSYNC() do { if (first_seam) { grid.sync(); first_seam = false; } else xcd_barrier(xbar); } while (0)
#ifndef PH_MASK
#define PH_MASK 0xffff
#endif
#define RUN(p) (lo <= (p) && (p) < hi)
#define ON(b) ((PH_MASK >> (b)) & 1)
#ifndef G1MASK
#define G1MASK 7
#endif
#ifndef ATMASK
#define ATMASK 3
#endif
#define ATK(k) ((ATMASK >> (k)) & 1)
#define G1K(k) ((G1MASK >> (k)) & 1)
#define SEAM(p) do { if (RUN(p) && RUN((p) + 1)) GSYNC(); } while (0)

#ifndef NPRO
#define NPRO 1
#endif
#ifndef EPI_SKIP_ON_REP
#define EPI_SKIP_ON_REP 0
#endif
#ifdef EXTRA_SYNCS
    for (int es = 0; es < EXTRA_SYNCS; ++es) GSYNC();
#endif
    for (int prep = 0; prep < NPRO; ++prep) {
    if (prep) { GSYNC(); ph -= 3; }
    int tid = threadIdx.x; asm volatile("" : "+v"(tid));
    const int lane = tid & 63, wave = __builtin_amdgcn_readfirstlane(tid >> 6), gw = vcu * 8 + wave;
    if (ON(0) && RUN(ph)) {
        LAS float* scr = (LAS float*)((LAS unsigned char*)lds + wave * 16896);
        for (int it = gw; it < 96 * 8; it += NGW) {
            const int cb = it % 96, ks = it / 96, k0 = ks * 128;
            for (int idx = lane; idx < NMODROW * 128; idx += 64) { const int r = idx >> 7, kk = idx & 127; const float v = r < 32 ? c_in[r * DM + k0 + kk] : cctx_in[k0 + kk];
                scr[idx] = v / (1.0f + __expf(-v)); }
            asm volatile("s_waitcnt lgkmcnt(0)" ::: "memory");
            f32x4 acc[NMODROW];
#pragma unroll
            for (int r = 0; r < NMODROW; ++r) acc[r] = (f32x4){0.f, 0.f, 0.f, 0.f};
            const int li = cb / 24, col0 = (cb % 24) * 256 + lane * 4;
            const float* wp = ada_w + ((size_t)li * DM + k0) * MODW + col0;
#pragma unroll 2
            for (int kk = 0; kk < 128; ++kk) { const f32x4 w4 = *(const f32x4*)(wp + (size_t)kk * MODW);
#pragma unroll
                for (int r = 0; r < NMODROW; ++r) { const float s = scr[r * 128 + kk]; acc[r] = acc[r] + w4 * s; } }
#pragma unroll
            for (int r = 0; r < NMODROW; ++r) *(f32x4*)(modp + ((size_t)ks * NMODROW + r) * (4 * MODW) + li * MODW + col0) = acc[r];
            asm volatile("s_waitcnt lgkmcnt(0)" ::: "memory");
        }
        {
            constexpr int I_FI = 16 * 176, I_FO = 44 * 32, I_AQ = 16 * 48, I_AO = 16 * 32, I_BI = 16 * 64, I_BO = 16 * 32, I_CQ = 16 * 64, I_CO = 16 * 32;
            constexpr int NIT = 4 * I_FI + 4 * I_FO + 2 * I_AQ + 2 * I_AO + I_BI + I_BO + I_CQ + I_CO;
            const int ntw = NGW > 1024 ? NGW - 768 : NGW, tw = NGW > 1024 ? gw - 768 : gw;
            if (tw >= 0) for (int it = tw; it < NIT; it += ntw) {
                int r = it;
                if (r < 4 * I_FI) { const int l = r / I_FI; r %= I_FI; const int kb = r / 176, nb = r % 176;
                    transpose_item(args.in[7] + (size_t)l * DM * 2 * FFH, DM, 2 * FFH, (bf16*)(Wb + W_FI) + (size_t)l * 2 * FFH * DM, kb * 64, nb * 32, ffn_in_row(nb * 32), scr, lane); continue; } r -= 4 * I_FI;
                if (r < 4 * I_FO) { const int l = r / I_FO; r %= I_FO; const int kb = r / 32, nb = r % 32;
                    transpose_item(args.in[8] + (size_t)l * FFH * DM, FFH, DM, (bf16*)(Wb + W_FO) + (size_t)l * DM * FFH, kb * 64, nb * 32, nb * 32, scr, lane); continue; } r -= 4 * I_FO;
                if (r < 2 * I_AQ) { const int l = r / I_AQ; r %= I_AQ; const int kb = r / 48, nb = r % 48;
                    transpose_item(args.in[9] + (size_t)l * DM * 1536, DM, 1536, (bf16*)(Wb + W_AQ) + (size_t)l * 1536 * DM, kb * 64, nb * 32, nb * 32, scr, lane); continue; } r -= 2 * I_AQ;
                if (r < 2 * I_AO) { const int l = r / I_AO; r %= I_AO; const int kb = r / 32, nb = r % 32;
                    transpose_item(args.in[10] + (size_t)l * DM * DM, DM, DM, (bf16*)(Wb + W_AO) + (size_t)l * DM * DM, kb * 64, nb * 32, nb * 32, scr, lane); continue; } r -= 2 * I_AO;
                if (r < I_BI) { const int kb = r / 64, nb = r % 64; transpose_item(args.in[12], DM, 2048, (bf16*)(Wb + W_BI), kb * 64, nb * 32, nb * 32, scr, lane); continue; } r -= I_BI;
                if (r < I_BO) { const int kb = r / 32, nb = r % 32; transpose_item(args.in[18], DM, DM, (bf16*)(Wb + W_BO), kb * 64, nb * 32, nb * 32, scr, lane); continue; } r -= I_BO;
                if (r < I_CQ) { const int kb = r / 64, nb = r % 64; transpose_item(args.in[19], DM, 2048, (bf16*)(Wb + W_CQ), kb * 64, nb * 32, nb * 32, scr, lane); continue; } r -= I_CQ;
                { const int kb = r / 32, nb = r % 32; transpose_item(args.in[20], DM, DM, (bf16*)(Wb + W_CO), kb * 64, nb * 32, nb * 32, scr, lane); }
            }
        }
        {
            const int gt = gw * 64 + lane, NGT = NGW * 64;
            const float* wsf = args.in[16];
            for (int e = gt; e < 8 * 128 * 128 / 2; e += NGT) ((unsigned*)Wsb)[e] = cvtpk(wsf[2 * e], wsf[2 * e + 1]);
            for (int e = gt; e < 2048 * 32; e += NGT) { const int t = e >> 5, p = e & 31, j = p & 15; const float pos = (float)(p < 16 ? (t >> 6) : (t & 63));
                const float inv = exp2f(-(float)j * (13.287712379549449f / 16.0f)); const float a = pos * inv; cosA[e] = cosf(a); sinA[e] = sinf(a); }
            for (int e = gt; e < 2048 * 64; e += NGT) { const int t = e >> 6, p = e & 63, j = p & 31; const float pos = (float)(p < 32 ? (t >> 6) : (t & 63));
                const float inv = exp2f(-(float)j * (13.287712379549449f / 32.0f)); const float a = pos * inv; cosC[e] = cosf(a); sinC[e] = sinf(a); }
        }
    }
    SEAM(ph); ++ph;
    if (ON(1) && RUN(ph)) {
        const int gt = gw * 64 + lane, NGT = NGW * 64;
        for (int e = gt; e < DEPTH * NMODROW * MODW / 4; e += NGT) {
            const int c4 = e % (MODW / 4), rr = (e / (MODW / 4)) % NMODROW, li = e / (MODW / 4 * NMODROW);
            f32x4 s = *(const f32x4*)(ada_b + li * MODW + c4 * 4);
#pragma unroll
            for (int k = 0; k < 8; ++k) s = s + *(const f32x4*)(modp + ((size_t)k * NMODROW + rr) * (4 * MODW) + li * MODW + c4 * 4);
            *(f32x4*)(mods + ((size_t)li * NMODROW + rr) * MODW + c4 * 4) = s;
        }
    }
    SEAM(ph); ++ph;
    if (ON(2) && RUN(ph)) {
        { const int rpw = (MTOT + NGW - 1) / NGW, mb = gw * rpw, me = mb + rpw < MTOT ? mb + rpw : MTOT;
          combine_span<false, true>(mb, me, x_in, ctx_in, nullptr, nullptr, nullptr, Hb, nullptr, nullptr, mods, mods + DM, norm_g, lane, 1.0f); }
    }
    SEAM(ph); ++ph;
    }

    for (int step = 3, rep = 0; step < 3 + 8 * DEPTH; ) {
        const int li = (step - 3) >> 3, op = (step - 3) & 7;
        int tid = threadIdx.x; asm volatile("" : "+v"(tid));
        const int lane = tid & 63, wave = __builtin_amdgcn_readfirstlane(tid >> 6), gw = vcu * 8 + wave;
        const int kind = li % 3; const int ja = li / 3; const bool ctx_out = li < DEPTH - 1; const int Mact = ctx_out ? MTOT : MLAT;
        const float* ng = norm_g + (size_t)li * 4 * DM;
        const bool noop = (op == 1 && kind == 1);
        if (RUN(ph) && !noop) {
#ifdef STAGGER_US
            if (op == 0 || op == 3 || op == 5 || op == 6) {
                const unsigned long long t0 = __builtin_amdgcn_s_memrealtime(); const unsigned long long dl = (unsigned long long)(((bx >> 3) & 3) * STAGGER_US * 100);
                while (__builtin_amdgcn_s_memrealtime() - t0 < dl) __builtin_amdgcn_s_sleep(32);
            }
#endif
            if (ON(3) && ((op == 0 && kind != 1) || op == 3 || op == 6)) {
                pg8::Gemm g; pg8::EpiBf16<0> E; E.bias = nullptr; E.split_cols = 0; E.split_stride = 0; E.scale0 = 1.f; E.skip = EPI_SKIP_ON_REP ? rep : 0;
                if (op == 0) { const int N1 = kind == 0 ? 1536 : 2048; g.A = Hb; g.Bt = kind == 0 ? (const bf16*)(Wb + W_AQ) + (size_t)ja * 1536 * DM : (const bf16*)(Wb + W_CQ); g.M = MTOT; g.N = N1; g.K = DM; E.O = QKV; E.ldc = N1; }
                else if (op == 3) { g.A = Ob; g.Bt = kind == 0 ? (const bf16*)(Wb + W_AO) + (size_t)ja * DM * DM : kind == 1 ? (const bf16*)(Wb + W_BO) : (const bf16*)(Wb + W_CO); g.M = Mact; g.N = DM; g.K = DM; E.O = Yb; E.ldc = DM; }
                else { g.A = HID; g.Bt = (const bf16*)(Wb + W_FO) + (size_t)li * DM * FFH; g.M = Mact; g.N = DM; g.K = FFH; E.O = Yb; E.ldc = DM; }
                pg8::StaticOrder S; S.init(g.M, g.N, G, bx);
                pg8::gemm_phase<pg8::EpiBf16<0>, pg8::StaticOrder, true, true>((PG8_LAS unsigned char*)lds, g, S, E);
            }
            else if (ON(4) && op == 0) {
                pg8::Gemm g{Hb, (const bf16*)(Wb + W_BI), MTOT, 2048, DM}; pg8::StaticOrder S; S.init(MTOT, 2048, G, bx);
                pg8::EpiBf16<1> E{QKV, 2048, args.in[13], 0, 0, 1.f, EPI_SKIP_ON_REP ? rep : 0}; pg8::gemm_phase<pg8::EpiBf16<1>, pg8::StaticOrder, true, true>((PG8_LAS unsigned char*)lds, g, S, E);
            }
            else if (ON(5) && op == 5) {
                pg8::Gemm g{Hb, (const bf16*)(Wb + W_FI) + (size_t)li * 2 * FFH * DM, Mact, 2 * FFH, DM}; pg8::StaticOrder S; S.init(Mact, 2 * FFH, G, bx);
                pg8::EpiSwiglu E{HID, FFH}; pg8::gemm_phase<pg8::EpiSwiglu, pg8::StaticOrder, true, true>((PG8_LAS unsigned char*)lds, g, S, E);
            }
            else if (ON(6) && op == 1) {
                if (kind == 0) {
                    for (int m = gw; m < MLAT; m += NGW) { const int t = m & 2047; bf16* kp = QKV + (size_t)m * 1536 + 1024 + (lane >> 4) * 64 + (lane & 15) * 2;
                        const unsigned w1 = *(const unsigned*)kp, w2 = *(const unsigned*)(kp + 32);
                        const f32x2 c = *(const f32x2*)(cosA + t * 32 + (lane & 15) * 2), s = *(const f32x2*)(sinA + t * 32 + (lane & 15) * 2);
                        const float a0 = bflo(w1), a1 = bfhi(w1), b0 = bflo(w2), b1 = bfhi(w2);
                        *(unsigned*)kp = cvtpk(a0 * c.x - b0 * s.x, a1 * c.y - b1 * s.y); *(unsigned*)(kp + 32) = cvtpk(b0 * c.x + a0 * s.x, b1 * c.y + a1 * s.y); }
                } else {
                    const float* kg = args.in[22];
                    for (int m = gw; m < MTOT; m += NGW) { bf16* kp = QKV + (size_t)m * 2048 + 1024 + (lane >> 4) * 128 + (lane & 15) * 4; const int i0 = (lane & 15) * 4;
                        const u32x2 w1 = *(const u32x2*)kp, w2 = *(const u32x2*)(kp + 64);
                        float a[4] = {bflo(w1.x), bfhi(w1.x), bflo(w1.y), bfhi(w1.y)}, b[4] = {bflo(w2.x), bfhi(w2.x), bflo(w2.y), bfhi(w2.y)};
                        float ss = 0.f;
#pragma unroll
                        for (int j = 0; j < 4; ++j) ss += a[j] * a[j] + b[j] * b[j];
                        ss += __shfl_xor(ss, 1); ss += __shfl_xor(ss, 2); ss += __shfl_xor(ss, 4); ss += __shfl_xor(ss, 8);
                        const float rstd = rsqrtf(ss * (1.0f / 128.0f) + 1e-6f);
                        const f32x4 g1 = *(const f32x4*)(kg + i0), g2 = *(const f32x4*)(kg + 64 + i0);
#pragma unroll
                        for (int j = 0; j < 4; ++j) { a[j] *= rstd * g1[j]; b[j] *= rstd * g2[j]; }
                        if (m < MLAT) { const int t = m & 2047; const f32x4 c = *(const f32x4*)(cosC + t * 64 + i0), s = *(const f32x4*)(sinC + t * 64 + i0);
#pragma unroll
                            for (int j = 0; j < 4; ++j) { const float x1 = a[j], x2 = b[j]; a[j] = x1 * c[j] - x2 * s[j]; b[j] = x2 * c[j] + x1 * s[j]; } }
                        u32x2 o1, o2; o1.x = cvtpk(a[0], a[1]); o1.y = cvtpk(a[2], a[3]); o2.x = cvtpk(b[0], b[1]); o2.y = cvtpk(b[2], b[3]);
                        *(u32x2*)kp = o1; *(u32x2*)(kp + 64) = o2; }
                }

            }
            else if (ON(7) && op == 2 && kind != 1) {
                if (kind == 0) {
                    const float* sink = args.in[11] + ja * 16;
                    const int nlat = 4096, ntot = nlat + (ctx_out ? 512 : 0);
                    for (int u = bx; u < ntot; u += G) {
                        att::UnitDesc d; d.nctx = 4; d.cosT = cosA; d.sinT = sinA; d.qg = nullptr;
                        int b, h;
                        if (u < nlat) { const int x = u & 7, j = (u >> 3) & 31, gi = (u >> 8) * 8 + x; b = gi >> 2; const int kvh = gi & 3; h = kvh * 4 + (j >> 3); const int q0 = (j & 7) * 256;
                            d.Q = QKV + ((size_t)b * SEQ + q0) * 1536 + h * 64; d.O = Ob + ((size_t)b * SEQ + q0) * DM + h * 64; d.qpos0 = q0;
                            const int klo = q0 - 128 < 0 ? 0 : q0 - 128, khi = q0 + 384 > SEQ ? SEQ : q0 + 384; d.band_kp0 = klo; d.NT = 4 + (khi - klo) / 64; }
                        else { const int cu = u - nlat; b = cu >> 4; h = cu & 15;
                            d.Q = QKV + ((size_t)MLAT + b * CTXL) * 1536 + h * 64; d.O = Ob + ((size_t)MLAT + b * CTXL) * DM + h * 64; d.qpos0 = -1; d.band_kp0 = 0; d.NT = 4; }
                        d.Kc = QKV + 1024 + (h >> 2) * 64; d.Vc = QKV + 1280 + (h >> 2) * 64; d.ctx_row0 = MLAT + b * CTXL; d.lat_row0 = (long)b * SEQ;
                        d.sink_l2 = sink[h] * 1.4426950408889634f;
                        att::attn_unit<64, 1536, false, true>(d, (char*)lds);
                    }
                } else {
                    const int nlat = 2048, ntot = nlat + (ctx_out ? 256 : 0);
                    for (int u = bx; u < ntot; u += G) {
                        att::UnitDesc d; d.nctx = 4; d.cosT = cosC; d.sinT = sinC; d.qg = args.in[21]; d.band_kp0 = 0;
                        int b, h;
                        if (u < nlat) { const int x = u & 7, j = (u >> 3) & 31, gi = ((u >> 8) * 8 + x) * 2 + (j >> 4); b = gi >> 2; const int kvh = gi & 3; h = kvh * 2 + ((j & 15) >> 3); const int q0 = (j & 7) * 256;
                            d.Q = QKV + ((size_t)b * SEQ + q0) * 2048 + h * 128; d.O = Ob + ((size_t)b * SEQ + q0) * DM + h * 128; d.qpos0 = q0; d.NT = 36; }
                        else { const int cu = u - nlat; b = cu >> 3; h = cu & 7;
                            d.Q = QKV + ((size_t)MLAT + b * CTXL) * 2048 + h * 128; d.O = Ob + ((size_t)MLAT + b * CTXL) * DM + h * 128; d.qpos0 = -1; d.NT = 4; }
                        d.Kc = QKV + 1024 + (h >> 1) * 128; d.Vc = QKV + 1536 + (h >> 1) * 128; d.ctx_row0 = MLAT + b * CTXL; d.lat_row0 = (long)b * SEQ;
                        d.sink_l2 = -INFINITY;
                        att::attn_unit<128, 2048, true, false>(d, (char*)lds);
                    }
                }

            }
            else if (ON(8) && op == 2) {
                constexpr int TB = 16384;
                char* V_lds = (char*)lds; f32x2* stat = (f32x2*)((char*)lds + 2 * TB);
                const float* lng = args.in[14]; const float* lnb = args.in[15]; const float* bsb = args.in[17];
                const int r32 = lane & 31, hh = lane >> 5, rb = wave & 3, chh = wave >> 2;
                const int sr = tid >> 4, sc = (tid & 15) * 8;
                const int vb0 = (int)(uintptr_t)V_lds + att::v_rd_base(lane);
                for (int u = bx; u < (MTOT / 128) * 2; u += G) {
                    const int chunk = u >> 1, gh = u & 1; const size_t row0 = (size_t)chunk * 128;
                    for (int rr = 0; rr < 16; ++rr) { const bf16* vp = QKV + (row0 + wave * 16 + rr) * 2048 + 1024 + lane * 16;
                        const bf16x8 v0 = *(const bf16x8*)vp, v1 = *(const bf16x8*)(vp + 8); float f[16];
#pragma unroll
                        for (int j = 0; j < 8; ++j) { f[j] = bf2f(v0[j]); f[8 + j] = bf2f(v1[j]); }
                        float s = 0.f;
#pragma unroll
                        for (int j = 0; j < 16; ++j) s += f[j];
                        const float mean = wave_sum(s) * (1.0f / 1024.0f); float q = 0.f;
#pragma unroll
                        for (int j = 0; j < 16; ++j) { const float dd = f[j] - mean; q += dd * dd; }
                        const float rstd = rsqrtf(wave_sum(q) * (1.0f / 1024.0f) + 1e-5f);
                        if (lane == 0) stat[wave * 16 + rr] = (f32x2){mean, rstd}; }
                    __syncthreads();
                    for (int gi = 0; gi < 4; ++gi) {
                        const int g = gh * 4 + gi;
                        const f32x4 lg0 = *(const f32x4*)(lng + g * 128 + sc), lg1 = *(const f32x4*)(lng + g * 128 + sc + 4), lb0 = *(const f32x4*)(lnb + g * 128 + sc), lb1 = *(const f32x4*)(lnb + g * 128 + sc + 4);
#pragma unroll
                        for (int l = 0; l < 4; ++l) { const int rl = sr + 32 * l; const bf16x8 raw = *(const bf16x8*)(QKV + (row0 + rl) * 2048 + 1024 + g * 128 + sc);
                            const f32x2 st = stat[rl]; float f[8];
#pragma unroll
                            for (int j = 0; j < 8; ++j) f[j] = (bf2f(raw[j]) - st.x) * st.y * (j < 4 ? lg0[j & 3] : lg1[j & 3]) + (j < 4 ? lb0[j & 3] : lb1[j & 3]);
                            u32x4 w = {cvtpk(f[0], f[1]), cvtpk(f[2], f[3]), cvtpk(f[4], f[5]), cvtpk(f[6], f[7])};
                            *(u32x4*)(V_lds + (l >> 1) * TB + att::v_st<128>(sr + 32 * (l & 1), sc)) = w; }
                        bf16x8 pa[2][4];
#pragma unroll
                        for (int T = 0; T < 2; ++T)
#pragma unroll
                            for (int ks = 0; ks < 4; ++ks) pa[T][ks] = *(const bf16x8*)(Wsb + (size_t)g * 16384 + (32 * rb + r32) * 128 + 64 * T + 16 * ks + 8 * hh);
                        __syncthreads();
                        f32x16 o[2]; o[0] = f32x16{}; o[1] = f32x16{};
                        if (chh == 0) {
                            att::pv_one<128, 0>(o[0], vb0, pa[0][0], pa[0][1], pa[0][2], pa[0][3]); att::pv_one<128, 1>(o[1], vb0, pa[0][0], pa[0][1], pa[0][2], pa[0][3]);
                            att::pv_one<128, 0>(o[0], vb0 + TB, pa[1][0], pa[1][1], pa[1][2], pa[1][3]); att::pv_one<128, 1>(o[1], vb0 + TB, pa[1][0], pa[1][1], pa[1][2], pa[1][3]);
                        } else {
                            att::pv_one<128, 2>(o[0], vb0, pa[0][0], pa[0][1], pa[0][2], pa[0][3]); att::pv_one<128, 3>(o[1], vb0, pa[0][0], pa[0][1], pa[0][2], pa[0][3]);
                            att::pv_one<128, 2>(o[0], vb0 + TB, pa[1][0], pa[1][1], pa[1][2], pa[1][3]); att::pv_one<128, 3>(o[1], vb0 + TB, pa[1][0], pa[1][1], pa[1][2], pa[1][3]);
                        }
                        { bf16* stg = (bf16*)((char*)lds + 2 * TB + 1024) + wave * 2048;
#pragma unroll
                          for (int r = 0; r < 16; ++r) { const int pr = att::crow(r, hh); const float bias = bsb[g * 128 + 32 * rb + pr];
#pragma unroll
                            for (int d = 0; d < 2; ++d) { const float v = o[d][r] + bias; stg[pr * 64 + d * 32 + r32] = (bf16)(cvtpk(v, v) & 0xffffu); } }
                          asm volatile("s_waitcnt lgkmcnt(0)" ::: "memory");
#pragma unroll
                          for (int i = 0; i < 4; ++i) { const int row = i * 8 + (lane >> 3), ch = lane & 7; const bf16x8 mv = *(const bf16x8*)(stg + row * 64 + ch * 8);
                            const size_t gr = row0 + 32 * rb + row; const int col = g * 128 + 64 * chh + ch * 8;
                            const bf16x8 uv = *(const bf16x8*)(QKV + gr * 2048 + col); float f[8];
#pragma unroll
                            for (int e = 0; e < 8; ++e) f[e] = bf2f(uv[e]) * bf2f(mv[e]);
                            u32x4 w = {cvtpk(f[0], f[1]), cvtpk(f[2], f[3]), cvtpk(f[4], f[5]), cvtpk(f[6], f[7])};
                            *(u32x4*)(Ob + gr * DM + col) = w; } }
                        __syncthreads();
                    }
                }

            }
            else if (ON(9) && op == 4) {
                { const int rpw = (Mact + NGW - 1) / NGW, mb = gw * rpw, me = mb + rpw < Mact ? mb + rpw : Mact; const float* ml = mods + (size_t)li * NMODROW * MODW; const bool first = li == 0 && !rep;
                  combine_span<true, true>(mb, me, first ? x_in : XL, first ? ctx_in : XC, XL, XC, Yb, Hb, ml + 2 * DM, ng + DM, ml + 3 * DM, ml + 4 * DM, ng + 2 * DM, lane, rep ? 0.0f : 1.0f); }
            }
            else if (ON(10) && op == 7) {
                const bool last = li == DEPTH - 1;
                { const int rpw = (Mact + NGW - 1) / NGW, mb = gw * rpw, me = mb + rpw < Mact ? mb + rpw : Mact; const float* ml = mods + (size_t)li * NMODROW * MODW; const float* mn = ml + (size_t)NMODROW * MODW;
                  if (last) combine_span<true, false>(mb, me, XL, XC, XL, XC, Yb, Hb, ml + 5 * DM, ng + 3 * DM, nullptr, nullptr, nullptr, lane, rep ? 0.0f : 1.0f);
                  else combine_span<true, true>(mb, me, XL, XC, XL, XC, Yb, Hb, ml + 5 * DM, ng + 3 * DM, mn, mn + DM, ng + 4 * DM, lane, rep ? 0.0f : 1.0f); }
            }
        }
        if (!noop && step + 1 < 3 + 8 * DEPTH) { if (RUN(ph) && RUN(ph + 1)) GSYNC(); }
#ifdef REP_MASK
        if (((REP_MASK >> (step - 3)) & 1) && rep == 0) { rep = 1; continue; }
        rep = 0;
#endif
        ++step; ++ph;
    }
#undef RUN
#undef SEAM
}

#ifndef MK_MULTI
#define MK_MULTI 0
#endif
extern "C" void kernel_launch(void* const* d_in, const int* in_sizes, int n_in, void* d_out, int out_size, void* d_ws, size_t ws_size, hipStream_t stream) {
    static int grid = 0;
    if (grid == 0) {
        if (n_in != 23 || ws_size < WS_END) { fprintf(stderr, "kernel_launch: unexpected n_in %d / ws_size %zu (need %zu)\n", n_in, ws_size, (size_t)WS_END); grid = -1; return; }
        int dev = 0, cus = 0, per_cu = 0;
        hipGetDevice(&dev); hipDeviceGetAttribute(&cus, hipDeviceAttributeMultiprocessorCount, dev);
        if (hipFuncSetAttribute((const void*)mega, hipFuncAttributeMaxDynamicSharedMemorySize, LDS_BYTES) != hipSuccess) { fprintf(stderr, "kernel_launch: hipFuncSetAttribute failed\n"); grid = -1; return; }
        if (hipOccupancyMaxActiveBlocksPerMultiprocessor(&per_cu, (const void*)mega, 512, LDS_BYTES) != hipSuccess || per_cu < 1) { fprintf(stderr, "kernel_launch: occupancy query says %d\n", per_cu); per_cu = 1; }
        (void)hipGetLastError();
        grid = cus * per_cu;
        fprintf(stderr, "kernel_launch: grid %d (cus %d x %d)\n", grid, cus, per_cu);
    }
    if (grid < 0) return;
    if (hipMemsetAsync((char*)d_ws + OFF_CTL, 0, CTL_BYTES, stream) != hipSuccess) { fprintf(stderr, "kernel_launch: memset failed\n"); return; }
    Args a{};
    for (int i = 0; i < 23; ++i) a.in[i] = (const float*)d_in[i];
    a.out = (float*)d_out; a.ws = (unsigned char*)d_ws;
#if MK_MULTI
    const int nph = 3 + 8 * DEPTH;
    for (int p = 0; p < nph; ++p) { a.ph_lo = p; a.ph_hi = p + 1; hipLaunchKernelGGL(mega, dim3(grid), dim3(512), LDS_BYTES, stream, a); }
#else
    a.ph_lo = 0; a.ph_hi = 1000;
    void* params[] = {&a};
    hipError_t e = hipLaunchCooperativeKernel((const void*)mega, dim3(grid), dim3(512), params, LDS_BYTES, stream);
    if (e != hipSuccess) fprintf(stderr, "kernel_launch: cooperative launch failed: %s (grid %d)\n", hipGetErrorString(e), grid);
#endif
}
```

```cpp
#define XBF16 1
#include <hip/hip_runtime.h>
#include <hip/hip_cooperative_groups.h>
#include <cstdio>
#include <cstdint>
namespace cg = cooperative_groups;
namespace pg8 {
#define PG8_LAS __attribute__((address_space(3)))
typedef unsigned short bf16_t;
typedef short bf16x8 __attribute__((ext_vector_type(8)));
typedef float f32x4 __attribute__((ext_vector_type(4)));
typedef unsigned u32x4 __attribute__((ext_vector_type(4)));
constexpr int BM = 256, BK = 64, HALF = 128, HTB = HALF * BK * 2  , STAGE_BYTES = 8 * HTB, NXCD = 8, WGM = 8;

__host__ __device__ __forceinline__ int lds_byte(int r, int c) { const int st = (r >> 4) * 2 + (c >> 5), rr = r & 15, cc = c & 31, ob = rr * 64 + cc * 2; return st * 1024 + (ob ^ (((ob >> 9) & 1) << 5)); }
__host__ __device__ __forceinline__ void stage_rc(int b, int& R, int& C) { const int st = b / 1024, sb = b % 1024, swz = sb ^ (((sb >> 9) & 1) << 5); R = (st >> 1) * 16 + swz / 64; C = (st & 1) * 32 + (swz % 64) / 2; }
__host__ __device__ __forceinline__ int perm32(int rho) { const int n = rho >> 4, i = rho & 15; return 8 * (i >> 2) + 4 * n + (i & 3); }

struct Unit { int pm, pn; };
struct Gemm { const bf16_t* A; const bf16_t* Bt; int M, N, K; };

struct StaticOrder {
    int nM, nN, nwg, G, c;
    __host__ __device__ void init(int M, int N, int G_, int c_) { nM = M / BM; nN = N / BM; nwg = nM * nN; G = G_; c = c_; }
    __host__ __device__ bool next(int i, Unit& u) const {
        const long L = (long)i * G + c; if (L >= nwg) return false;
        int wgid = (int)L; { const int q = nwg / NXCD, r = nwg % NXCD, xcd = wgid % NXCD, off = wgid / NXCD; wgid = (xcd < r ? xcd * (q + 1) : r * (q + 1) + (xcd - r) * q) + off; }
        const int nig = WGM * nN, gid = wgid / nig, fm = gid * WGM, gsz = (nM - fm) < WGM ? (nM - fm) : WGM;
        u.pm = fm + ((wgid % nig) % gsz); u.pn = (wgid % nig) / gsz; return true;
    }
    __device__ __forceinline__ void a_ready(const Unit&) const {}
    __device__ __forceinline__ void done(const Unit&) const {}
};

__device__ __forceinline__ unsigned cvt_pk_bf16(float lo, float hi) { unsigned r; asm volatile("v_cvt_pk_bf16_f32 %0, %1, %2" : "=v"(r) : "v"(lo), "v"(hi)); return r; }
typedef float f32x2 __attribute__((ext_vector_type(2)));
__device__ __forceinline__ f32x2 gelu_pk(f32x2 v) {
    const f32x2 av = __builtin_elementwise_abs(v), d = av * 0.2316418882f + 1.0f;
    f32x2 t; t.x = __builtin_amdgcn_rcpf(d.x); t.y = __builtin_amdgcn_rcpf(d.y);
    f32x2 q = t * 0.5307027145f + (-0.7265760135f); q = q * t + 0.7107068705f; q = q * t + (-0.142248368f); q = q * t + 0.127414796f; q = q * t;
    const f32x2 s = (v * v) * (-0.72134752044f);
    f32x2 e; e.x = __builtin_amdgcn_exp2f(s.x); e.y = __builtin_amdgcn_exp2f(s.y);
    const f32x2 m = v * (q * e), r = v - m;
    f32x2 o; o.x = v.x < 0.f ? m.x : r.x; o.y = v.y < 0.f ? m.y : r.y; return o;
}

#ifndef PG8_STMODE
#define PG8_STMODE 0
#endif
#if PG8_STMODE == 1
#define PG8_ST16(p, v) asm volatile("global_store_dwordx4 %0, %1, off sc1\n\ts_nop 1" :: "v"(p), "v"(v) : "memory")
#elif PG8_STMODE == 2
#define PG8_ST16(p, v) asm volatile("global_store_dwordx4 %0, %1, off nt\n\ts_nop 1" :: "v"(p), "v"(v) : "memory")
#elif PG8_STMODE == 4
#define PG8_ST16(p, v) asm volatile("global_store_dwordx4 %0, %1, off\n\ts_nop 1" :: "v"(p), "v"(v) : "memory")
#elif PG8_STMODE == 3
#define PG8_ST16(p, v) asm volatile("global_store_dwordx4 %0, %1, off sc0 sc1\n\ts_nop 1" :: "v"(p), "v"(v) : "memory")
#else
#define PG8_ST16(p, v) (*(u32x4*)(p) = (v))
#endif
template <int ACT  > struct EpiBf16 {
    static constexpr bool PERM = true, AFTER_DRAIN = false; static_assert(ACT == 0 || ACT == 1, "EpiBf16: ACT is 0 (none) or 1 (gelu_pk)");
    bf16_t* O; int ldc; const float* bias; int split_cols; size_t split_stride; float scale0; int skip;
    __device__ __forceinline__ void operator()(const f32x4 (&acc)[2][2][4][2], const Unit& u, int wr, int wc, int fr, int fq) const {
        if (skip) return;
        const int row0 = u.pm * BM + wr * 64 + fr; int colt = u.pn * BM; bf16_t* base = O;
        float sc = 1.f; if (split_cols) { const int t = colt / split_cols; base += (size_t)t * split_stride; colt -= t * split_cols; if (t == 0) sc = scale0; }
        const int col0 = colt + wc * 32 + 8 * fq, bcol0 = u.pn * BM + wc * 32 + 8 * fq;
        f32x4 bv[2][2];
#pragma unroll
        for (int bj = 0; bj < 2; ++bj)
#pragma unroll
            for (int n = 0; n < 2; ++n) bv[bj][n] = bias ? *(const f32x4*)(bias + bcol0 + bj * HALF + 4 * n) : (f32x4){0.f, 0.f, 0.f, 0.f};
#pragma unroll
        for (int ai = 0; ai < 2; ++ai)
#pragma unroll
            for (int m = 0; m < 4; ++m) { bf16_t* rowp = base + (size_t)(row0 + ai * HALF + m * 16) * ldc + col0;
#pragma unroll
                for (int bj = 0; bj < 2; ++bj) { f32x4 v0 = acc[ai][bj][m][0] + bv[bj][0], v1 = acc[ai][bj][m][1] + bv[bj][1];
                    if (ACT == 1) { f32x2 a = gelu_pk((f32x2){v0[0], v0[1]}), b = gelu_pk((f32x2){v0[2], v0[3]}), c = gelu_pk((f32x2){v1[0], v1[1]}), d = gelu_pk((f32x2){v1[2], v1[3]});
                        v0 = (f32x4){a.x, a.y, b.x, b.y}; v1 = (f32x4){c.x, c.y, d.x, d.y}; }
                    v0 = v0 * sc; v1 = v1 * sc; u32x4 w; w.x = cvt_pk_bf16(v0[0], v0[1]); w.y = cvt_pk_bf16(v0[2], v0[3]); w.z = cvt_pk_bf16(v1[0], v1[1]); w.w = cvt_pk_bf16(v1[2], v1[3]);
                    PG8_ST16(rowp + bj * HALF, w); } }
    }
};
template <class Epi, class Sched, bool ALIGN_EPI = false, bool SP2 = false>
__device__ __forceinline__ void gemm_phase(PG8_LAS unsigned char* lds, const Gemm g, const Sched& S, const Epi& E) {
    int tid = threadIdx.x; asm volatile("" : "+v"(tid));
    const int wid = __builtin_amdgcn_readfirstlane(tid >> 6), lane = tid & 63, wr = wid >> 2, wc = wid & 3, fr = lane & 15, fq = lane >> 4;
    const int K = g.K, nt = K / BK;
    unsigned voffA[2], voffB[2];
#pragma unroll
    for (int i = 0; i < 2; ++i) { int R, C; stage_rc(tid * 16 + i * 8192, R, C); const int Rb = Epi::PERM ? ((R & ~31) + perm32(R & 31)) : R;
        voffA[i] = (unsigned)(R * K + C) * 2u; voffB[i] = (unsigned)(Rb * K + C) * 2u; }
    const size_t kstep = (size_t)(BK * 2);
    const size_t hstep = (size_t)HALF * K * 2;
    const size_t tstep = 2 * hstep;
    const unsigned ldsw = (unsigned)wid * 1024u;
    const int aoff = lds_byte(wr * 64 + fr, fq * 8), boff = lds_byte(wc * 32 + fr, fq * 8);
#define PG8_SA(b, h) (((b) * 2 + (h)) * HTB)
#define PG8_SB(b, h) ((4 + (b) * 2 + (h)) * HTB)
#define PG8_STAGE(bufoff, gbase, voff) do { _Pragma("unroll") for (int _i = 0; _i < 2; ++_i) \
        __builtin_amdgcn_global_load_lds((const unsigned*)((const char*)(gbase) + (voff)[_i]), (PG8_LAS unsigned*)(lds + (bufoff) + ldsw + _i * 8192), 16, 0, 0); } while (0)
#define PG8_LDA(dst, b, h) do { _Pragma("unroll") for (int m = 0; m < 4; ++m) _Pragma("unroll") for (int k = 0; k < 2; ++k) dst[m][k] = *(const PG8_LAS bf16x8*)(lds + PG8_SA(b, h) + aoff + m * 2048 + k * 1024); } while (0)
#define PG8_LDB(dst, b, h) do { _Pragma("unroll") for (int n = 0; n < 2; ++n) _Pragma("unroll") for (int k = 0; k < 2; ++k) dst[n][k] = *(const PG8_LAS bf16x8*)(lds + PG8_SB(b, h) + boff + n * 2048 + k * 1024); } while (0)
#define PG8_MMA(ai, bj, At, Bt) do { __builtin_amdgcn_s_setprio(1); _Pragma("unroll") for (int m = 0; m < 4; ++m) _Pragma("unroll") for (int n = 0; n < 2; ++n) _Pragma("unroll") for (int k = 0; k < 2; ++k) \
        acc[ai][bj][m][n] = __builtin_amdgcn_mfma_f32_16x16x32_bf16(Bt[n][k], At[m][k], acc[ai][bj][m][n], 0, 0, 0); __builtin_amdgcn_s_setprio(0); } while (0)
#define PG8_WAIT_V(n) asm volatile("s_waitcnt vmcnt(" #n ")" ::: "memory")
#define PG8_WAIT_L(n) asm volatile("s_waitcnt lgkmcnt(" #n ")" ::: "memory")
#define PG8_BAR __builtin_amdgcn_s_barrier()
#define PG8_SCHED __builtin_amdgcn_sched_barrier(0)
    Unit cur, nxt; int ui = 0;
    if (!S.next(0, cur)) return;
    f32x4 acc[2][2][4][2];
#pragma unroll
    for (int a = 0; a < 2; ++a)
#pragma unroll
        for (int b = 0; b < 2; ++b)
#pragma unroll
            for (int m = 0; m < 4; ++m)
#pragma unroll
                for (int n = 0; n < 2; ++n) acc[a][b][m][n] = (f32x4){0.f, 0.f, 0.f, 0.f};
    bf16x8 At[4][2], B0[2][2], B1[2][2];
    const char* cA = (const char*)g.A + (size_t)cur.pm * tstep; const char* cB = (const char*)g.Bt + (size_t)cur.pn * tstep;
    S.a_ready(cur);
    if constexpr (SP2) {
        PG8_STAGE(PG8_SB(0, 0), cB, voffB); PG8_STAGE(PG8_SB(0, 1), cB + hstep, voffB); PG8_STAGE(PG8_SA(0, 0), cA, voffA); PG8_STAGE(PG8_SA(0, 1), cA + hstep, voffA);
        if (wr == 1) PG8_BAR;
        PG8_WAIT_V(2); PG8_BAR;
        PG8_STAGE(PG8_SB(1, 0), cB + kstep, voffB); PG8_STAGE(PG8_SA(1, 0), cA + kstep, voffA); PG8_STAGE(PG8_SB(1, 1), cB + hstep + kstep, voffB);
        PG8_WAIT_V(6); PG8_BAR;
    } else {
        PG8_STAGE(PG8_SB(0, 0), cB, voffB); PG8_STAGE(PG8_SA(0, 0), cA, voffA); PG8_STAGE(PG8_SB(0, 1), cB + hstep, voffB); PG8_STAGE(PG8_SA(0, 1), cA + hstep, voffA);
        if (wr == 1) PG8_BAR;
        PG8_WAIT_V(4); PG8_BAR;
        PG8_STAGE(PG8_SB(1, 0), cB + kstep, voffB); PG8_STAGE(PG8_SA(1, 0), cA + kstep, voffA); PG8_STAGE(PG8_SB(1, 1), cB + hstep + kstep, voffB);
        PG8_WAIT_V(6); PG8_BAR;
    }
    for (;;) {
        const bool has_next = S.next(ui + 1, nxt);
        const char* nA = has_next ? (const char*)g.A + (size_t)nxt.pm * tstep : cA; const char* nB = has_next ? (const char*)g.Bt + (size_t)nxt.pn * tstep : cB;
        for (int t = 0; t < nt; t += 2) {
            const bool last = (t == nt - 2);
            const char* a1 = cA + (size_t)(t + 1) * kstep;
            const char* a2 = last ? nA : cA + (size_t)(t + 2) * kstep; const char* b2 = last ? nB : cB + (size_t)(t + 2) * kstep;
            const char* a3 = a2 + kstep; const char* b3 = b2 + kstep;
            if (last && has_next) S.a_ready(nxt);
            if constexpr (SP2) {
            PG8_LDB(B0, 0, 0); PG8_LDB(B1, 0, 1); PG8_SCHED; PG8_LDA(At, 0, 0); PG8_STAGE(PG8_SA(1, 1), a1 + hstep, voffA);
            PG8_WAIT_V(8); PG8_WAIT_L(0); PG8_BAR; PG8_MMA(0, 0, At, B0); PG8_MMA(0, 1, At, B1); PG8_BAR; PG8_SCHED;
            PG8_LDA(At, 0, 1); PG8_STAGE(PG8_SB(0, 0), b2, voffB); PG8_STAGE(PG8_SB(0, 1), b2 + hstep, voffB); PG8_STAGE(PG8_SA(0, 0), a2, voffA);
            PG8_WAIT_V(8); PG8_WAIT_L(0); PG8_BAR; PG8_MMA(1, 0, At, B0); PG8_MMA(1, 1, At, B1); PG8_BAR; PG8_SCHED;
            PG8_LDB(B0, 1, 0); PG8_LDB(B1, 1, 1); PG8_SCHED; PG8_LDA(At, 1, 0); PG8_STAGE(PG8_SA(0, 1), a2 + hstep, voffA);
            PG8_WAIT_V(8); PG8_WAIT_L(0); PG8_BAR; PG8_MMA(0, 0, At, B0); PG8_MMA(0, 1, At, B1); PG8_BAR; PG8_SCHED;
            PG8_LDA(At, 1, 1); PG8_STAGE(PG8_SB(1, 0), b3, voffB); PG8_STAGE(PG8_SB(1, 1), b3 + hstep, voffB); PG8_STAGE(PG8_SA(1, 0), a3, voffA);
            PG8_WAIT_V(8); PG8_WAIT_L(0); PG8_BAR; PG8_MMA(1, 0, At, B0); PG8_MMA(1, 1, At, B1); PG8_BAR; PG8_SCHED;
            } else {
            PG8_LDB(B0, 0, 0); PG8_SCHED; PG8_LDA(At, 0, 0); PG8_STAGE(PG8_SA(1, 1), a1 + hstep, voffA);
            PG8_WAIT_L(8); PG8_BAR; PG8_WAIT_L(0); PG8_MMA(0, 0, At, B0); PG8_BAR; PG8_SCHED;
            PG8_LDB(B1, 0, 1); PG8_STAGE(PG8_SB(0, 0), b2, voffB);
            PG8_BAR; PG8_WAIT_L(0); PG8_MMA(0, 1, At, B1); PG8_BAR;
            PG8_LDA(At, 0, 1); PG8_STAGE(PG8_SA(0, 0), a2, voffA);
            PG8_BAR; PG8_WAIT_L(0); PG8_MMA(1, 0, At, B0); PG8_BAR; PG8_SCHED;
            PG8_STAGE(PG8_SB(0, 1), b2 + hstep, voffB);
            PG8_WAIT_V(6); PG8_BAR; PG8_MMA(1, 1, At, B1); PG8_BAR;
            PG8_LDB(B0, 1, 0); PG8_SCHED; PG8_LDA(At, 1, 0); PG8_STAGE(PG8_SA(0, 1), a2 + hstep, voffA);
            PG8_WAIT_L(8); PG8_BAR; PG8_WAIT_L(0); PG8_MMA(0, 0, At, B0); PG8_BAR; PG8_SCHED;
            PG8_LDB(B1, 1, 1); PG8_STAGE(PG8_SB(1, 0), b3, voffB);
            PG8_BAR; PG8_WAIT_L(0); PG8_MMA(0, 1, At, B1); PG8_BAR;
            PG8_LDA(At, 1, 1); PG8_STAGE(PG8_SA(1, 0), a3, voffA);
            PG8_BAR; PG8_WAIT_L(0); PG8_MMA(1, 0, At, B0); PG8_BAR; PG8_SCHED;
            PG8_STAGE(PG8_SB(1, 1), b3 + hstep, voffB);
            PG8_WAIT_V(6); PG8_BAR; PG8_MMA(1, 1, At, B1); PG8_BAR;
            }
        }
        if constexpr (ALIGN_EPI) { if (wr == 0) PG8_BAR; }
        if constexpr (!Epi::AFTER_DRAIN) { E(acc, cur, wr, wc, fr, fq); S.done(cur); }
        if (!has_next) break;
#pragma unroll
        for (int a = 0; a < 2; ++a)
#pragma unroll
            for (int b = 0; b < 2; ++b)
#pragma unroll
                for (int m = 0; m < 4; ++m)
#pragma unroll
                    for (int n = 0; n < 2; ++n) acc[a][b][m][n] = (f32x4){0.f, 0.f, 0.f, 0.f};
        cur = nxt; cA = nA; cB = nB; ++ui;
        if constexpr (ALIGN_EPI) { if (wr == 1) PG8_BAR; }
    }
    PG8_WAIT_V(0);
    if constexpr (!ALIGN_EPI) { if (wr == 0) PG8_BAR; }
    PG8_BAR;
    if constexpr (Epi::AFTER_DRAIN) { E.fused(acc, cur, wr, wc, fr, fq, lds, wid, lane); S.done(cur); }
#undef PG8_SA
#undef PG8_SB
#undef PG8_STAGE
#undef PG8_LDA
#undef PG8_LDB
#undef PG8_MMA
#undef PG8_WAIT_V
#undef PG8_WAIT_L
#undef PG8_BAR
#undef PG8_SCHED
}
}
namespace pg8 {
struct EpiSwiglu {
    static constexpr bool PERM = true, AFTER_DRAIN = false;
    bf16_t* O; int ldc;
    __device__ __forceinline__ void operator()(const f32x4 (&acc)[2][2][4][2], const Unit& u, int wr, int wc, int fr, int fq) const {
        const int row0 = u.pm * BM + wr * 64 + fr; const int col0 = u.pn * HALF + wc * 32 + 8 * fq;
#pragma unroll
        for (int ai = 0; ai < 2; ++ai)
#pragma unroll
            for (int m = 0; m < 4; ++m) { bf16_t* rowp = O + (size_t)(row0 + ai * HALF + m * 16) * ldc + col0;
                float o[8];
#pragma unroll
                for (int n = 0; n < 2; ++n)
#pragma unroll
                    for (int e = 0; e < 4; ++e) { const float g = acc[ai][0][m][n][e], up = acc[ai][1][m][n][e];
                        o[n * 4 + e] = g * __builtin_amdgcn_rcpf(1.0f + __expf(-g)) * up; }
                u32x4 w; w.x = cvt_pk_bf16(o[0], o[1]); w.y = cvt_pk_bf16(o[2], o[3]); w.z = cvt_pk_bf16(o[4], o[5]); w.w = cvt_pk_bf16(o[6], o[7]);
                PG8_ST16(rowp, w); }
    }
};
}

constexpr int DM = 1024, NBATCH = 32, SEQ = 2048, CTXL = 256, MLAT = NBATCH * SEQ, MCTX = NBATCH * CTXL, MTOT = MLAT + MCTX, FFH = 2816, DEPTH = 4;
constexpr int NMODROW = 33, MODW = 6 * DM;
constexpr int LDS_BYTES = 147456;
constexpr size_t MiB = 1u << 20;
constexpr size_t OFF_MODP = 0;
constexpr size_t OFF_MODS = 26 * MiB;
constexpr size_t OFF_ROPE = 30 * MiB;
constexpr size_t OFF_WS = 32 * MiB;
constexpr size_t OFF_W = 33 * MiB;
constexpr size_t W_FI = 0, W_FO = 44 * MiB, W_AQ = 66 * MiB, W_AO = 72 * MiB, W_BI = 76 * MiB, W_BO = 80 * MiB, W_CQ = 82 * MiB, W_CO = 86 * MiB;
constexpr size_t OFF_XC = 121 * MiB;
constexpr size_t OFF_H = 153 * MiB;
constexpr size_t OFF_Y = 297 * MiB;
constexpr size_t OFF_BIG = 441 * MiB;
constexpr size_t OFF_O = OFF_BIG + 288 * MiB;
constexpr size_t OFF_CTL = OFF_BIG + 432 * MiB;
constexpr size_t CTL_BYTES = 65536;
constexpr size_t OFF_XLB = OFF_CTL + 1 * MiB;
constexpr size_t WS_END = OFF_XLB + 128 * MiB;
constexpr int LDS_XB = LDS_BYTES - 64;

typedef unsigned short bf16;
typedef short bf16x8 __attribute__((ext_vector_type(8)));
typedef short s16x4 __attribute__((ext_vector_type(4)));
typedef float f32x16 __attribute__((ext_vector_type(16)));
typedef float f32x4 __attribute__((ext_vector_type(4)));
typedef float f32x2 __attribute__((ext_vector_type(2)));
typedef unsigned u32x4 __attribute__((ext_vector_type(4)));
typedef unsigned u32x2 __attribute__((ext_vector_type(2)));
#define LAS __attribute__((address_space(3)))

__device__ __forceinline__ unsigned cvtpk(float lo, float hi) { unsigned r; asm volatile("v_cvt_pk_bf16_f32 %0, %1, %2" : "=v"(r) : "v"(lo), "v"(hi)); return r; }
__device__ __forceinline__ float bf2f(short s) { return __uint_as_float(((unsigned)(unsigned short)s) << 16); }
__device__ __forceinline__ float bflo(unsigned w) { return __uint_as_float(w << 16); }
__device__ __forceinline__ float bfhi(unsigned w) { return __uint_as_float(w & 0xffff0000u); }
__device__ __forceinline__ float wave_sum(float v) {
#pragma unroll
    for (int o = 1; o < 64; o <<= 1) v += __shfl_xor(v, o);
    return v;
}

namespace att {
#define SBAR() __builtin_amdgcn_sched_barrier(0)
__device__ __forceinline__ int crow(int r, int hi) { return (r & 3) + 8 * (r >> 2) + 4 * hi; }
template <int DH> __device__ __forceinline__ int kswz(int row, int colB) { return row * (DH * 2) + (colB ^ ((row & 7) << 4)); }
template <int DH> __device__ __forceinline__ int v_st(int k, int c) { const int kk = (k & ~0xC) | ((k & 4) << 1) | ((k & 8) >> 1); return ((kk >> 3) * (DH / 32) + (c >> 5)) * 512 + ((kk & 7) * 32 + (c & 31)) * 2; }
__device__ __forceinline__ int v_rd_base(int lane) { return ((lane & 3) << 3) | (((lane >> 2) & 3) << 6) | (((lane >> 4) & 1) << 5) | (((lane >> 5) & 1) << 8); }
template <int DH> constexpr int v_rd_off(int d0, int ks, int half) { return d0 * 512 + ks * (DH / 32) * 1024 + half * (DH / 32) * 512; }
template <int OFF> __device__ __forceinline__ s16x4 tr_read(int vb) { s16x4 r; asm volatile("ds_read_b64_tr_b16 %0, %1 offset:%2" : "=&v"(r) : "v"(vb), "i"(OFF) : "memory"); return r; }
template <int DH, int D0> __device__ __forceinline__ void pv_one(f32x16& od, int vb, bf16x8 pa0, bf16x8 pa1, bf16x8 pa2, bf16x8 pa3) {
  const s16x4 l0 = tr_read<v_rd_off<DH>(D0, 0, 0)>(vb), h0 = tr_read<v_rd_off<DH>(D0, 0, 1)>(vb), l1 = tr_read<v_rd_off<DH>(D0, 1, 0)>(vb), h1 = tr_read<v_rd_off<DH>(D0, 1, 1)>(vb);
  const s16x4 l2 = tr_read<v_rd_off<DH>(D0, 2, 0)>(vb), h2 = tr_read<v_rd_off<DH>(D0, 2, 1)>(vb), l3 = tr_read<v_rd_off<DH>(D0, 3, 0)>(vb), h3 = tr_read<v_rd_off<DH>(D0, 3, 1)>(vb);
  asm volatile("s_waitcnt lgkmcnt(0)" ::: "memory"); SBAR();
#define PK(L, H) (bf16x8){L[0], L[1], L[2], L[3], H[0], H[1], H[2], H[3]}
  od = __builtin_amdgcn_mfma_f32_32x32x16_bf16(pa0, PK(l0, h0), od, 0, 0, 0);
  od = __builtin_amdgcn_mfma_f32_32x32x16_bf16(pa1, PK(l1, h1), od, 0, 0, 0);
  od = __builtin_amdgcn_mfma_f32_32x32x16_bf16(pa2, PK(l2, h2), od, 0, 0, 0);
  od = __builtin_amdgcn_mfma_f32_32x32x16_bf16(pa3, PK(l3, h3), od, 0, 0, 0);
#undef PK
}
template <int DH> __device__ __forceinline__ void pv_all(f32x16* o, int vb, bf16x8 pa0, bf16x8 pa1, bf16x8 pa2, bf16x8 pa3) {
  pv_one<DH, 0>(o[0], vb, pa0, pa1, pa2, pa3); pv_one<DH, 1>(o[1], vb, pa0, pa1, pa2, pa3);
  if constexpr (DH == 128) { pv_one<DH, 2>(o[2], vb, pa0, pa1, pa2, pa3); pv_one<DH, 3>(o[3], vb, pa0, pa1, pa2, pa3); }
}
template <int DH> struct SC { static constexpr float SCALE = DH == 128 ? 0.088388347648318440f : 0.125f; static constexpr float C = SCALE * 1.4426950408889634f; static constexpr float THRS = 8.f / SCALE; };
template <int DH> __device__ __forceinline__ void partialSM(f32x16& p0, f32x16& p1, float& m_reg, float& mn, float& alpha) {
  constexpr float C = SC<DH>::C;
  float pmax = p0[0];
#pragma unroll
  for (int r = 1; r < 16; ++r) pmax = fmaxf(pmax, p0[r]);
#pragma unroll
  for (int r = 0; r < 16; ++r) pmax = fmaxf(pmax, p1[r]);
  { auto rr = __builtin_amdgcn_permlane32_swap(__float_as_uint(pmax), __float_as_uint(pmax), false, false);
    pmax = fmaxf(__uint_as_float(rr[0]), __uint_as_float(rr[1])); }
  if (__builtin_expect(__all(pmax - m_reg <= SC<DH>::THRS), 1)) { mn = m_reg; alpha = 1.f; }
  else { mn = fmaxf(m_reg, pmax); alpha = __builtin_amdgcn_exp2f((m_reg - mn) * C); m_reg = mn; }
  const float mnC = -mn * C;
#pragma unroll
  for (int r = 0; r < 16; ++r) p0[r] = fmaf(p0[r], C, mnC);
#pragma unroll
  for (int r = 0; r < 16; ++r) p1[r] = fmaf(p1[r], C, mnC);
#pragma unroll
  for (int r = 0; r < 16; ++r) p0[r] = __builtin_amdgcn_exp2f(p0[r]);
}
__device__ __forceinline__ void finishSM(f32x16& p0, f32x16& p1, float alpha, float& l_reg, bf16x8& pa0, bf16x8& pa1, bf16x8& pa2, bf16x8& pa3) {
#pragma unroll
  for (int r = 0; r < 16; ++r) p1[r] = __builtin_amdgcn_exp2f(p1[r]);
  float ps = 0;
#pragma unroll
  for (int r = 0; r < 16; ++r) ps += p0[r];
#pragma unroll
  for (int r = 0; r < 16; ++r) ps += p1[r];
  { auto rr = __builtin_amdgcn_permlane32_swap(__float_as_uint(ps), __float_as_uint(ps), false, false);
    ps = __uint_as_float(rr[0]) + __uint_as_float(rr[1]); }
  l_reg = l_reg * alpha + ps;
#define PK4(P, BASE, OUT) do { unsigned a0 = cvtpk(P[BASE + 0], P[BASE + 1]), a1 = cvtpk(P[BASE + 2], P[BASE + 3]);   \
    unsigned b0 = cvtpk(P[BASE + 4], P[BASE + 5]), b1 = cvtpk(P[BASE + 6], P[BASE + 7]);                              \
    auto r0 = __builtin_amdgcn_permlane32_swap(a0, b0, false, false); auto r1 = __builtin_amdgcn_permlane32_swap(a1, b1, false, false); \
    u32x4 w = {r0[0], r1[0], r0[1], r1[1]}; OUT = *reinterpret_cast<bf16x8*>(&w); } while (0)
  PK4(p0, 0, pa0); PK4(p0, 8, pa1); PK4(p1, 0, pa2); PK4(p1, 8, pa3);
#undef PK4
}
template <int DH> __device__ __forceinline__ void qkt(f32x16& p0, f32x16& p1, const char* Ks, const bf16x8* qr, int r32, int hi) {
  p0 = f32x16{}; p1 = f32x16{};
#pragma unroll
  for (int d0 = 0; d0 < DH / 16; ++d0) { const int cb = (d0 * 16 + hi * 8) * 2;
    const bf16x8 b0 = *reinterpret_cast<const bf16x8*>(Ks + kswz<DH>(r32, cb));
    const bf16x8 b1 = *reinterpret_cast<const bf16x8*>(Ks + kswz<DH>(32 + r32, cb));
    p0 = __builtin_amdgcn_mfma_f32_32x32x16_bf16(b0, qr[d0], p0, 0, 0, 0);
    p1 = __builtin_amdgcn_mfma_f32_32x32x16_bf16(b1, qr[d0], p1, 0, 0, 0); }
}
__device__ __forceinline__ void wmask(f32x16& p0, f32x16& p1, int kp0, int qp, int hi) {
  const int d0 = kp0 + 4 * hi - qp;
#pragma unroll
  for (int r = 0; r < 16; ++r) { const int d = d0 + (r & 3) + 8 * (r >> 2); if (d > 128 || d < -128) p0[r] = -1e30f; if (d + 32 > 128 || d + 32 < -128) p1[r] = -1e30f; }
}
struct UnitDesc {
  const bf16* Q; const bf16* Kc; const bf16* Vc; bf16* O;
  long ctx_row0, lat_row0; int nctx, band_kp0, NT, qpos0;
  const float* cosT; const float* sinT; const float* qg; float sink_l2;
};
template <int DH, int PITCH, bool QKNORM, bool MASK>
__device__ __forceinline__ void attn_unit(const UnitDesc& u, char* lds) {
  constexpr int NB = DH / 16, NO = DH / 32, TB = 64 * DH * 2, NLD = DH / 64, SDEPTH = DH == 128 ? 1 : 2;
  int tid = threadIdx.x; asm volatile("" : "+v"(tid));
  const int wid = tid >> 6, lane = tid & 63, r32 = lane & 31, hi = lane >> 5;
  char* V_lds = lds; char* K_lds = lds + 2 * TB;
  float* ws = (float*)(lds + 4 * TB) + wid * 64; float* li_l = ws; float* al_l = ws + 32;
  float m_reg = -1e30f, l_reg = 0; f32x16 o[NO];
#pragma unroll
  for (int d = 0; d < NO; ++d) o[d] = f32x16{};
  bf16x8 qr[NB];
  {
    const bf16* Qw = u.Q + (long)(wid * 32 + r32) * PITCH + hi * 8;
    float qf[NB][8];
#pragma unroll
    for (int d0 = 0; d0 < NB; ++d0) { const bf16x8 raw = *reinterpret_cast<const bf16x8*>(Qw + d0 * 16);
#pragma unroll
      for (int j = 0; j < 8; ++j) qf[d0][j] = bf2f(raw[j]); }
    if constexpr (QKNORM) {
      float ss = 0.f;
#pragma unroll
      for (int d0 = 0; d0 < NB; ++d0)
#pragma unroll
        for (int j = 0; j < 8; ++j) ss += qf[d0][j] * qf[d0][j];
      ss += __shfl_xor(ss, 32);
      const float rstd = rsqrtf(ss * (1.0f / DH) + 1e-6f);
#pragma unroll
      for (int d0 = 0; d0 < NB; ++d0) { const f32x4 g0 = *(const f32x4*)(u.qg + d0 * 16 + hi * 8), g1 = *(const f32x4*)(u.qg + d0 * 16 + hi * 8 + 4);
#pragma unroll
        for (int j = 0; j < 4; ++j) { qf[d0][j] *= rstd * g0[j]; qf[d0][4 + j] *= rstd * g1[j]; } }
    }
    if (u.qpos0 >= 0) {
      const int pos = u.qpos0 + wid * 32 + r32;
      const float* cp = u.cosT + (long)pos * (DH / 2) + hi * 8; const float* sp = u.sinT + (long)pos * (DH / 2) + hi * 8;
#pragma unroll
      for (int d0 = 0; d0 < NB / 2; ++d0) {
        const f32x4 c0 = *(const f32x4*)(cp + d0 * 16), c1 = *(const f32x4*)(cp + d0 * 16 + 4), s0 = *(const f32x4*)(sp + d0 * 16), s1 = *(const f32x4*)(sp + d0 * 16 + 4);
#pragma unroll
        for (int j = 0; j < 8; ++j) { const float c = j < 4 ? c0[j & 3] : c1[j & 3], s = j < 4 ? s0[j & 3] : s1[j & 3];
          const float x1 = qf[d0][j], x2 = qf[d0 + NB / 2][j]; qf[d0][j] = x1 * c - x2 * s; qf[d0 + NB / 2][j] = x2 * c + x1 * s; }
      }
    }
#pragma unroll
    for (int d0 = 0; d0 < NB; ++d0) { u32x4 w = {cvtpk(qf[d0][0], qf[d0][1]), cvtpk(qf[d0][2], qf[d0][3]), cvtpk(qf[d0][4], qf[d0][5]), cvtpk(qf[d0][6], qf[d0][7])}; qr[d0] = *reinterpret_cast<bf16x8*>(&w); }
  }
  const int sr = DH == 128 ? (tid >> 4) : (tid >> 3), sc = DH == 128 ? (tid & 15) * 8 : (tid & 7) * 8;
  const int vb0 = (int)(uintptr_t)V_lds + v_rd_base(lane);
  struct { bf16x8 v[NLD], k[NLD]; } st_[SDEPTH];
  const int qp = u.qpos0 + wid * 32 + r32;
#define TROW(t) ((t) < u.nctx ? u.ctx_row0 + 64 * (t) : u.lat_row0 + u.band_kp0 + 64 * ((t) - u.nctx))
#define TKP(t) (u.band_kp0 + 64 * ((t) - u.nctx))
#define SLOAD(i, t) do { const long row_ = TROW(t); _Pragma("unroll") for (int l_ = 0; l_ < NLD; ++l_) { \
    st_[i].v[l_] = *reinterpret_cast<const bf16x8*>(u.Vc + (row_ + sr + 32 * l_) * PITCH + sc); st_[i].k[l_] = *reinterpret_cast<const bf16x8*>(u.Kc + (row_ + sr + 32 * l_) * PITCH + sc); } } while (0)
#define SWRITE(b, i) do { _Pragma("unroll") for (int l_ = 0; l_ < NLD; ++l_) { *(bf16x8*)(V_lds + (b) * TB + v_st<DH>(sr + 32 * l_, sc)) = st_[i].v[l_]; \
    *(bf16x8*)(K_lds + (b) * TB + kswz<DH>(sr + 32 * l_, sc * 2)) = st_[i].k[l_]; } } while (0)
#define SWAIT() do { if constexpr (SDEPTH == 1) asm volatile("s_waitcnt vmcnt(0)" ::: "memory"); else if constexpr (NLD == 2) asm volatile("s_waitcnt vmcnt(4)" ::: "memory"); else asm volatile("s_waitcnt vmcnt(2)" ::: "memory"); } while (0)
#define RESC(a) do { if (__any((a) < 1.f)) { if (hi == 0) al_l[r32] = (a); asm volatile("s_waitcnt lgkmcnt(0)" ::: "memory"); \
    _Pragma("unroll") for (int d = 0; d < NO; ++d) _Pragma("unroll") for (int r = 0; r < 16; ++r) o[d][r] *= al_l[crow(r, hi)]; } } while (0)
#define AMASK(P0, P1, t) do { if constexpr (MASK) { if ((t) >= u.nctx && (TKP(t) < qw - 97 || TKP(t) + 63 > qw + 128)) wmask(P0, P1, TKP(t), qp, hi); } } while (0)
  f32x16 pA0, pA1, pB0, pB1; float mnA, mnB, alA, alB; bf16x8 pa0, pa1, pa2, pa3; const int NT = u.NT;
  constexpr int SE = 0, SO = SDEPTH - 1;
  const int qw = __builtin_amdgcn_readfirstlane(u.qpos0 + wid * 32);
#define ACT(t) (!MASK || (t) < u.nctx || (TKP(t) <= qw + 159 && TKP(t) + 63 >= qw - 128))
  bool actA = true, actB = true;
  SLOAD(SE, 0); asm volatile("s_waitcnt vmcnt(0)" ::: "memory"); SWRITE(0, SE); __syncthreads();
  qkt<DH>(pA0, pA1, K_lds, qr, r32, hi); AMASK(pA0, pA1, 0); partialSM<DH>(pA0, pA1, m_reg, mnA, alA);
  SLOAD(SO, 1); if constexpr (SDEPTH == 2) { if (2 < NT) SLOAD(SE, 2); }
  SWAIT(); SWRITE(1, SO); __syncthreads();
  for (int j = 1; j + 1 < NT; j += 2) {
    actB = ACT(j);
    SBAR(); if (actB) { qkt<DH>(pB0, pB1, K_lds + TB, qr, r32, hi); AMASK(pB0, pB1, j); }
    if (actA) finishSM(pA0, pA1, alA, l_reg, pa0, pa1, pa2, pa3); SBAR();
    SLOAD(SO, j + SDEPTH); SBAR();
    if (actA) pv_all<DH>(o, vb0, pa0, pa1, pa2, pa3);
    if (actB) partialSM<DH>(pB0, pB1, m_reg, mnB, alB); else alB = 1.f;
    __syncthreads(); SWAIT(); SWRITE(0, SE);
    RESC(alB); __syncthreads();
    actA = ACT(j + 1);
    SBAR(); if (actA) { qkt<DH>(pA0, pA1, K_lds, qr, r32, hi); AMASK(pA0, pA1, j + 1); }
    if (actB) finishSM(pB0, pB1, alB, l_reg, pa0, pa1, pa2, pa3); SBAR();
    if (SDEPTH == 1 || j + 3 < NT) SLOAD(SE, j + 1 + SDEPTH); SBAR();
    if (actB) pv_all<DH>(o, vb0 + TB, pa0, pa1, pa2, pa3);
    if (actA) partialSM<DH>(pA0, pA1, m_reg, mnA, alA); else alA = 1.f;
    __syncthreads(); SWAIT(); SWRITE(1, SO);
    RESC(alA); __syncthreads();
  }
  actB = ACT(NT - 1);
  SBAR(); if (actB) { qkt<DH>(pB0, pB1, K_lds + TB, qr, r32, hi); AMASK(pB0, pB1, NT - 1); }
  if (actA) finishSM(pA0, pA1, alA, l_reg, pa0, pa1, pa2, pa3); SBAR();
  if (actA) pv_all<DH>(o, vb0, pa0, pa1, pa2, pa3);
  if (actB) partialSM<DH>(pB0, pB1, m_reg, mnB, alB); else alB = 1.f;
  __syncthreads(); RESC(alB);
  if (actB) { finishSM(pB0, pB1, alB, l_reg, pa0, pa1, pa2, pa3); SBAR();
    pv_all<DH>(o, vb0 + TB, pa0, pa1, pa2, pa3); }
#undef ACT
  l_reg += __builtin_amdgcn_exp2f(u.sink_l2 - m_reg * SC<DH>::C);
  if (hi == 0) li_l[r32] = l_reg; asm volatile("s_waitcnt lgkmcnt(0)" ::: "memory");
  float rli[16];
#pragma unroll
  for (int r = 0; r < 16; ++r) rli[r] = __builtin_amdgcn_rcpf(li_l[crow(r, hi)]);
  { bf16* stg = (bf16*)(lds + 4 * TB + 2048) + wid * (32 * DH);
#pragma unroll
    for (int r = 0; r < 16; ++r) { const int orow = crow(r, hi);
#pragma unroll
      for (int d0 = 0; d0 < NO; ++d0) { const float v = o[d0][r] * rli[r]; const unsigned w = cvtpk(v, v); stg[orow * DH + d0 * 32 + r32] = (bf16)(w & 0xffffu); } }
    asm volatile("s_waitcnt lgkmcnt(0)" ::: "memory");
    constexpr int CPR = DH / 8, RPI = 64 / CPR;
    bf16* Ow = u.O + (long)(wid * 32) * DM;
#pragma unroll
    for (int i = 0; i < 32 / RPI; ++i) { const int row = i * RPI + lane / CPR, ch = lane % CPR; const u32x4 v = *(const u32x4*)(stg + row * DH + ch * 8); *(u32x4*)(Ow + (long)row * DM + ch * 8) = v; } }
  __syncthreads();
#undef TROW
#undef TKP
#undef SLOAD
#undef SWRITE
#undef SWAIT
#undef RESC
#undef AMASK
}
}

__device__ __forceinline__ void transpose_item(const float* W, int K, int N, bf16* WT, int k0, int n0, int drow0, LAS float* scr, int lane) {
    float tv[32];
#pragma unroll
    for (int i = 0; i < 32; ++i) tv[i] = W[(size_t)(k0 + 2 * i + (lane >> 5)) * N + n0 + (lane & 31)];
#pragma unroll
    for (int i = 0; i < 32; ++i) scr[(2 * i + (lane >> 5)) * 33 + (lane & 31)] = tv[i];
    asm volatile("s_waitcnt lgkmcnt(0)" ::: "memory");
    const int c = lane & 7;
#pragma unroll
    for (int j = 0; j < 4; ++j) { const int n = (lane >> 3) + 8 * j; const LAS float* s = scr + (8 * c) * 33 + n;
        u32x4 o; o.x = cvtpk(s[0 * 33], s[1 * 33]); o.y = cvtpk(s[2 * 33], s[3 * 33]); o.z = cvtpk(s[4 * 33], s[5 * 33]); o.w = cvtpk(s[6 * 33], s[7 * 33]);
        *(u32x4*)(WT + (size_t)(drow0 + n) * K + k0 + 8 * c) = o; }
    asm volatile("s_waitcnt lgkmcnt(0)" ::: "memory");
}
__device__ __forceinline__ int ffn_in_row(int n0) { return n0 < FFH ? 256 * (n0 >> 7) + (n0 & 127) : 256 * ((n0 - FFH) >> 7) + 128 + ((n0 - FFH) & 127); }

struct RowJob { const float* xin; const bf16* y; float* xout; bf16* h; const float* gate; const float* sh; const float* sc; };
template <int NR, bool HASY, bool HASH>
__device__ __forceinline__ void combine_rows(const RowJob (&J)[NR], const float* npost, const float* npre, int lane, float gmul) {
    f32x4 xv[NR][4]; u32x2 yv[NR][4];
#pragma unroll
    for (int q = 0; q < NR; ++q)
#pragma unroll
        for (int j = 0; j < 4; ++j) { xv[q][j] = ((const f32x4*)J[q].xin)[lane + 64 * j]; if constexpr (HASY) yv[q][j] = ((const u32x2*)J[q].y)[lane + 64 * j]; }
    if constexpr (HASY) {
        float rstd[NR];
#pragma unroll
        for (int q = 0; q < NR; ++q) { float ss = 0.f;
#pragma unroll
            for (int j = 0; j < 4; ++j) { const float a = bflo(yv[q][j].x), b = bfhi(yv[q][j].x), c = bflo(yv[q][j].y), d = bfhi(yv[q][j].y); ss += (a * a + b * b) + (c * c + d * d); }
            rstd[q] = rsqrtf(wave_sum(ss) * (1.0f / DM) + 1e-6f) * gmul; }
#pragma unroll
        for (int j = 0; j < 4; ++j) { const f32x4 n4 = ((const f32x4*)npost)[lane + 64 * j];
#pragma unroll
            for (int q = 0; q < NR; ++q) { const f32x4 g4 = ((const f32x4*)J[q].gate)[lane + 64 * j];
                const f32x4 yf = {bflo(yv[q][j].x), bfhi(yv[q][j].x), bflo(yv[q][j].y), bfhi(yv[q][j].y)};
                xv[q][j] = xv[q][j] + g4 * (yf * rstd[q] * n4);
                ((f32x4*)J[q].xout)[lane + 64 * j] = xv[q][j]; } }
    }
    if constexpr (HASH) {
        float rstd[NR];
#pragma unroll
        for (int q = 0; q < NR; ++q) { float ss = 0.f;
#pragma unroll
            for (int j = 0; j < 4; ++j) ss += (xv[q][j].x * xv[q][j].x + xv[q][j].y * xv[q][j].y) + (xv[q][j].z * xv[q][j].z + xv[q][j].w * xv[q][j].w);
            rstd[q] = rsqrtf(wave_sum(ss) * (1.0f / DM) + 1e-6f); }
#pragma unroll
        for (int j = 0; j < 4; ++j) { const f32x4 n4 = ((const f32x4*)npre)[lane + 64 * j];
#pragma unroll
            for (int q = 0; q < NR; ++q) { const f32x4 s4 = ((const f32x4*)J[q].sc)[lane + 64 * j], b4 = ((const f32x4*)J[q].sh)[lane + 64 * j];
                const f32x4 hv = (xv[q][j] * rstd[q] * n4) * (s4 + 1.0f) + b4;
                u32x2 w; w.x = cvtpk(hv.x, hv.y); w.y = cvtpk(hv.z, hv.w); ((u32x2*)J[q].h)[lane + 64 * j] = w; } }
    }
}

template <bool HASY, bool HASH, bool XIN32 = true, bool XOUT32 = true>
__device__ __forceinline__ void combine_span(int mb, int me, const void* xin_lat, const void* xin_ctx, void* xout_lat, void* xout_ctx, const bf16* Y, bf16* H,
                                             const float* gate0, const float* npost, const float* sh0, const float* sc0, const float* npre, int lane, float gmul) {
    int cur_r = -1; f32x4 A1[4], A2[4], B2[4];
    for (int m = mb; m < me;) {
        const int r = m < MLAT ? (m >> 11) : 32;
        if (r != cur_r) { cur_r = r;
#pragma unroll
            for (int j = 0; j < 4; ++j) {
                if constexpr (HASY) A1[j] = ((const f32x4*)(gate0 + (size_t)r * MODW))[lane + 64 * j] * ((const f32x4*)npost)[lane + 64 * j] * gmul;
                if constexpr (HASH) { A2[j] = ((const f32x4*)npre)[lane + 64 * j] * (((const f32x4*)(sc0 + (size_t)r * MODW))[lane + 64 * j] + 1.0f); B2[j] = ((const f32x4*)(sh0 + (size_t)r * MODW))[lane + 64 * j]; } } }
        const int mn = m + 1; const bool two = mn < me && (mn < MLAT ? (mn >> 11) : 32) == r;
        const int mq[2] = {m, two ? mn : m};
        f32x4 xv[2][4]; u32x2 yv[2][4];
#pragma unroll
        for (int q = 0; q < 2; ++q) { const int mm = mq[q]; const size_t eo = mm < MLAT ? (size_t)mm * DM : (size_t)(mm - MLAT) * DM; const void* xb = mm < MLAT ? xin_lat : xin_ctx;
#pragma unroll
            for (int j = 0; j < 4; ++j) {
                if constexpr (XIN32) xv[q][j] = ((const f32x4*)((const float*)xb + eo))[lane + 64 * j];
                else { const u32x2 w = ((const u32x2*)((const bf16*)xb + eo))[lane + 64 * j]; xv[q][j] = (f32x4){bflo(w.x), bfhi(w.x), bflo(w.y), bfhi(w.y)}; }
                if constexpr (HASY) yv[q][j] = ((const u32x2*)(Y + (size_t)mm * DM))[lane + 64 * j]; } }
        if constexpr (HASY) {
            float rstd[2];
#pragma unroll
            for (int q = 0; q < 2; ++q) { float ss = 0.f;
#pragma unroll
                for (int j = 0; j < 4; ++j) { const float a = bflo(yv[q][j].x), b = bfhi(yv[q][j].x), c = bflo(yv[q][j].y), d = bfhi(yv[q][j].y); ss += (a * a + b * b) + (c * c + d * d); }
                rstd[q] = rsqrtf(wave_sum(ss) * (1.0f / DM) + 1e-6f); }
#pragma unroll
            for (int q = 0; q < 2; ++q) { const int mm = mq[q]; const size_t eo = mm < MLAT ? (size_t)mm * DM : (size_t)(mm - MLAT) * DM; void* xb = mm < MLAT ? xout_lat : xout_ctx;
#pragma unroll
                for (int j = 0; j < 4; ++j) { const f32x4 yf = {bflo(yv[q][j].x), bfhi(yv[q][j].x), bflo(yv[q][j].y), bfhi(yv[q][j].y)};
                    xv[q][j] = xv[q][j] + A1[j] * (yf * rstd[q]);
                    if constexpr (XOUT32) ((f32x4*)((float*)xb + eo))[lane + 64 * j] = xv[q][j];
                    else { u32x2 w; w.x = cvtpk(xv[q][j].x, xv[q][j].y); w.y = cvtpk(xv[q][j].z, xv[q][j].w); ((u32x2*)((bf16*)xb + eo))[lane + 64 * j] = w;
                        xv[q][j] = (f32x4){bflo(w.x), bfhi(w.x), bflo(w.y), bfhi(w.y)}; } } }
        }
        if constexpr (HASH) {
            float rstd[2];
#pragma unroll
            for (int q = 0; q < 2; ++q) { float ss = 0.f;
#pragma unroll
                for (int j = 0; j < 4; ++j) ss += (xv[q][j].x * xv[q][j].x + xv[q][j].y * xv[q][j].y) + (xv[q][j].z * xv[q][j].z + xv[q][j].w * xv[q][j].w);
                rstd[q] = rsqrtf(wave_sum(ss) * (1.0f / DM) + 1e-6f); }
#pragma unroll
            for (int q = 0; q < 2; ++q) { const int mm = mq[q];
#pragma unroll
                for (int j = 0; j < 4; ++j) { const f32x4 hv = (xv[q][j] * rstd[q]) * A2[j] + B2[j];
                    u32x2 w; w.x = cvtpk(hv.x, hv.y); w.y = cvtpk(hv.z, hv.w); ((u32x2*)(H + (size_t)mm * DM))[lane + 64 * j] = w; } }
        }
        m += two ? 2 : 1;
    }
}

#define XB_TMO      128
#define XB_XCNT(j)  (256  + 64 * (j))
#define XB_XSUB(j)  (1280 + 64 * (j))
#define XB_XGEN(j)  (2304 + 64 * (j))
#define XB_TOP      3328
#define XB_TOPGEN   3392
#define XCD_BAR_WORDS 3456
#define XB_SPIN_CAP (1u << 18)

__device__ __forceinline__ unsigned xb_ld(unsigned* p)              { return __hip_atomic_load(p, __ATOMIC_RELAXED, __HIP_MEMORY_SCOPE_AGENT); }
__device__ __forceinline__ unsigned xb_add(unsigned* p, unsigned v) { return __hip_atomic_fetch_add(p, v, __ATOMIC_RELAXED, __HIP_MEMORY_SCOPE_AGENT); }
__device__ __forceinline__ unsigned xb_xcc_id() { return (unsigned)__builtin_amdgcn_s_getreg((3 << 11) | 20) & 0xFu; }
#define XB_SPIN(cond, bar) do { unsigned _sp = 0; while (cond) { __builtin_amdgcn_s_sleep(1); \
    if ((++_sp & 255u) == 0u) { if (xb_ld(&(bar)[XB_TMO])) break; if (_sp > XB_SPIN_CAP) { atomicAdd(&(bar)[XB_TMO], 1u); break; } } } } while (0)

struct XcdBarrier {
    unsigned* bar; unsigned x;
    volatile LAS unsigned* st;
};

__device__ __forceinline__ XcdBarrier xcd_barrier_post(unsigned* bar, volatile LAS unsigned* st) {
    XcdBarrier b; b.bar = bar; b.x = xb_xcc_id(); b.st = st;
    if (threadIdx.x == 0) (void)xb_add(&bar[XB_XCNT(b.x)], 1u);
    return b;
}
__device__ __forceinline__ void xcd_barrier_complete(unsigned* bar, unsigned x, unsigned& nloc, unsigned& nx) {
    const unsigned G = gridDim.x * gridDim.y * gridDim.z;
    unsigned sum, cnt, mine, sp = 0u;
    for (;;) {
        sum = 0u; cnt = 0u; mine = 0u;
#pragma unroll
        for (unsigned j = 0; j < 16; ++j) { const unsigned c = xb_ld(&bar[XB_XCNT(j)]); sum += c; cnt += (c > 0u) ? 1u : 0u; mine = (j == x) ? c : mine; }
        if (sum == G) break;
        __builtin_amdgcn_s_sleep(1);
        if ((++sp & 255u) == 0u) { if (xb_ld(&bar[XB_TMO])) break; if (sp > XB_SPIN_CAP) { atomicAdd(&bar[XB_TMO], 1u); break; } }
    }
    nloc = mine > 0u ? mine : 1u; nx = cnt > 0u ? cnt : 1u;
}

__device__ __forceinline__ void xcd_barrier(const XcdBarrier& b) {
    asm volatile("s_waitcnt vmcnt(0)" ::: "memory");
    __syncthreads();
    if (threadIdx.x == 0) {
        unsigned* bar = b.bar;
        __builtin_amdgcn_s_waitcnt(0);
        unsigned nloc = b.st[0], nx = b.st[1];
        if (nloc == 0u) { xcd_barrier_complete(bar, b.x, nloc, nx); b.st[0] = nloc; b.st[1] = nx; }
        const unsigned old = xb_add(&bar[XB_XSUB(b.x)], 1u);
        const unsigned gen = old / nloc;
        if (old + 1u == (gen + 1u) * nloc) {
            __builtin_amdgcn_fence(__ATOMIC_RELEASE, "agent");
            asm volatile("s_waitcnt vmcnt(0)" ::: "memory");
            const unsigned og = xb_add(&bar[XB_TOP], 1u);
            const unsigned tg = og / nx;
            if (og + 1u == (tg + 1u) * nx) xb_add(&bar[XB_TOPGEN], 1u);
            else XB_SPIN(xb_ld(&bar[XB_TOPGEN]) == tg, bar);
            __builtin_amdgcn_fence(__ATOMIC_ACQUIRE, "agent");
            xb_add(&bar[XB_XGEN(b.x)], 1u);
            asm volatile("s_waitcnt vmcnt(0)" ::: "memory");
        } else {
            XB_SPIN(xb_ld(&bar[XB_XGEN(b.x)]) == gen, bar);
            __builtin_amdgcn_fence(__ATOMIC_ACQUIRE, "agent");
            asm volatile("s_waitcnt vmcnt(0)" ::: "memory");
        }
    }
    __syncthreads();
}

struct Args { const float* in[23]; float* out; unsigned char* ws; int ph_lo, ph_hi; };

__global__ void __launch_bounds__(512, 2) mega(Args args) {
    extern __shared__ __attribute__((aligned(16))) unsigned char lds[];
    cg::grid_group grid = cg::this_grid();
    const int G = gridDim.x, bx = blockIdx.x;
    const int vcu = (G % 8 == 0) ? (bx % 8) * (G / 8) + bx / 8 : bx;
    const int NGW = G * 8;
    const int lo = args.ph_lo, hi = args.ph_hi;
    unsigned char* ws = args.ws;
    const float* x_in = args.in[0]; const float* c_in = args.in[1]; const float* ctx_in = args.in[2]; const float* cctx_in = args.in[3];
    const float* ada_w = args.in[4]; const float* ada_b = args.in[5]; const float* norm_g = args.in[6];
    float* modp = (float*)(ws + OFF_MODP); float* mods = (float*)(ws + OFF_MODS);
    float* cosA = (float*)(ws + OFF_ROPE); float* sinA = cosA + 2048 * 32; float* cosC = sinA + 2048 * 32; float* sinC = cosC + 2048 * 64;
    bf16* Wsb = (bf16*)(ws + OFF_WS);
    unsigned char* Wb = ws + OFF_W;
#ifndef XBF16
#define XBF16 0
#endif
    void* XC = (void*)(ws + OFF_XC); void* XL = XBF16 ? (void*)(ws + OFF_XLB) : (void*)args.out;
    bf16* Hb = (bf16*)(ws + OFF_H); bf16* Yb = (bf16*)(ws + OFF_Y); bf16* QKV = (bf16*)(ws + OFF_BIG); bf16* Ob = (bf16*)(ws + OFF_O); bf16* HID = (bf16*)(ws + OFF_BIG);
    if (threadIdx.x < 16) ((LAS unsigned*)((LAS unsigned char*)lds + LDS_XB))[threadIdx.x] = 0u;
    __syncthreads();
    const XcdBarrier xbar = xcd_barrier_post((unsigned*)(ws + OFF_CTL), (volatile LAS unsigned*)((LAS unsigned char*)lds + LDS_XB));
    bool first_seam = true;
    int ph = 0;
#define GSYNC() do { if (first_seam) { grid.sync(); first_seam = false; } else xcd_barrier(xbar); } while (0)
#ifndef PH_MASK
#define PH_MASK 0xffff
#endif
#define RUN(p) (lo <= (p) && (p) < hi)
#define ON(b) ((PH_MASK >> (b)) & 1)
#ifndef G1MASK
#define G1MASK 7
#endif
#ifndef ATMASK
#define ATMASK 3
#endif
#define ATK(k) ((ATMASK >> (k)) & 1)
#define G1K(k) ((G1MASK >> (k)) & 1)
#define SEAM(p) do { if (RUN(p) && RUN((p) + 1)) GSYNC(); } while (0)

#ifndef NPRO
#define NPRO 1
#endif
#ifndef EPI_SKIP_ON_REP
#define EPI_SKIP_ON_REP 0
#endif
#ifdef EXTRA_SYNCS
    for (int es = 0; es < EXTRA_SYNCS; ++es) GSYNC();
#endif
    for (int prep = 0; prep < NPRO; ++prep) {
    if (prep) { GSYNC(); ph -= 3; }
    int tid = threadIdx.x; asm volatile("" : "+v"(tid));
    const int lane = tid & 63, wave = __builtin_amdgcn_readfirstlane(tid >> 6), gw = vcu * 8 + wave;
    if (ON(0) && RUN(ph)) {
        LAS float* scr = (LAS float*)((LAS unsigned char*)lds + wave * 16896);
        for (int it = gw; it < 96 * 8; it += NGW) {
            const int cb = it % 96, ks = it / 96, k0 = ks * 128;
            for (int idx = lane; idx < NMODROW * 128; idx += 64) { const int r = idx >> 7, kk = idx & 127; const float v = r < 32 ? c_in[r * DM + k0 + kk] : cctx_in[k0 + kk];
                scr[idx] = v / (1.0f + __expf(-v)); }
            asm volatile("s_waitcnt lgkmcnt(0)" ::: "memory");
            f32x4 acc[NMODROW];
#pragma unroll
            for (int r = 0; r < NMODROW; ++r) acc[r] = (f32x4){0.f, 0.f, 0.f, 0.f};
            const int li = cb / 24, col0 = (cb % 24) * 256 + lane * 4;
            const float* wp = ada_w + ((size_t)li * DM + k0) * MODW + col0;
#pragma unroll 2
            for (int kk = 0; kk < 128; ++kk) { const f32x4 w4 = *(const f32x4*)(wp + (size_t)kk * MODW);
#pragma unroll
                for (int r = 0; r < NMODROW; ++r) { const float s = scr[r * 128 + kk]; acc[r] = acc[r] + w4 * s; } }
#pragma unroll
            for (int r = 0; r < NMODROW; ++r) *(f32x4*)(modp + ((size_t)ks * NMODROW + r) * (4 * MODW) + li * MODW + col0) = acc[r];
            asm volatile("s_waitcnt lgkmcnt(0)" ::: "memory");
        }
        {
            constexpr int I_FI = 16 * 176, I_FO = 44 * 32, I_AQ = 16 * 48, I_AO = 16 * 32, I_BI = 16 * 64, I_BO = 16 * 32, I_CQ = 16 * 64, I_CO = 16 * 32;
            constexpr int NIT = 4 * I_FI + 4 * I_FO + 2 * I_AQ + 2 * I_AO + I_BI + I_BO + I_CQ + I_CO;
            const int ntw = NGW > 1024 ? NGW - 768 : NGW, tw = NGW > 1024 ? gw - 768 : gw;
            if (tw >= 0) for (int it = tw; it < NIT; it += ntw) {
                int r = it;
                if (r < 4 * I_FI) { const int l = r / I_FI; r %= I_FI; const int kb = r / 176, nb = r % 176;
                    transpose_item(args.in[7] + (size_t)l * DM * 2 * FFH, DM, 2 * FFH, (bf16*)(Wb + W_FI) + (size_t)l * 2 * FFH * DM, kb * 64, nb * 32, ffn_in_row(nb * 32), scr, lane); continue; } r -= 4 * I_FI;
                if (r < 4 * I_FO) { const int l = r / I_FO; r %= I_FO; const int kb = r / 32, nb = r % 32;
                    transpose_item(args.in[8] + (size_t)l * FFH * DM, FFH, DM, (bf16*)(Wb + W_FO) + (size_t)l * DM * FFH, kb * 64, nb * 32, nb * 32, scr, lane); continue; } r -= 4 * I_FO;
                if (r < 2 * I_AQ) { const int l = r / I_AQ; r %= I_AQ; const int kb = r / 48, nb = r % 48;
                    transpose_item(args.in[9] + (size_t)l * DM * 1536, DM, 1536, (bf16*)(Wb + W_AQ) + (size_t)l * 1536 * DM, kb * 64, nb * 32, nb * 32, scr, lane); continue; } r -= 2 * I_AQ;
                if (r < 2 * I_AO) { const int l = r / I_AO; r %= I_AO; const int kb = r / 32, nb = r % 32;
                    transpose_item(args.in[10] + (size_t)l * DM * DM, DM, DM, (bf16*)(Wb + W_AO) + (size_t)l * DM * DM, kb * 64, nb * 32, nb * 32, scr, lane); continue; } r -= 2 * I_AO;
                if (r < I_BI) { const int kb = r / 64, nb = r % 64; transpose_item(args.in[12], DM, 2048, (bf16*)(Wb + W_BI), kb * 64, nb * 32, nb * 32, scr, lane); continue; } r -= I_BI;
                if (r < I_BO) { const int kb = r / 32, nb = r % 32; transpose_item(args.in[18], DM, DM, (bf16*)(Wb + W_BO), kb * 64, nb * 32, nb * 32, scr, lane); continue; } r -= I_BO;
                if (r < I_CQ) { const int kb = r / 64, nb = r % 64; transpose_item(args.in[19], DM, 2048, (bf16*)(Wb + W_CQ), kb * 64, nb * 32, nb * 32, scr, lane); continue; } r -= I_CQ;
                { const int kb = r / 32, nb = r % 32; transpose_item(args.in[20], DM, DM, (bf16*)(Wb + W_CO), kb * 64, nb * 32, nb * 32, scr, lane); }
            }
        }
        {
            const int gt = gw * 64 + lane, NGT = NGW * 64;
            const float* wsf = args.in[16];
            for (int e = gt; e < 8 * 128 * 128 / 2; e += NGT) ((unsigned*)Wsb)[e] = cvtpk(wsf[2 * e], wsf[2 * e + 1]);
            for (int e = gt; e < 2048 * 32; e += NGT) { const int t = e >> 5, p = e & 31, j = p & 15; const float pos = (float)(p < 16 ? (t >> 6) : (t & 63));
                const float inv = exp2f(-(float)j * (13.287712379549449f / 16.0f)); const float a = pos * inv; cosA[e] = cosf(a); sinA[e] = sinf(a); }
            for (int e = gt; e < 2048 * 64; e += NGT) { const int t = e >> 6, p = e & 63, j = p & 31; const float pos = (float)(p < 32 ? (t >> 6) : (t & 63));
                const float inv = exp2f(-(float)j * (13.287712379549449f / 32.0f)); const float a = pos * inv; cosC[e] = cosf(a); sinC[e] = sinf(a); }
        }
    }
    SEAM(ph); ++ph;
    if (ON(1) && RUN(ph)) {
        const int gt = gw * 64 + lane, NGT = NGW * 64;
        for (int e = gt; e < DEPTH * NMODROW * MODW / 4; e += NGT) {
            const int c4 = e % (MODW / 4), rr = (e / (MODW / 4)) % NMODROW, li = e / (MODW / 4 * NMODROW);
            f32x4 s = *(const f32x4*)(ada_b + li * MODW + c4 * 4);
#pragma unroll
            for (int k = 0; k < 8; ++k) s = s + *(const f32x4*)(modp + ((size_t)k * NMODROW + rr) * (4 * MODW) + li * MODW + c4 * 4);
            *(f32x4*)(mods + ((size_t)li * NMODROW + rr) * MODW + c4 * 4) = s;
        }
    }
    SEAM(ph); ++ph;
    if (ON(2) && RUN(ph)) {
        { const int rpw = (MTOT + NGW - 1) / NGW, mb = gw * rpw, me = mb + rpw < MTOT ? mb + rpw : MTOT;
          combine_span<false, true>(mb, me, x_in, ctx_in, nullptr, nullptr, nullptr, Hb, nullptr, nullptr, mods, mods + DM, norm_g, lane, 1.0f); }
    }
    SEAM(ph); ++ph;
    }

    for (int step = 3, rep = 0; step < 3 + 8 * DEPTH; ) {
        const int li = (step - 3) >> 3, op = (step - 3) & 7;
        int tid = threadIdx.x; asm volatile("" : "+v"(tid));
        const int lane = tid & 63, wave = __builtin_amdgcn_readfirstlane(tid >> 6), gw = vcu * 8 + wave;
        const int kind = li % 3; const int ja = li / 3; const bool ctx_out = li < DEPTH - 1; const int Mact = ctx_out ? MTOT : MLAT;
        const float* ng = norm_g + (size_t)li * 4 * DM;
        const bool noop = (op == 1 && kind == 1);
        if (RUN(ph) && !noop) {
#ifdef STAGGER_US
            if (op == 0 || op == 3 || op == 5 || op == 6) {
                const unsigned long long t0 = __builtin_amdgcn_s_memrealtime(); const unsigned long long dl = (unsigned long long)(((bx >> 3) & 3) * STAGGER_US * 100);
                while (__builtin_amdgcn_s_memrealtime() - t0 < dl) __builtin_amdgcn_s_sleep(32);
            }
#endif
            if (ON(3) && ((op == 0 && kind != 1) || op == 3 || op == 6)) {
                pg8::Gemm g; pg8::EpiBf16<0> E; E.bias = nullptr; E.split_cols = 0; E.split_stride = 0; E.scale0 = 1.f; E.skip = EPI_SKIP_ON_REP ? rep : 0;
                if (op == 0) { const int N1 = kind == 0 ? 1536 : 2048; g.A = Hb; g.Bt = kind == 0 ? (const bf16*)(Wb + W_AQ) + (size_t)ja * 1536 * DM : (const bf16*)(Wb + W_CQ); g.M = MTOT; g.N = N1; g.K = DM; E.O = QKV; E.ldc = N1; }
                else if (op == 3) { g.A = Ob; g.Bt = kind == 0 ? (const bf16*)(Wb + W_AO) + (size_t)ja * DM * DM : kind == 1 ? (const bf16*)(Wb + W_BO) : (const bf16*)(Wb + W_CO); g.M = Mact; g.N = DM; g.K = DM; E.O = Yb; E.ldc = DM; }
                else { g.A = HID; g.Bt = (const bf16*)(Wb + W_FO) + (size_t)li * DM * FFH; g.M = Mact; g.N = DM; g.K = FFH; E.O = Yb; E.ldc = DM; }
                pg8::StaticOrder S; S.init(g.M, g.N, G, bx);
                pg8::gemm_phase<pg8::EpiBf16<0>, pg8::StaticOrder, true, true>((PG8_LAS unsigned char*)lds, g, S, E);
            }
            else if (ON(4) && op == 0) {
                pg8::Gemm g{Hb, (const bf16*)(Wb + W_BI), MTOT, 2048, DM}; pg8::StaticOrder S; S.init(MTOT, 2048, G, bx);
                pg8::EpiBf16<1> E{QKV, 2048, args.in[13], 0, 0, 1.f, EPI_SKIP_ON_REP ? rep : 0}; pg8::gemm_phase<pg8::EpiBf16<1>, pg8::StaticOrder, true, true>((PG8_LAS unsigned char*)lds, g, S, E);
            }
            else if (ON(5) && op == 5) {
                pg8::Gemm g{Hb, (const bf16*)(Wb + W_FI) + (size_t)li * 2 * FFH * DM, Mact, 2 * FFH, DM}; pg8::StaticOrder S; S.init(Mact, 2 * FFH, G, bx);
                pg8::EpiSwiglu E{HID, FFH}; pg8::gemm_phase<pg8::EpiSwiglu, pg8::StaticOrder, true, true>((PG8_LAS unsigned char*)lds, g, S, E);
            }
            else if (ON(6) && op == 1) {
                if (kind == 0) {
                    for (int m = gw; m < MLAT; m += NGW) { const int t = m & 2047; bf16* kp = QKV + (size_t)m * 1536 + 1024 + (lane >> 4) * 64 + (lane & 15) * 2;
                        const unsigned w1 = *(const unsigned*)kp, w2 = *(const unsigned*)(kp + 32);
                        const f32x2 c = *(const f32x2*)(cosA + t * 32 + (lane & 15) * 2), s = *(const f32x2*)(sinA + t * 32 + (lane & 15) * 2);
                        const float a0 = bflo(w1), a1 = bfhi(w1), b0 = bflo(w2), b1 = bfhi(w2);
                        *(unsigned*)kp = cvtpk(a0 * c.x - b0 * s.x, a1 * c.y - b1 * s.y); *(unsigned*)(kp + 32) = cvtpk(b0 * c.x + a0 * s.x, b1 * c.y + a1 * s.y); }
                } else {
                    const float* kg = args.in[22];
                    for (int m = gw; m < MTOT; m += NGW) { bf16* kp = QKV + (size_t)m * 2048 + 1024 + (lane >> 4) * 128 + (lane & 15) * 4; const int i0 = (lane & 15) * 4;
                        const u32x2 w1 = *(const u32x2*)kp, w2 = *(const u32x2*)(kp + 64);
                        float a[4] = {bflo(w1.x), bfhi(w1.x), bflo(w1.y), bfhi(w1.y)}, b[4] = {bflo(w2.x), bfhi(w2.x), bflo(w2.y), bfhi(w2.y)};
                        float ss = 0.f;
#pragma unroll
                        for (int j = 0; j < 4; ++j) ss += a[j] * a[j] + b[j] * b[j];
                        ss += __shfl_xor(ss, 1); ss += __shfl_xor(ss, 2); ss += __shfl_xor(ss, 4); ss += __shfl_xor(ss, 8);
                        const float rstd = rsqrtf(ss * (1.0f / 128.0f) + 1e-6f);
                        const f32x4 g1 = *(const f32x4*)(kg + i0), g2 = *(const f32x4*)(kg + 64 + i0);
#pragma unroll
                        for (int j = 0; j < 4; ++j) { a[j] *= rstd * g1[j]; b[j] *= rstd * g2[j]; }
                        if (m < MLAT) { const int t = m & 2047; const f32x4 c = *(const f32x4*)(cosC + t * 64 + i0), s = *(const f32x4*)(sinC + t * 64 + i0);
#pragma unroll
                            for (int j = 0; j < 4; ++j) { const float x1 = a[j], x2 = b[j]; a[j] = x1 * c[j] - x2 * s[j]; b[j] = x2 * c[j] + x1 * s[j]; } }
                        u32x2 o1, o2; o1.x = cvtpk(a[0], a[1]); o1.y = cvtpk(a[2], a[3]); o2.x = cvtpk(b[0], b[1]); o2.y = cvtpk(b[2], b[3]);
                        *(u32x2*)kp = o1; *(u32x2*)(kp + 64) = o2; }
                }

            }
            else if (ON(7) && op == 2 && kind != 1) {
                if (kind == 0) {
                    const float* sink = args.in[11] + ja * 16;
                    const int nlat = 4096, ntot = nlat + (ctx_out ? 512 : 0);
                    for (int u = bx; u < ntot; u += G) {
                        att::UnitDesc d; d.nctx = 4; d.cosT = cosA; d.sinT = sinA; d.qg = nullptr;
                        int b, h;
                        if (u < nlat) { const int x = u & 7, j = (u >> 3) & 31, gi = (u >> 8) * 8 + x; b = gi >> 2; const int kvh = gi & 3; h = kvh * 4 + (j >> 3); const int q0 = (j & 7) * 256;
                            d.Q = QKV + ((size_t)b * SEQ + q0) * 1536 + h * 64; d.O = Ob + ((size_t)b * SEQ + q0) * DM + h * 64; d.qpos0 = q0;
                            const int klo = q0 - 128 < 0 ? 0 : q0 - 128, khi = q0 + 384 > SEQ ? SEQ : q0 + 384; d.band_kp0 = klo; d.NT = 4 + (khi - klo) / 64; }
                        else { const int cu = u - nlat; b = cu >> 4; h = cu & 15;
                            d.Q = QKV + ((size_t)MLAT + b * CTXL) * 1536 + h * 64; d.O = Ob + ((size_t)MLAT + b * CTXL) * DM + h * 64; d.qpos0 = -1; d.band_kp0 = 0; d.NT = 4; }
                        d.Kc = QKV + 1024 + (h >> 2) * 64; d.Vc = QKV + 1280 + (h >> 2) * 64; d.ctx_row0 = MLAT + b * CTXL; d.lat_row0 = (long)b * SEQ;
                        d.sink_l2 = sink[h] * 1.4426950408889634f;
                        att::attn_unit<64, 1536, false, true>(d, (char*)lds);
                    }
                } else {
                    const int nlat = 2048, ntot = nlat + (ctx_out ? 256 : 0);
                    for (int u = bx; u < ntot; u += G) {
                        att::UnitDesc d; d.nctx = 4; d.cosT = cosC; d.sinT = sinC; d.qg = args.in[21]; d.band_kp0 = 0;
                        int b, h;
                        if (u < nlat) { const int x = u & 7, j = (u >> 3) & 31, gi = ((u >> 8) * 8 + x) * 2 + (j >> 4); b = gi >> 2; const int kvh = gi & 3; h = kvh * 2 + ((j & 15) >> 3); const int q0 = (j & 7) * 256;
                            d.Q = QKV + ((size_t)b * SEQ + q0) * 2048 + h * 128; d.O = Ob + ((size_t)b * SEQ + q0) * DM + h * 128; d.qpos0 = q0; d.NT = 36; }
                        else { const int cu = u - nlat; b = cu >> 3; h = cu & 7;
                            d.Q = QKV + ((size_t)MLAT + b * CTXL) * 2048 + h * 128; d.O = Ob + ((size_t)MLAT + b * CTXL) * DM + h * 128; d.qpos0 = -1; d.NT = 4; }
                        d.Kc = QKV + 1024 + (h >> 1) * 128; d.Vc = QKV + 1536 + (h >> 1) * 128; d.ctx_row0 = MLAT + b * CTXL; d.lat_row0 = (long)b * SEQ;
                        d.sink_l2 = -INFINITY;
                        att::attn_unit<128, 2048, true, false>(d, (char*)lds);
                    }
                }

            }
            else if (ON(8) && op == 2) {
                constexpr int TB = 16384;
                char* V_lds = (char*)lds; f32x2* stat = (f32x2*)((char*)lds + 2 * TB);
                const float* lng = args.in[14]; const float* lnb = args.in[15]; const float* bsb = args.in[17];
                const int r32 = lane & 31, hh = lane >> 5, rb = wave & 3, chh = wave >> 2;
                const int sr = tid >> 4, sc = (tid & 15) * 8;
                const int vb0 = (int)(uintptr_t)V_lds + att::v_rd_base(lane);
                for (int u = bx; u < (MTOT / 128) * 2; u += G) {
                    const int chunk = u >> 1, gh = u & 1; const size_t row0 = (size_t)chunk * 128;
                    for (int rr = 0; rr < 16; ++rr) { const bf16* vp = QKV + (row0 + wave * 16 + rr) * 2048 + 1024 + lane * 16;
                        const bf16x8 v0 = *(const bf16x8*)vp, v1 = *(const bf16x8*)(vp + 8); float f[16];
#pragma unroll
                        for (int j = 0; j < 8; ++j) { f[j] = bf2f(v0[j]); f[8 + j] = bf2f(v1[j]); }
                        float s = 0.f;
#pragma unroll
                        for (int j = 0; j < 16; ++j) s += f[j];
                        const float mean = wave_sum(s) * (1.0f / 1024.0f); float q = 0.f;
#pragma unroll
                        for (int j = 0; j < 16; ++j) { const float dd = f[j] - mean; q += dd * dd; }
                        const float rstd = rsqrtf(wave_sum(q) * (1.0f / 1024.0f) + 1e-5f);
                        if (lane == 0) stat[wave * 16 + rr] = (f32x2){mean, rstd}; }
                    __syncthreads();
                    for (int gi = 0; gi < 4; ++gi) {
                        const int g = gh * 4 + gi;
                        const f32x4 lg0 = *(const f32x4*)(lng + g * 128 + sc), lg1 = *(const f32x4*)(lng + g * 128 + sc + 4), lb0 = *(const f32x4*)(lnb + g * 128 + sc), lb1 = *(const f32x4*)(lnb + g * 128 + sc + 4);
#pragma unroll
                        for (int l = 0; l < 4; ++l) { const int rl = sr + 32 * l; const bf16x8 raw = *(const bf16x8*)(QKV + (row0 + rl) * 2048 + 1024 + g * 128 + sc);
                            const f32x2 st = stat[rl]; float f[8];
#pragma unroll
                            for (int j = 0; j < 8; ++j) f[j] = (bf2f(raw[j]) - st.x) * st.y * (j < 4 ? lg0[j & 3] : lg1[j & 3]) + (j < 4 ? lb0[j & 3] : lb1[j & 3]);
                            u32x4 w = {cvtpk(f[0], f[1]), cvtpk(f[2], f[3]), cvtpk(f[4], f[5]), cvtpk(f[6], f[7])};
                            *(u32x4*)(V_lds + (l >> 1) * TB + att::v_st<128>(sr + 32 * (l & 1), sc)) = w; }
                        bf16x8 pa[2][4];
#pragma unroll
                        for (int T = 0; T < 2; ++T)
#pragma unroll
                            for (int ks = 0; ks < 4; ++ks) pa[T][ks] = *(const bf16x8*)(Wsb + (size_t)g * 16384 + (32 * rb + r32) * 128 + 64 * T + 16 * ks + 8 * hh);
                        __syncthreads();
                        f32x16 o[2]; o[0] = f32x16{}; o[1] = f32x16{};
                        if (chh == 0) {
                            att::pv_one<128, 0>(o[0], vb0, pa[0][0], pa[0][1], pa[0][2], pa[0][3]); att::pv_one<128, 1>(o[1], vb0, pa[0][0], pa[0][1], pa[0][2], pa[0][3]);
                            att::pv_one<128, 0>(o[0], vb0 + TB, pa[1][0], pa[1][1], pa[1][2], pa[1][3]); att::pv_one<128, 1>(o[1], vb0 + TB, pa[1][0], pa[1][1], pa[1][2], pa[1][3]);
                        } else {
                            att::pv_one<128, 2>(o[0], vb0, pa[0][0], pa[0][1], pa[0][2], pa[0][3]); att::pv_one<128, 3>(o[1], vb0, pa[0][0], pa[0][1], pa[0][2], pa[0][3]);
                            att::pv_one<128, 2>(o[0], vb0 + TB, pa[1][0], pa[1][1], pa[1][2], pa[1][3]); att::pv_one<128, 3>(o[1], vb0 + TB, pa[1][0], pa[1][1], pa[1][2], pa[1][3]);
                        }
                        { bf16* stg = (bf16*)((char*)lds + 2 * TB + 1024) + wave * 2048;
#pragma unroll
                          for (int r = 0; r < 16; ++r) { const int pr = att::crow(r, hh); const float bias = bsb[g * 128 + 32 * rb + pr];
#pragma unroll
                            for (int d = 0; d < 2; ++d) { const float v = o[d][r] + bias; stg[pr * 64 + d * 32 + r32] = (bf16)(cvtpk(v, v) & 0xffffu); } }
                          asm volatile("s_waitcnt lgkmcnt(0)" ::: "memory");
#pragma unroll
                          for (int i = 0; i < 4; ++i) { const int row = i * 8 + (lane >> 3), ch = lane & 7; const bf16x8 mv = *(const bf16x8*)(stg + row * 64 + ch * 8);
                            const size_t gr = row0 + 32 * rb + row; const int col = g * 128 + 64 * chh + ch * 8;
                            const bf16x8 uv = *(const bf16x8*)(QKV + gr * 2048 + col); float f[8];
#pragma unroll
                            for (int e = 0; e < 8; ++e) f[e] = bf2f(uv[e]) * bf2f(mv[e]);
                            u32x4 w = {cvtpk(f[0], f[1]), cvtpk(f[2], f[3]), cvtpk(f[4], f[5]), cvtpk(f[6], f[7])};
                            *(u32x4*)(Ob + gr * DM + col) = w; } }
                        __syncthreads();
                    }
                }

            }
            else if (ON(9) && op == 4) {
                { const int rpw = (Mact + NGW - 1) / NGW, mb = gw * rpw, me = mb + rpw < Mact ? mb + rpw : Mact; const float* ml = mods + (size_t)li * NMODROW * MODW; const bool first = li == 0 && !rep;
                  if (first) combine_span<true, true, true, !XBF16>(mb, me, x_in, ctx_in, XL, XC, Yb, Hb, ml + 2 * DM, ng + DM, ml + 3 * DM, ml + 4 * DM, ng + 2 * DM, lane, 1.0f);
                  else combine_span<true, true, !XBF16, !XBF16>(mb, me, XL, XC, XL, XC, Yb, Hb, ml + 2 * DM, ng + DM, ml + 3 * DM, ml + 4 * DM, ng + 2 * DM, lane, rep ? 0.0f : 1.0f); }
            }
            else if (ON(10) && op == 7) {
                const bool last = li == DEPTH - 1;
                { const int rpw = (Mact + NGW - 1) / NGW, mb = gw * rpw, me = mb + rpw < Mact ? mb + rpw : Mact; const float* ml = mods + (size_t)li * NMODROW * MODW; const float* mn = ml + (size_t)NMODROW * MODW;
                  if (last) combine_span<true, false, !XBF16, true>(mb, me, XL, XC, args.out, XC, Yb, Hb, ml + 5 * DM, ng + 3 * DM, nullptr, nullptr, nullptr, lane, rep ? 0.0f : 1.0f);
                  else combine_span<true, true, !XBF16, !XBF16>(mb, me, XL, XC, XL, XC, Yb, Hb, ml + 5 * DM, ng + 3 * DM, mn, mn + DM, ng + 4 * DM, lane, rep ? 0.0f : 1.0f); }
            }
        }
        if (!noop && step + 1 < 3 + 8 * DEPTH) { if (RUN(ph) && RUN(ph + 1)) GSYNC(); }
#ifdef REP_MASK
        if (((REP_MASK >> (step - 3)) & 1) && rep == 0) { rep = 1; continue; }
        rep = 0;
#endif
        ++step; ++ph;
    }
#undef RUN
#undef SEAM
}

#ifndef MK_MULTI
#define MK_MULTI 0
#endif
extern "C" void kernel_launch(void* const* d_in, const int* in_sizes, int n_in, void* d_out, int out_size, void* d_ws, size_t ws_size, hipStream_t stream) {
    static int grid = 0;
    if (grid == 0) {
        if (n_in != 23 || ws_size < WS_END) { fprintf(stderr, "kernel_launch: unexpected n_in %d / ws_size %zu (need %zu)\n", n_in, ws_size, (size_t)WS_END); grid = -1; return; }
        int dev = 0, cus = 0, per_cu = 0;
        hipGetDevice(&dev); hipDeviceGetAttribute(&cus, hipDeviceAttributeMultiprocessorCount, dev);
        if (hipFuncSetAttribute((const void*)mega, hipFuncAttributeMaxDynamicSharedMemorySize, LDS_BYTES) != hipSuccess) { fprintf(stderr, "kernel_launch: hipFuncSetAttribute failed\n"); grid = -1; return; }
        if (hipOccupancyMaxActiveBlocksPerMultiprocessor(&per_cu, (const void*)mega, 512, LDS_BYTES) != hipSuccess || per_cu < 1) { fprintf(stderr, "kernel_launch: occupancy query says %d\n", per_cu); per_cu = 1; }
        (void)hipGetLastError();
        grid = cus * per_cu;
        fprintf(stderr, "kernel_launch: grid %d (cus %d x %d)\n", grid, cus, per_cu);
    }
    if (grid < 0) return;
    if (hipMemsetAsync((char*)d_ws + OFF_CTL, 0, CTL_BYTES, stream) != hipSuccess) { fprintf(stderr, "kernel_launch: memset failed\n"); return; }
    Args a{};
    for (int i = 0; i < 23; ++i) a.in[i] = (const float*)d_in[i];
    a.out = (float*)d_out; a.ws = (unsigned char*)d_ws;
#if MK_MULTI
    const int nph = 3 + 8 * DEPTH;
    for (int p = 0; p < nph; ++p) { a.ph_lo = p; a.ph_hi = p + 1; hipLaunchKernelGGL(mega, dim3(grid), dim3(512), LDS_BYTES, stream, a); }
#else
    a.ph_lo = 0; a.ph_hi = 1000;
    void* params[] = {&a};
    hipError_t e = hipLaunchCooperativeKernel((const void*)mega, dim3(grid), dim3(512), params, LDS_BYTES, stream);
    if (e != hipSuccess) fprintf(stderr, "kernel_launch: cooperative launch failed: %s (grid %d)\n", hipGetErrorString(e), grid);
#endif
}
```

```cpp
#define XBF16 1
#include <hip/hip_runtime.h>
#include <hip/hip_cooperative_groups.h>
#include <cstdio>
#include <cstdint>
namespace cg = cooperative_groups;
namespace pg8 {
#define PG8_LAS __attribute__((address_space(3)))
typedef unsigned short bf16_t;
typedef short bf16x8 __attribute__((ext_vector_type(8)));
typedef float f32x4 __attribute__((ext_vector_type(4)));
typedef unsigned u32x4 __attribute__((ext_vector_type(4)));
constexpr int BM = 256, BK = 64, HALF = 128, HTB = HALF * BK * 2  , STAGE_BYTES = 8 * HTB, NXCD = 8, WGM = 8;

__host__ __device__ __forceinline__ int lds_byte(int r, int c) { const int st = (r >> 4) * 2 + (c >> 5), rr = r & 15, cc = c & 31, ob = rr * 64 + cc * 2; return st * 1024 + (ob ^ (((ob >> 9) & 1) << 5)); }
__host__ __device__ __forceinline__ void stage_rc(int b, int& R, int& C) { const int st = b / 1024, sb = b % 1024, swz = sb ^ (((sb >> 9) & 1) << 5); R = (st >> 1) * 16 + swz / 64; C = (st & 1) * 32 + (swz % 64) / 2; }
__host__ __device__ __forceinline__ int perm32(int rho) { const int n = rho >> 4, i = rho & 15; return 8 * (i >> 2) + 4 * n + (i & 3); }

struct Unit { int pm, pn; };
struct Gemm { const bf16_t* A; const bf16_t* Bt; int M, N, K; };

struct StaticOrder {
    int nM, nN, nwg, G, c;
    __host__ __device__ void init(int M, int N, int G_, int c_) { nM = M / BM; nN = N / BM; nwg = nM * nN; G = G_; c = c_; }
    __host__ __device__ bool next(int i, Unit& u) const {
        const long L = (long)i * G + c; if (L >= nwg) return false;
        int wgid = (int)L; { const int q = nwg / NXCD, r = nwg % NXCD, xcd = wgid % NXCD, off = wgid / NXCD; wgid = (xcd < r ? xcd * (q + 1) : r * (q + 1) + (xcd - r) * q) + off; }
        const int nig = WGM * nN, gid = wgid / nig, fm = gid * WGM, gsz = (nM - fm) < WGM ? (nM - fm) : WGM;
        u.pm = fm + ((wgid % nig) % gsz); u.pn = (wgid % nig) / gsz; return true;
    }
    __device__ __forceinline__ void a_ready(const Unit&) const {}
    __device__ __forceinline__ void done(const Unit&) const {}
};

__device__ __forceinline__ unsigned cvt_pk_bf16(float lo, float hi) { unsigned r; asm volatile("v_cvt_pk_bf16_f32 %0, %1, %2" : "=v"(r) : "v"(lo), "v"(hi)); return r; }
typedef float f32x2 __attribute__((ext_vector_type(2)));
__device__ __forceinline__ f32x2 gelu_pk(f32x2 v) {
    const f32x2 av = __builtin_elementwise_abs(v), d = av * 0.2316418882f + 1.0f;
    f32x2 t; t.x = __builtin_amdgcn_rcpf(d.x); t.y = __builtin_amdgcn_rcpf(d.y);
    f32x2 q = t * 0.5307027145f + (-0.7265760135f); q = q * t + 0.7107068705f; q = q * t + (-0.142248368f); q = q * t + 0.127414796f; q = q * t;
    const f32x2 s = (v * v) * (-0.72134752044f);
    f32x2 e; e.x = __builtin_amdgcn_exp2f(s.x); e.y = __builtin_amdgcn_exp2f(s.y);
    const f32x2 m = v * (q * e), r = v - m;
    f32x2 o; o.x = v.x < 0.f ? m.x : r.x; o.y = v.y < 0.f ? m.y : r.y; return o;
}

#ifndef PG8_STMODE
#define PG8_STMODE 0
#endif
#if PG8_STMODE == 1
#define PG8_ST16(p, v) asm volatile("global_store_dwordx4 %0, %1, off sc1\n\ts_nop 1" :: "v"(p), "v"(v) : "memory")
#elif PG8_STMODE == 2
#define PG8_ST16(p, v) asm volatile("global_store_dwordx4 %0, %1, off nt\n\ts_nop 1" :: "v"(p), "v"(v) : "memory")
#elif PG8_STMODE == 4
#define PG8_ST16(p, v) asm volatile("global_store_dwordx4 %0, %1, off\n\ts_nop 1" :: "v"(p), "v"(v) : "memory")
#elif PG8_STMODE == 3
#define PG8_ST16(p, v) asm volatile("global_store_dwordx4 %0, %1, off sc0 sc1\n\ts_nop 1" :: "v"(p), "v"(v) : "memory")
#else
#define PG8_ST16(p, v) (*(u32x4*)(p) = (v))
#endif
template <int ACT  > struct EpiBf16 {
    static constexpr bool PERM = true, AFTER_DRAIN = false; static_assert(ACT == 0 || ACT == 1, "EpiBf16: ACT is 0 (none) or 1 (gelu_pk)");
    bf16_t* O; int ldc; const float* bias; int split_cols; size_t split_stride; float scale0; int skip; bf16_t* scratch;
    __device__ __forceinline__ void operator()(const f32x4 (&acc)[2][2][4][2], const Unit& u, int wr, int wc, int fr, int fq) const {
        if (skip == 1) return;
        const int row0 = u.pm * BM + wr * 64 + fr; int colt = u.pn * BM; bf16_t* base = O;
        float sc = 1.f; if (split_cols) { const int t = colt / split_cols; base += (size_t)t * split_stride; colt -= t * split_cols; if (t == 0) sc = scale0; }
        const int col0 = colt + wc * 32 + 8 * fq, bcol0 = u.pn * BM + wc * 32 + 8 * fq;
        f32x4 bv[2][2];
#pragma unroll
        for (int bj = 0; bj < 2; ++bj)
#pragma unroll
            for (int n = 0; n < 2; ++n) bv[bj][n] = bias ? *(const f32x4*)(bias + bcol0 + bj * HALF + 4 * n) : (f32x4){0.f, 0.f, 0.f, 0.f};
#pragma unroll
        for (int ai = 0; ai < 2; ++ai)
#pragma unroll
            for (int m = 0; m < 4; ++m) { bf16_t* rowp = base + (size_t)(row0 + ai * HALF + m * 16) * ldc + col0; int bjs = HALF;
                if (skip == 2) { rowp = scratch + ((size_t)((((u.pm * 8 + u.pn) & 1023) * 8 + wr * 4 + wc) * 16 + (ai * 4 + m) * 2)) * 512 + (fq * 16 + fr) * 8; bjs = 512; }
#pragma unroll
                for (int bj = 0; bj < 2; ++bj) { f32x4 v0 = acc[ai][bj][m][0] + bv[bj][0], v1 = acc[ai][bj][m][1] + bv[bj][1];
                    if (ACT == 1) { f32x2 a = gelu_pk((f32x2){v0[0], v0[1]}), b = gelu_pk((f32x2){v0[2], v0[3]}), c = gelu_pk((f32x2){v1[0], v1[1]}), d = gelu_pk((f32x2){v1[2], v1[3]});
                        v0 = (f32x4){a.x, a.y, b.x, b.y}; v1 = (f32x4){c.x, c.y, d.x, d.y}; }
                    v0 = v0 * sc; v1 = v1 * sc; u32x4 w; w.x = cvt_pk_bf16(v0[0], v0[1]); w.y = cvt_pk_bf16(v0[2], v0[3]); w.z = cvt_pk_bf16(v1[0], v1[1]); w.w = cvt_pk_bf16(v1[2], v1[3]);
                    PG8_ST16(rowp + bj * bjs, w); } }
    }
};
template <class Epi, class Sched, bool ALIGN_EPI = false, bool SP2 = false>
__device__ __forceinline__ void gemm_phase(PG8_LAS unsigned char* lds, const Gemm g, const Sched& S, const Epi& E) {
    int tid = threadIdx.x; asm volatile("" : "+v"(tid));
    const int wid = __builtin_amdgcn_readfirstlane(tid >> 6), lane = tid & 63, wr = wid >> 2, wc = wid & 3, fr = lane & 15, fq = lane >> 4;
    const int K = g.K, nt = K / BK;
    unsigned voffA[2], voffB[2];
#pragma unroll
    for (int i = 0; i < 2; ++i) { int R, C; stage_rc(tid * 16 + i * 8192, R, C); const int Rb = Epi::PERM ? ((R & ~31) + perm32(R & 31)) : R;
        voffA[i] = (unsigned)(R * K + C) * 2u; voffB[i] = (unsigned)(Rb * K + C) * 2u; }
    const size_t kstep = (size_t)(BK * 2);
    const size_t hstep = (size_t)HALF * K * 2;
    const size_t tstep = 2 * hstep;
    const unsigned ldsw = (unsigned)wid * 1024u;
    const int aoff = lds_byte(wr * 64 + fr, fq * 8), boff = lds_byte(wc * 32 + fr, fq * 8);
#define PG8_SA(b, h) (((b) * 2 + (h)) * HTB)
#define PG8_SB(b, h) ((4 + (b) * 2 + (h)) * HTB)
#define PG8_STAGE(bufoff, gbase, voff) do { _Pragma("unroll") for (int _i = 0; _i < 2; ++_i) \
        __builtin_amdgcn_global_load_lds((const unsigned*)((const char*)(gbase) + (voff)[_i]), (PG8_LAS unsigned*)(lds + (bufoff) + ldsw + _i * 8192), 16, 0, 0); } while (0)
#define PG8_LDA(dst, b, h) do { _Pragma("unroll") for (int m = 0; m < 4; ++m) _Pragma("unroll") for (int k = 0; k < 2; ++k) dst[m][k] = *(const PG8_LAS bf16x8*)(lds + PG8_SA(b, h) + aoff + m * 2048 + k * 1024); } while (0)
#define PG8_LDB(dst, b, h) do { _Pragma("unroll") for (int n = 0; n < 2; ++n) _Pragma("unroll") for (int k = 0; k < 2; ++k) dst[n][k] = *(const PG8_LAS bf16x8*)(lds + PG8_SB(b, h) + boff + n * 2048 + k * 1024); } while (0)
#define PG8_MMA(ai, bj, At, Bt) do { __builtin_amdgcn_s_setprio(1); _Pragma("unroll") for (int m = 0; m < 4; ++m) _Pragma("unroll") for (int n = 0; n < 2; ++n) _Pragma("unroll") for (int k = 0; k < 2; ++k) \
        acc[ai][bj][m][n] = __builtin_amdgcn_mfma_f32_16x16x32_bf16(Bt[n][k], At[m][k], acc[ai][bj][m][n], 0, 0, 0); __builtin_amdgcn_s_setprio(0); } while (0)
#define PG8_WAIT_V(n) asm volatile("s_waitcnt vmcnt(" #n ")" ::: "memory")
#define PG8_WAIT_L(n) asm volatile("s_waitcnt lgkmcnt(" #n ")" ::: "memory")
#define PG8_BAR __builtin_amdgcn_s_barrier()
#define PG8_SCHED __builtin_amdgcn_sched_barrier(0)
    Unit cur, nxt; int ui = 0;
    if (!S.next(0, cur)) return;
    f32x4 acc[2][2][4][2];
#pragma unroll
    for (int a = 0; a < 2; ++a)
#pragma unroll
        for (int b = 0; b < 2; ++b)
#pragma unroll
            for (int m = 0; m < 4; ++m)
#pragma unroll
                for (int n = 0; n < 2; ++n) acc[a][b][m][n] = (f32x4){0.f, 0.f, 0.f, 0.f};
    bf16x8 At[4][2], B0[2][2], B1[2][2];
    const char* cA = (const char*)g.A + (size_t)cur.pm * tstep; const char* cB = (const char*)g.Bt + (size_t)cur.pn * tstep;
    S.a_ready(cur);
    if constexpr (SP2) {
        PG8_STAGE(PG8_SB(0, 0), cB, voffB); PG8_STAGE(PG8_SB(0, 1), cB + hstep, voffB); PG8_STAGE(PG8_SA(0, 0), cA, voffA); PG8_STAGE(PG8_SA(0, 1), cA + hstep, voffA);
        if (wr == 1) PG8_BAR;
        PG8_WAIT_V(2); PG8_BAR;
        PG8_STAGE(PG8_SB(1, 0), cB + kstep, voffB); PG8_STAGE(PG8_SA(1, 0), cA + kstep, voffA); PG8_STAGE(PG8_SB(1, 1), cB + hstep + kstep, voffB);
        PG8_WAIT_V(6); PG8_BAR;
    } else {
        PG8_STAGE(PG8_SB(0, 0), cB, voffB); PG8_STAGE(PG8_SA(0, 0), cA, voffA); PG8_STAGE(PG8_SB(0, 1), cB + hstep, voffB); PG8_STAGE(PG8_SA(0, 1), cA + hstep, voffA);
        if (wr == 1) PG8_BAR;
        PG8_WAIT_V(4); PG8_BAR;
        PG8_STAGE(PG8_SB(1, 0), cB + kstep, voffB); PG8_STAGE(PG8_SA(1, 0), cA + kstep, voffA); PG8_STAGE(PG8_SB(1, 1), cB + hstep + kstep, voffB);
        PG8_WAIT_V(6); PG8_BAR;
    }
    for (;;) {
        const bool has_next = S.next(ui + 1, nxt);
        const char* nA = has_next ? (const char*)g.A + (size_t)nxt.pm * tstep : cA; const char* nB = has_next ? (const char*)g.Bt + (size_t)nxt.pn * tstep : cB;
        for (int t = 0; t < nt; t += 2) {
            const bool last = (t == nt - 2);
            const char* a1 = cA + (size_t)(t + 1) * kstep;
            const char* a2 = last ? nA : cA + (size_t)(t + 2) * kstep; const char* b2 = last ? nB : cB + (size_t)(t + 2) * kstep;
            const char* a3 = a2 + kstep; const char* b3 = b2 + kstep;
            if (last && has_next) S.a_ready(nxt);
            if constexpr (SP2) {
            PG8_LDB(B0, 0, 0); PG8_LDB(B1, 0, 1); PG8_SCHED; PG8_LDA(At, 0, 0); PG8_STAGE(PG8_SA(1, 1), a1 + hstep, voffA);
            PG8_WAIT_V(8); PG8_WAIT_L(0); PG8_BAR; PG8_MMA(0, 0, At, B0); PG8_MMA(0, 1, At, B1); PG8_BAR; PG8_SCHED;
            PG8_LDA(At, 0, 1); PG8_STAGE(PG8_SB(0, 0), b2, voffB); PG8_STAGE(PG8_SB(0, 1), b2 + hstep, voffB); PG8_STAGE(PG8_SA(0, 0), a2, voffA);
            PG8_WAIT_V(8); PG8_WAIT_L(0); PG8_BAR; PG8_MMA(1, 0, At, B0); PG8_MMA(1, 1, At, B1); PG8_BAR; PG8_SCHED;
            PG8_LDB(B0, 1, 0); PG8_LDB(B1, 1, 1); PG8_SCHED; PG8_LDA(At, 1, 0); PG8_STAGE(PG8_SA(0, 1), a2 + hstep, voffA);
            PG8_WAIT_V(8); PG8_WAIT_L(0); PG8_BAR; PG8_MMA(0, 0, At, B0); PG8_MMA(0, 1, At, B1); PG8_BAR; PG8_SCHED;
            PG8_LDA(At, 1, 1); PG8_STAGE(PG8_SB(1, 0), b3, voffB); PG8_STAGE(PG8_SB(1, 1), b3 + hstep, voffB); PG8_STAGE(PG8_SA(1, 0), a3, voffA);
            PG8_WAIT_V(8); PG8_WAIT_L(0); PG8_BAR; PG8_MMA(1, 0, At, B0); PG8_MMA(1, 1, At, B1); PG8_BAR; PG8_SCHED;
            } else {
            PG8_LDB(B0, 0, 0); PG8_SCHED; PG8_LDA(At, 0, 0); PG8_STAGE(PG8_SA(1, 1), a1 + hstep, voffA);
            PG8_WAIT_L(8); PG8_BAR; PG8_WAIT_L(0); PG8_MMA(0, 0, At, B0); PG8_BAR; PG8_SCHED;
            PG8_LDB(B1, 0, 1); PG8_STAGE(PG8_SB(0, 0), b2, voffB);
            PG8_BAR; PG8_WAIT_L(0); PG8_MMA(0, 1, At, B1); PG8_BAR;
            PG8_LDA(At, 0, 1); PG8_STAGE(PG8_SA(0, 0), a2, voffA);
            PG8_BAR; PG8_WAIT_L(0); PG8_MMA(1, 0, At, B0); PG8_BAR; PG8_SCHED;
            PG8_STAGE(PG8_SB(0, 1), b2 + hstep, voffB);
            PG8_WAIT_V(6); PG8_BAR; PG8_MMA(1, 1, At, B1); PG8_BAR;
            PG8_LDB(B0, 1, 0); PG8_SCHED; PG8_LDA(At, 1, 0); PG8_STAGE(PG8_SA(0, 1), a2 + hstep, voffA);
            PG8_WAIT_L(8); PG8_BAR; PG8_WAIT_L(0); PG8_MMA(0, 0, At, B0); PG8_BAR; PG8_SCHED;
            PG8_LDB(B1, 1, 1); PG8_STAGE(PG8_SB(1, 0), b3, voffB);
            PG8_BAR; PG8_WAIT_L(0); PG8_MMA(0, 1, At, B1); PG8_BAR;
            PG8_LDA(At, 1, 1); PG8_STAGE(PG8_SA(1, 0), a3, voffA);
            PG8_BAR; PG8_WAIT_L(0); PG8_MMA(1, 0, At, B0); PG8_BAR; PG8_SCHED;
            PG8_STAGE(PG8_SB(1, 1), b3 + hstep, voffB);
            PG8_WAIT_V(6); PG8_BAR; PG8_MMA(1, 1, At, B1); PG8_BAR;
            }
        }
        if constexpr (ALIGN_EPI) { if (wr == 0) PG8_BAR; }
        if constexpr (!Epi::AFTER_DRAIN) { E(acc, cur, wr, wc, fr, fq); S.done(cur); }
        if (!has_next) break;
#pragma unroll
        for (int a = 0; a < 2; ++a)
#pragma unroll
            for (int b = 0; b < 2; ++b)
#pragma unroll
                for (int m = 0; m < 4; ++m)
#pragma unroll
                    for (int n = 0; n < 2; ++n) acc[a][b][m][n] = (f32x4){0.f, 0.f, 0.f, 0.f};
        cur = nxt; cA = nA; cB = nB; ++ui;
        if constexpr (ALIGN_EPI) { if (wr == 1) PG8_BAR; }
    }
    PG8_WAIT_V(0);
    if constexpr (!ALIGN_EPI) { if (wr == 0) PG8_BAR; }
    PG8_BAR;
    if constexpr (Epi::AFTER_DRAIN) { E.fused(acc, cur, wr, wc, fr, fq, lds, wid, lane); S.done(cur); }
#undef PG8_SA
#undef PG8_SB
#undef PG8_STAGE
#undef PG8_LDA
#undef PG8_LDB
#undef PG8_MMA
#undef PG8_WAIT_V
#undef PG8_WAIT_L
#undef PG8_BAR
#undef PG8_SCHED
}
}
namespace pg8 {
struct EpiSwiglu {
    static constexpr bool PERM = true, AFTER_DRAIN = false;
    bf16_t* O; int ldc;
    __device__ __forceinline__ void operator()(const f32x4 (&acc)[2][2][4][2], const Unit& u, int wr, int wc, int fr, int fq) const {
        const int row0 = u.pm * BM + wr * 64 + fr; const int col0 = u.pn * HALF + wc * 32 + 8 * fq;
#pragma unroll
        for (int ai = 0; ai < 2; ++ai)
#pragma unroll
            for (int m = 0; m < 4; ++m) { bf16_t* rowp = O + (size_t)(row0 + ai * HALF + m * 16) * ldc + col0;
                float o[8];
#pragma unroll
                for (int n = 0; n < 2; ++n)
#pragma unroll
                    for (int e = 0; e < 4; ++e) { const float g = acc[ai][0][m][n][e], up = acc[ai][1][m][n][e];
                        o[n * 4 + e] = g * __builtin_amdgcn_rcpf(1.0f + __expf(-g)) * up; }
                u32x4 w; w.x = cvt_pk_bf16(o[0], o[1]); w.y = cvt_pk_bf16(o[2], o[3]); w.z = cvt_pk_bf16(o[4], o[5]); w.w = cvt_pk_bf16(o[6], o[7]);
                PG8_ST16(rowp, w); }
    }
};
}

constexpr int DM = 1024, NBATCH = 32, SEQ = 2048, CTXL = 256, MLAT = NBATCH * SEQ, MCTX = NBATCH * CTXL, MTOT = MLAT + MCTX, FFH = 2816, DEPTH = 4;
constexpr int NMODROW = 33, MODW = 6 * DM;
constexpr int LDS_BYTES = 147456;
constexpr size_t MiB = 1u << 20;
constexpr size_t OFF_MODP = 0;
constexpr size_t OFF_MODS = 26 * MiB;
constexpr size_t OFF_ROPE = 30 * MiB;
constexpr size_t OFF_WS = 32 * MiB;
constexpr size_t OFF_W = 33 * MiB;
constexpr size_t W_FI = 0, W_FO = 44 * MiB, W_AQ = 66 * MiB, W_AO = 72 * MiB, W_BI = 76 * MiB, W_BO = 80 * MiB, W_CQ = 82 * MiB, W_CO = 86 * MiB;
constexpr size_t OFF_XC = 121 * MiB;
constexpr size_t OFF_H = 153 * MiB;
constexpr size_t OFF_Y = 297 * MiB;
constexpr size_t OFF_BIG = 441 * MiB;
constexpr size_t OFF_O = OFF_BIG + 288 * MiB;
constexpr size_t OFF_CTL = OFF_BIG + 432 * MiB;
constexpr size_t CTL_BYTES = 65536;
constexpr size_t OFF_XLB = OFF_CTL + 1 * MiB;
constexpr size_t WS_END = OFF_XLB + 128 * MiB;
constexpr int LDS_XB = LDS_BYTES - 64;

typedef unsigned short bf16;
typedef short bf16x8 __attribute__((ext_vector_type(8)));
typedef short s16x4 __attribute__((ext_vector_type(4)));
typedef float f32x16 __attribute__((ext_vector_type(16)));
typedef float f32x4 __attribute__((ext_vector_type(4)));
typedef float f32x2 __attribute__((ext_vector_type(2)));
typedef unsigned u32x4 __attribute__((ext_vector_type(4)));
typedef unsigned u32x2 __attribute__((ext_vector_type(2)));
#define LAS __attribute__((address_space(3)))

__device__ __forceinline__ unsigned cvtpk(float lo, float hi) { unsigned r; asm volatile("v_cvt_pk_bf16_f32 %0, %1, %2" : "=v"(r) : "v"(lo), "v"(hi)); return r; }
__device__ __forceinline__ float bf2f(short s) { return __uint_as_float(((unsigned)(unsigned short)s) << 16); }
__device__ __forceinline__ float bflo(unsigned w) { return __uint_as_float(w << 16); }
__device__ __forceinline__ float bfhi(unsigned w) { return __uint_as_float(w & 0xffff0000u); }
__device__ __forceinline__ float wave_sum(float v) {
#pragma unroll
    for (int o = 1; o < 64; o <<= 1) v += __shfl_xor(v, o);
    return v;
}

namespace att {
#define SBAR() __builtin_amdgcn_sched_barrier(0)
__device__ __forceinline__ int crow(int r, int hi) { return (r & 3) + 8 * (r >> 2) + 4 * hi; }
template <int DH> __device__ __forceinline__ int kswz(int row, int colB) { return row * (DH * 2) + (colB ^ ((row & 7) << 4)); }
template <int DH> __device__ __forceinline__ int v_st(int k, int c) { const int kk = (k & ~0xC) | ((k & 4) << 1) | ((k & 8) >> 1); return ((kk >> 3) * (DH / 32) + (c >> 5)) * 512 + ((kk & 7) * 32 + (c & 31)) * 2; }
__device__ __forceinline__ int v_rd_base(int lane) { return ((lane & 3) << 3) | (((lane >> 2) & 3) << 6) | (((lane >> 4) & 1) << 5) | (((lane >> 5) & 1) << 8); }
template <int DH> constexpr int v_rd_off(int d0, int ks, int half) { return d0 * 512 + ks * (DH / 32) * 1024 + half * (DH / 32) * 512; }
template <int OFF> __device__ __forceinline__ s16x4 tr_read(int vb) { s16x4 r; asm volatile("ds_read_b64_tr_b16 %0, %1 offset:%2" : "=&v"(r) : "v"(vb), "i"(OFF) : "memory"); return r; }
template <int DH, int D0> __device__ __forceinline__ void pv_one(f32x16& od, int vb, bf16x8 pa0, bf16x8 pa1, bf16x8 pa2, bf16x8 pa3) {
  const s16x4 l0 = tr_read<v_rd_off<DH>(D0, 0, 0)>(vb), h0 = tr_read<v_rd_off<DH>(D0, 0, 1)>(vb), l1 = tr_read<v_rd_off<DH>(D0, 1, 0)>(vb), h1 = tr_read<v_rd_off<DH>(D0, 1, 1)>(vb);
  const s16x4 l2 = tr_read<v_rd_off<DH>(D0, 2, 0)>(vb), h2 = tr_read<v_rd_off<DH>(D0, 2, 1)>(vb), l3 = tr_read<v_rd_off<DH>(D0, 3, 0)>(vb), h3 = tr_read<v_rd_off<DH>(D0, 3, 1)>(vb);
  asm volatile("s_waitcnt lgkmcnt(0)" ::: "memory"); SBAR();
#define PK(L, H) (bf16x8){L[0], L[1], L[2], L[3], H[0], H[1], H[2], H[3]}
  od = __builtin_amdgcn_mfma_f32_32x32x16_bf16(pa0, PK(l0, h0), od, 0, 0, 0);
  od = __builtin_amdgcn_mfma_f32_32x32x16_bf16(pa1, PK(l1, h1), od, 0, 0, 0);
  od = __builtin_amdgcn_mfma_f32_32x32x16_bf16(pa2, PK(l2, h2), od, 0, 0, 0);
  od = __builtin_amdgcn_mfma_f32_32x32x16_bf16(pa3, PK(l3, h3), od, 0, 0, 0);
#undef PK
}
template <int DH> __device__ __forceinline__ void pv_all(f32x16* o, int vb, bf16x8 pa0, bf16x8 pa1, bf16x8 pa2, bf16x8 pa3) {
  pv_one<DH, 0>(o[0], vb, pa0, pa1, pa2, pa3); pv_one<DH, 1>(o[1], vb, pa0, pa1, pa2, pa3);
  if constexpr (DH == 128) { pv_one<DH, 2>(o[2], vb, pa0, pa1, pa2, pa3); pv_one<DH, 3>(o[3], vb, pa0, pa1, pa2, pa3); }
}
template <int DH> struct SC { static constexpr float SCALE = DH == 128 ? 0.088388347648318440f : 0.125f; static constexpr float C = SCALE * 1.4426950408889634f; static constexpr float THRS = 8.f / SCALE; };
template <int DH> __device__ __forceinline__ void partialSM(f32x16& p0, f32x16& p1, float& m_reg, float& mn, float& alpha) {
  constexpr float C = SC<DH>::C;
  float pmax = p0[0];
#pragma unroll
  for (int r = 1; r < 16; ++r) pmax = fmaxf(pmax, p0[r]);
#pragma unroll
  for (int r = 0; r < 16; ++r) pmax = fmaxf(pmax, p1[r]);
  { auto rr = __builtin_amdgcn_permlane32_swap(__float_as_uint(pmax), __float_as_uint(pmax), false, false);
    pmax = fmaxf(__uint_as_float(rr[0]), __uint_as_float(rr[1])); }
  if (__builtin_expect(__all(pmax - m_reg <= SC<DH>::THRS), 1)) { mn = m_reg; alpha = 1.f; }
  else { mn = fmaxf(m_reg, pmax); alpha = __builtin_amdgcn_exp2f((m_reg - mn) * C); m_reg = mn; }
  const float mnC = -mn * C;
#pragma unroll
  for (int r = 0; r < 16; ++r) p0[r] = fmaf(p0[r], C, mnC);
#pragma unroll
  for (int r = 0; r < 16; ++r) p1[r] = fmaf(p1[r], C, mnC);
#pragma unroll
  for (int r = 0; r < 16; ++r) p0[r] = __builtin_amdgcn_exp2f(p0[r]);
}
__device__ __forceinline__ void finishSM(f32x16& p0, f32x16& p1, float alpha, float& l_reg, bf16x8& pa0, bf16x8& pa1, bf16x8& pa2, bf16x8& pa3) {
#pragma unroll
  for (int r = 0; r < 16; ++r) p1[r] = __builtin_amdgcn_exp2f(p1[r]);
  float ps = 0;
#pragma unroll
  for (int r = 0; r < 16; ++r) ps += p0[r];
#pragma unroll
  for (int r = 0; r < 16; ++r) ps += p1[r];
  { auto rr = __builtin_amdgcn_permlane32_swap(__float_as_uint(ps), __float_as_uint(ps), false, false);
    ps = __uint_as_float(rr[0]) + __uint_as_float(rr[1]); }
  l_reg = l_reg * alpha + ps;
#define PK4(P, BASE, OUT) do { unsigned a0 = cvtpk(P[BASE + 0], P[BASE + 1]), a1 = cvtpk(P[BASE + 2], P[BASE + 3]);   \
    unsigned b0 = cvtpk(P[BASE + 4], P[BASE + 5]), b1 = cvtpk(P[BASE + 6], P[BASE + 7]);                              \
    auto r0 = __builtin_amdgcn_permlane32_swap(a0, b0, false, false); auto r1 = __builtin_amdgcn_permlane32_swap(a1, b1, false, false); \
    u32x4 w = {r0[0], r1[0], r0[1], r1[1]}; OUT = *reinterpret_cast<bf16x8*>(&w); } while (0)
  PK4(p0, 0, pa0); PK4(p0, 8, pa1); PK4(p1, 0, pa2); PK4(p1, 8, pa3);
#undef PK4
}
template <int DH> __device__ __forceinline__ void qkt(f32x16& p0, f32x16& p1, const char* Ks, const bf16x8* qr, int r32, int hi) {
  p0 = f32x16{}; p1 = f32x16{};
#pragma unroll
  for (int d0 = 0; d0 < DH / 16; ++d0) { const int cb = (d0 * 16 + hi * 8) * 2;
    const bf16x8 b0 = *reinterpret_cast<const bf16x8*>(Ks + kswz<DH>(r32, cb));
    const bf16x8 b1 = *reinterpret_cast<const bf16x8*>(Ks + kswz<DH>(32 + r32, cb));
    p0 = __builtin_amdgcn_mfma_f32_32x32x16_bf16(b0, qr[d0], p0, 0, 0, 0);
    p1 = __builtin_amdgcn_mfma_f32_32x32x16_bf16(b1, qr[d0], p1, 0, 0, 0); }
}
__device__ __forceinline__ void wmask(f32x16& p0, f32x16& p1, int kp0, int qp, int hi) {
  const int d0 = kp0 + 4 * hi - qp;
#pragma unroll
  for (int r = 0; r < 16; ++r) { const int d = d0 + (r & 3) + 8 * (r >> 2); if (d > 128 || d < -128) p0[r] = -1e30f; if (d + 32 > 128 || d + 32 < -128) p1[r] = -1e30f; }
}
struct UnitDesc {
  const bf16* Q; const bf16* Kc; const bf16* Vc; bf16* O;
  long ctx_row0, lat_row0; int nctx, band_kp0, NT, qpos0;
  const float* cosT; const float* sinT; const float* qg; float sink_l2;
};
template <int DH, int PITCH, bool QKNORM, bool MASK>
__device__ __forceinline__ void attn_unit(const UnitDesc& u, char* lds) {
  constexpr int NB = DH / 16, NO = DH / 32, TB = 64 * DH * 2, NLD = DH / 64, SDEPTH = DH == 128 ? 1 : 2;
  int tid = threadIdx.x; asm volatile("" : "+v"(tid));
  const int wid = tid >> 6, lane = tid & 63, r32 = lane & 31, hi = lane >> 5;
  char* V_lds = lds; char* K_lds = lds + 2 * TB;
  float* ws = (float*)(lds + 4 * TB) + wid * 64; float* li_l = ws; float* al_l = ws + 32;
  float m_reg = -1e30f, l_reg = 0; f32x16 o[NO];
#pragma unroll
  for (int d = 0; d < NO; ++d) o[d] = f32x16{};
  bf16x8 qr[NB];
  {
    const bf16* Qw = u.Q + (long)(wid * 32 + r32) * PITCH + hi * 8;
    float qf[NB][8];
#pragma unroll
    for (int d0 = 0; d0 < NB; ++d0) { const bf16x8 raw = *reinterpret_cast<const bf16x8*>(Qw + d0 * 16);
#pragma unroll
      for (int j = 0; j < 8; ++j) qf[d0][j] = bf2f(raw[j]); }
    if constexpr (QKNORM) {
      float ss = 0.f;
#pragma unroll
      for (int d0 = 0; d0 < NB; ++d0)
#pragma unroll
        for (int j = 0; j < 8; ++j) ss += qf[d0][j] * qf[d0][j];
      ss += __shfl_xor(ss, 32);
      const float rstd = rsqrtf(ss * (1.0f / DH) + 1e-6f);
#pragma unroll
      for (int d0 = 0; d0 < NB; ++d0) { const f32x4 g0 = *(const f32x4*)(u.qg + d0 * 16 + hi * 8), g1 = *(const f32x4*)(u.qg + d0 * 16 + hi * 8 + 4);
#pragma unroll
        for (int j = 0; j < 4; ++j) { qf[d0][j] *= rstd * g0[j]; qf[d0][4 + j] *= rstd * g1[j]; } }
    }
    if (u.qpos0 >= 0) {
      const int pos = u.qpos0 + wid * 32 + r32;
      const float* cp = u.cosT + (long)pos * (DH / 2) + hi * 8; const float* sp = u.sinT + (long)pos * (DH / 2) + hi * 8;
#pragma unroll
      for (int d0 = 0; d0 < NB / 2; ++d0) {
        const f32x4 c0 = *(const f32x4*)(cp + d0 * 16), c1 = *(const f32x4*)(cp + d0 * 16 + 4), s0 = *(const f32x4*)(sp + d0 * 16), s1 = *(const f32x4*)(sp + d0 * 16 + 4);
#pragma unroll
        for (int j = 0; j < 8; ++j) { const float c = j < 4 ? c0[j & 3] : c1[j & 3], s = j < 4 ? s0[j & 3] : s1[j & 3];
          const float x1 = qf[d0][j], x2 = qf[d0 + NB / 2][j]; qf[d0][j] = x1 * c - x2 * s; qf[d0 + NB / 2][j] = x2 * c + x1 * s; }
      }
    }
#pragma unroll
    for (int d0 = 0; d0 < NB; ++d0) { u32x4 w = {cvtpk(qf[d0][0], qf[d0][1]), cvtpk(qf[d0][2], qf[d0][3]), cvtpk(qf[d0][4], qf[d0][5]), cvtpk(qf[d0][6], qf[d0][7])}; qr[d0] = *reinterpret_cast<bf16x8*>(&w); }
  }
  const int sr = DH == 128 ? (tid >> 4) : (tid >> 3), sc = DH == 128 ? (tid & 15) * 8 : (tid & 7) * 8;
  const int vb0 = (int)(uintptr_t)V_lds + v_rd_base(lane);
  struct { bf16x8 v[NLD], k[NLD]; } st_[SDEPTH];
  const int qp = u.qpos0 + wid * 32 + r32;
#define TROW(t) ((t) < u.nctx ? u.ctx_row0 + 64 * (t) : u.lat_row0 + u.band_kp0 + 64 * ((t) - u.nctx))
#define TKP(t) (u.band_kp0 + 64 * ((t) - u.nctx))
#define SLOAD(i, t) do { const long row_ = TROW(t); _Pragma("unroll") for (int l_ = 0; l_ < NLD; ++l_) { \
    st_[i].v[l_] = *reinterpret_cast<const bf16x8*>(u.Vc + (row_ + sr + 32 * l_) * PITCH + sc); st_[i].k[l_] = *reinterpret_cast<const bf16x8*>(u.Kc + (row_ + sr + 32 * l_) * PITCH + sc); } } while (0)
#define SWRITE(b, i) do { _Pragma("unroll") for (int l_ = 0; l_ < NLD; ++l_) { *(bf16x8*)(V_lds + (b) * TB + v_st<DH>(sr + 32 * l_, sc)) = st_[i].v[l_]; \
    *(bf16x8*)(K_lds + (b) * TB + kswz<DH>(sr + 32 * l_, sc * 2)) = st_[i].k[l_]; } } while (0)
#define SWAIT() do { if constexpr (SDEPTH == 1) asm volatile("s_waitcnt vmcnt(0)" ::: "memory"); else if constexpr (NLD == 2) asm volatile("s_waitcnt vmcnt(4)" ::: "memory"); else asm volatile("s_waitcnt vmcnt(2)" ::: "memory"); } while (0)
#define RESC(a) do { if (__any((a) < 1.f)) { if (hi == 0) al_l[r32] = (a); asm volatile("s_waitcnt lgkmcnt(0)" ::: "memory"); \
    _Pragma("unroll") for (int d = 0; d < NO; ++d) _Pragma("unroll") for (int r = 0; r < 16; ++r) o[d][r] *= al_l[crow(r, hi)]; } } while (0)
#define AMASK(P0, P1, t) do { if constexpr (MASK) { if ((t) >= u.nctx && (TKP(t) < qw - 97 || TKP(t) + 63 > qw + 128)) wmask(P0, P1, TKP(t), qp, hi); } } while (0)
  f32x16 pA0, pA1, pB0, pB1; float mnA, mnB, alA, alB; bf16x8 pa0, pa1, pa2, pa3; const int NT = u.NT;
  constexpr int SE = 0, SO = SDEPTH - 1;
  const int qw = __builtin_amdgcn_readfirstlane(u.qpos0 + wid * 32);
#define ACT(t) (!MASK || (t) < u.nctx || (TKP(t) <= qw + 159 && TKP(t) + 63 >= qw - 128))
  bool actA = true, actB = true;
  SLOAD(SE, 0); asm volatile("s_waitcnt vmcnt(0)" ::: "memory"); SWRITE(0, SE); __syncthreads();
  qkt<DH>(pA0, pA1, K_lds, qr, r32, hi); AMASK(pA0, pA1, 0); partialSM<DH>(pA0, pA1, m_reg, mnA, alA);
  SLOAD(SO, 1); if constexpr (SDEPTH == 2) { if (2 < NT) SLOAD(SE, 2); }
  SWAIT(); SWRITE(1, SO); __syncthreads();
  for (int j = 1; j + 1 < NT; j += 2) {
    actB = ACT(j);
    SBAR(); if (actB) { qkt<DH>(pB0, pB1, K_lds + TB, qr, r32, hi); AMASK(pB0, pB1, j); }
    if (actA) finishSM(pA0, pA1, alA, l_reg, pa0, pa1, pa2, pa3); SBAR();
    SLOAD(SO, j + SDEPTH); SBAR();
    if (actA) pv_all<DH>(o, vb0, pa0, pa1, pa2, pa3);
    if (actB) partialSM<DH>(pB0, pB1, m_reg, mnB, alB); else alB = 1.f;
    __syncthreads(); SWAIT(); SWRITE(0, SE);
    RESC(alB); __syncthreads();
    actA = ACT(j + 1);
    SBAR(); if (actA) { qkt<DH>(pA0, pA1, K_lds, qr, r32, hi); AMASK(pA0, pA1, j + 1); }
    if (actB) finishSM(pB0, pB1, alB, l_reg, pa0, pa1, pa2, pa3); SBAR();
    if (SDEPTH == 1 || j + 3 < NT) SLOAD(SE, j + 1 + SDEPTH); SBAR();
    if (actB) pv_all<DH>(o, vb0 + TB, pa0, pa1, pa2, pa3);
    if (actA) partialSM<DH>(pA0, pA1, m_reg, mnA, alA); else alA = 1.f;
    __syncthreads(); SWAIT(); SWRITE(1, SO);
    RESC(alA); __syncthreads();
  }
  actB = ACT(NT - 1);
  SBAR(); if (actB) { qkt<DH>(pB0, pB1, K_lds + TB, qr, r32, hi); AMASK(pB0, pB1, NT - 1); }
  if (actA) finishSM(pA0, pA1, alA, l_reg, pa0, pa1, pa2, pa3); SBAR();
  if (actA) pv_all<DH>(o, vb0, pa0, pa1, pa2, pa3);
  if (actB) partialSM<DH>(pB0, pB1, m_reg, mnB, alB); else alB = 1.f;
  __syncthreads(); RESC(alB);
  if (actB) { finishSM(pB0, pB1, alB, l_reg, pa0, pa1, pa2, pa3); SBAR();
    pv_all<DH>(o, vb0 + TB, pa0, pa1, pa2, pa3); }
#undef ACT
  l_reg += __builtin_amdgcn_exp2f(u.sink_l2 - m_reg * SC<DH>::C);
  if (hi == 0) li_l[r32] = l_reg; asm volatile("s_waitcnt lgkmcnt(0)" ::: "memory");
  float rli[16];
#pragma unroll
  for (int r = 0; r < 16; ++r) rli[r] = __builtin_amdgcn_rcpf(li_l[crow(r, hi)]);
  { bf16* stg = (bf16*)(lds + 4 * TB + 2048) + wid * (32 * DH);
#pragma unroll
    for (int r = 0; r < 16; ++r) { const int orow = crow(r, hi);
#pragma unroll
      for (int d0 = 0; d0 < NO; ++d0) { const float v = o[d0][r] * rli[r]; const unsigned w = cvtpk(v, v); stg[orow * DH + d0 * 32 + r32] = (bf16)(w & 0xffffu); } }
    asm volatile("s_waitcnt lgkmcnt(0)" ::: "memory");
    constexpr int CPR = DH / 8, RPI = 64 / CPR;
    bf16* Ow = u.O + (long)(wid * 32) * DM;
#pragma unroll
    for (int i = 0; i < 32 / RPI; ++i) { const int row = i * RPI + lane / CPR, ch = lane % CPR; const u32x4 v = *(const u32x4*)(stg + row * DH + ch * 8); *(u32x4*)(Ow + (long)row * DM + ch * 8) = v; } }
  __syncthreads();
#undef TROW
#undef TKP
#undef SLOAD
#undef SWRITE
#undef SWAIT
#undef RESC
#undef AMASK
}
}

__device__ __forceinline__ void transpose_item(const float* W, int K, int N, bf16* WT, int k0, int n0, int drow0, LAS float* scr, int lane) {
    float tv[32];
#pragma unroll
    for (int i = 0; i < 32; ++i) tv[i] = W[(size_t)(k0 + 2 * i + (lane >> 5)) * N + n0 + (lane & 31)];
#pragma unroll
    for (int i = 0; i < 32; ++i) scr[(2 * i + (lane >> 5)) * 33 + (lane & 31)] = tv[i];
    asm volatile("s_waitcnt lgkmcnt(0)" ::: "memory");
    const int c = lane & 7;
#pragma unroll
    for (int j = 0; j < 4; ++j) { const int n = (lane >> 3) + 8 * j; const LAS float* s = scr + (8 * c) * 33 + n;
        u32x4 o; o.x = cvtpk(s[0 * 33], s[1 * 33]); o.y = cvtpk(s[2 * 33], s[3 * 33]); o.z = cvtpk(s[4 * 33], s[5 * 33]); o.w = cvtpk(s[6 * 33], s[7 * 33]);
        *(u32x4*)(WT + (size_t)(drow0 + n) * K + k0 + 8 * c) = o; }
    asm volatile("s_waitcnt lgkmcnt(0)" ::: "memory");
}
__device__ __forceinline__ int ffn_in_row(int n0) { return n0 < FFH ? 256 * (n0 >> 7) + (n0 & 127) : 256 * ((n0 - FFH) >> 7) + 128 + ((n0 - FFH) & 127); }

struct RowJob { const float* xin; const bf16* y; float* xout; bf16* h; const float* gate; const float* sh; const float* sc; };
template <int NR, bool HASY, bool HASH>
__device__ __forceinline__ void combine_rows(const RowJob (&J)[NR], const float* npost, const float* npre, int lane, float gmul) {
    f32x4 xv[NR][4]; u32x2 yv[NR][4];
#pragma unroll
    for (int q = 0; q < NR; ++q)
#pragma unroll
        for (int j = 0; j < 4; ++j) { xv[q][j] = ((const f32x4*)J[q].xin)[lane + 64 * j]; if constexpr (HASY) yv[q][j] = ((const u32x2*)J[q].y)[lane + 64 * j]; }
    if constexpr (HASY) {
        float rstd[NR];
#pragma unroll
        for (int q = 0; q < NR; ++q) { float ss = 0.f;
#pragma unroll
            for (int j = 0; j < 4; ++j) { const float a = bflo(yv[q][j].x), b = bfhi(yv[q][j].x), c = bflo(yv[q][j].y), d = bfhi(yv[q][j].y); ss += (a * a + b * b) + (c * c + d * d); }
            rstd[q] = rsqrtf(wave_sum(ss) * (1.0f / DM) + 1e-6f) * gmul; }
#pragma unroll
        for (int j = 0; j < 4; ++j) { const f32x4 n4 = ((const f32x4*)npost)[lane + 64 * j];
#pragma unroll
            for (int q = 0; q < NR; ++q) { const f32x4 g4 = ((const f32x4*)J[q].gate)[lane + 64 * j];
                const f32x4 yf = {bflo(yv[q][j].x), bfhi(yv[q][j].x), bflo(yv[q][j].y), bfhi(yv[q][j].y)};
                xv[q][j] = xv[q][j] + g4 * (yf * rstd[q] * n4);
                ((f32x4*)J[q].xout)[lane + 64 * j] = xv[q][j]; } }
    }
    if constexpr (HASH) {
        float rstd[NR];
#pragma unroll
        for (int q = 0; q < NR; ++q) { float ss = 0.f;
#pragma unroll
            for (int j = 0; j < 4; ++j) ss += (xv[q][j].x * xv[q][j].x + xv[q][j].y * xv[q][j].y) + (xv[q][j].z * xv[q][j].z + xv[q][j].w * xv[q][j].w);
            rstd[q] = rsqrtf(wave_sum(ss) * (1.0f / DM) + 1e-6f); }
#pragma unroll
        for (int j = 0; j < 4; ++j) { const f32x4 n4 = ((const f32x4*)npre)[lane + 64 * j];
#pragma unroll
            for (int q = 0; q < NR; ++q) { const f32x4 s4 = ((const f32x4*)J[q].sc)[lane + 64 * j], b4 = ((const f32x4*)J[q].sh)[lane + 64 * j];
                const f32x4 hv = (xv[q][j] * rstd[q] * n4) * (s4 + 1.0f) + b4;
                u32x2 w; w.x = cvtpk(hv.x, hv.y); w.y = cvtpk(hv.z, hv.w); ((u32x2*)J[q].h)[lane + 64 * j] = w; } }
    }
}

template <bool HASY, bool HASH, bool XIN32 = true, bool XOUT32 = true>
__device__ __forceinline__ void combine_span(int mb, int me, const void* xin_lat, const void* xin_ctx, void* xout_lat, void* xout_ctx, const bf16* Y, bf16* H,
                                             const float* gate0, const float* npost, const float* sh0, const float* sc0, const float* npre, int lane, float gmul) {
    int cur_r = -1; f32x4 A1[4], A2[4], B2[4];
    for (int m = mb; m < me;) {
        const int r = m < MLAT ? (m >> 11) : 32;
        if (r != cur_r) { cur_r = r;
#pragma unroll
            for (int j = 0; j < 4; ++j) {
                if constexpr (HASY) A1[j] = ((const f32x4*)(gate0 + (size_t)r * MODW))[lane + 64 * j] * ((const f32x4*)npost)[lane + 64 * j] * gmul;
                if constexpr (HASH) { A2[j] = ((const f32x4*)npre)[lane + 64 * j] * (((const f32x4*)(sc0 + (size_t)r * MODW))[lane + 64 * j] + 1.0f); B2[j] = ((const f32x4*)(sh0 + (size_t)r * MODW))[lane + 64 * j]; } } }
        const int mn = m + 1; const bool two = mn < me && (mn < MLAT ? (mn >> 11) : 32) == r;
        const int mq[2] = {m, two ? mn : m};
        f32x4 xv[2][4]; u32x2 yv[2][4];
#pragma unroll
        for (int q = 0; q < 2; ++q) { const int mm = mq[q]; const size_t eo = mm < MLAT ? (size_t)mm * DM : (size_t)(mm - MLAT) * DM; const void* xb = mm < MLAT ? xin_lat : xin_ctx;
#pragma unroll
            for (int j = 0; j < 4; ++j) {
                if constexpr (XIN32) xv[q][j] = ((const f32x4*)((const float*)xb + eo))[lane + 64 * j];
                else { const u32x2 w = ((const u32x2*)((const bf16*)xb + eo))[lane + 64 * j]; xv[q][j] = (f32x4){bflo(w.x), bfhi(w.x), bflo(w.y), bfhi(w.y)}; }
                if constexpr (HASY) yv[q][j] = ((const u32x2*)(Y + (size_t)mm * DM))[lane + 64 * j]; } }
        if constexpr (HASY) {
            float rstd[2];
#pragma unroll
            for (int q = 0; q < 2; ++q) { float ss = 0.f;
#pragma unroll
                for (int j = 0; j < 4; ++j) { const float a = bflo(yv[q][j].x), b = bfhi(yv[q][j].x), c = bflo(yv[q][j].y), d = bfhi(yv[q][j].y); ss += (a * a + b * b) + (c * c + d * d); }
                rstd[q] = rsqrtf(wave_sum(ss) * (1.0f / DM) + 1e-6f); }
#pragma unroll
            for (int q = 0; q < 2; ++q) { const int mm = mq[q]; const size_t eo = mm < MLAT ? (size_t)mm * DM : (size_t)(mm - MLAT) * DM; void* xb = mm < MLAT ? xout_lat : xout_ctx;
#pragma unroll
                for (int j = 0; j < 4; ++j) { const f32x4 yf = {bflo(yv[q][j].x), bfhi(yv[q][j].x), bflo(yv[q][j].y), bfhi(yv[q][j].y)};
                    xv[q][j] = xv[q][j] + A1[j] * (yf * rstd[q]);
                    if constexpr (XOUT32) ((f32x4*)((float*)xb + eo))[lane + 64 * j] = xv[q][j];
                    else { u32x2 w; w.x = cvtpk(xv[q][j].x, xv[q][j].y); w.y = cvtpk(xv[q][j].z, xv[q][j].w); ((u32x2*)((bf16*)xb + eo))[lane + 64 * j] = w;
                        xv[q][j] = (f32x4){bflo(w.x), bfhi(w.x), bflo(w.y), bfhi(w.y)}; } } }
        }
        if constexpr (HASH) {
            float rstd[2];
#pragma unroll
            for (int q = 0; q < 2; ++q) { float ss = 0.f;
#pragma unroll
                for (int j = 0; j < 4; ++j) ss += (xv[q][j].x * xv[q][j].x + xv[q][j].y * xv[q][j].y) + (xv[q][j].z * xv[q][j].z + xv[q][j].w * xv[q][j].w);
                rstd[q] = rsqrtf(wave_sum(ss) * (1.0f / DM) + 1e-6f); }
#pragma unroll
            for (int q = 0; q < 2; ++q) { const int mm = mq[q];
#pragma unroll
                for (int j = 0; j < 4; ++j) { const f32x4 hv = (xv[q][j] * rstd[q]) * A2[j] + B2[j];
                    u32x2 w; w.x = cvtpk(hv.x, hv.y); w.y = cvtpk(hv.z, hv.w); ((u32x2*)(H + (size_t)mm * DM))[lane + 64 * j] = w; } }
        }
        m += two ? 2 : 1;
    }
}

#define XB_TMO      128
#define XB_XCNT(j)  (256  + 64 * (j))
#define XB_XSUB(j)  (1280 + 64 * (j))
#define XB_XGEN(j)  (2304 + 64 * (j))
#define XB_TOP      3328
#define XB_TOPGEN   3392
#define XCD_BAR_WORDS 3456
#define XB_SPIN_CAP (1u << 18)

__device__ __forceinline__ unsigned xb_ld(unsigned* p)              { return __hip_atomic_load(p, __ATOMIC_RELAXED, __HIP_MEMORY_SCOPE_AGENT); }
__device__ __forceinline__ unsigned xb_add(unsigned* p, unsigned v) { return __hip_atomic_fetch_add(p, v, __ATOMIC_RELAXED, __HIP_MEMORY_SCOPE_AGENT); }
__device__ __forceinline__ unsigned xb_xcc_id() { return (unsigned)__builtin_amdgcn_s_getreg((3 << 11) | 20) & 0xFu; }
#define XB_SPIN(cond, bar) do { unsigned _sp = 0; while (cond) { __builtin_amdgcn_s_sleep(1); \
    if ((++_sp & 255u) == 0u) { if (xb_ld(&(bar)[XB_TMO])) break; if (_sp > XB_SPIN_CAP) { atomicAdd(&(bar)[XB_TMO], 1u); break; } } } } while (0)

struct XcdBarrier {
    unsigned* bar; unsigned x;
    volatile LAS unsigned* st;
};

__device__ __forceinline__ XcdBarrier xcd_barrier_post(unsigned* bar, volatile LAS unsigned* st) {
    XcdBarrier b; b.bar = bar; b.x = xb_xcc_id(); b.st = st;
    if (threadIdx.x == 0) (void)xb_add(&bar[XB_XCNT(b.x)], 1u);
    return b;
}
__device__ __forceinline__ void xcd_barrier_complete(unsigned* bar, unsigned x, unsigned& nloc, unsigned& nx) {
    const unsigned G = gridDim.x * gridDim.y * gridDim.z;
    unsigned sum, cnt, mine, sp = 0u;
    for (;;) {
        sum = 0u; cnt = 0u; mine = 0u;
#pragma unroll
        for (unsigned j = 0; j < 16; ++j) { const unsigned c = xb_ld(&bar[XB_XCNT(j)]); sum += c; cnt += (c > 0u) ? 1u : 0u; mine = (j == x) ? c : mine; }
        if (sum == G) break;
        __builtin_amdgcn_s_sleep(1);
        if ((++sp & 255u) == 0u) { if (xb_ld(&bar[XB_TMO])) break; if (sp > XB_SPIN_CAP) { atomicAdd(&bar[XB_TMO], 1u); break; } }
    }
    nloc = mine > 0u ? mine : 1u; nx = cnt > 0u ? cnt : 1u;
}

__device__ __forceinline__ void xcd_barrier(const XcdBarrier& b) {
    asm volatile("s_waitcnt vmcnt(0)" ::: "memory");
    __syncthreads();
    if (threadIdx.x == 0) {
        unsigned* bar = b.bar;
        __builtin_amdgcn_s_waitcnt(0);
        unsigned nloc = b.st[0], nx = b.st[1];
        if (nloc == 0u) { xcd_barrier_complete(bar, b.x, nloc, nx); b.st[0] = nloc; b.st[1] = nx; }
        const unsigned old = xb_add(&bar[XB_XSUB(b.x)], 1u);
        const unsigned gen = old / nloc;
        if (old + 1u == (gen + 1u) * nloc) {
            __builtin_amdgcn_fence(__ATOMIC_RELEASE, "agent");
            asm volatile("s_waitcnt vmcnt(0)" ::: "memory");
            const unsigned og = xb_add(&bar[XB_TOP], 1u);
            const unsigned tg = og / nx;
            if (og + 1u == (tg + 1u) * nx) xb_add(&bar[XB_TOPGEN], 1u);
            else XB_SPIN(xb_ld(&bar[XB_TOPGEN]) == tg, bar);
            __builtin_amdgcn_fence(__ATOMIC_ACQUIRE, "agent");
            xb_add(&bar[XB_XGEN(b.x)], 1u);
            asm volatile("s_waitcnt vmcnt(0)" ::: "memory");
        } else {
            XB_SPIN(xb_ld(&bar[XB_XGEN(b.x)]) == gen, bar);
            __builtin_amdgcn_fence(__ATOMIC_ACQUIRE, "agent");
            asm volatile("s_waitcnt vmcnt(0)" ::: "memory");
        }
    }
    __syncthreads();
}

struct Args { const float* in[23]; float* out; unsigned char* ws; int ph_lo, ph_hi; };

__global__ void __launch_bounds__(512, 2) mega(Args args) {
    extern __shared__ __attribute__((aligned(16))) unsigned char lds[];
    cg::grid_group grid = cg::this_grid();
    const int G = gridDim.x, bx = blockIdx.x;
    const int vcu = (G % 8 == 0) ? (bx % 8) * (G / 8) + bx / 8 : bx;
    const int NGW = G * 8;
    const int lo = args.ph_lo, hi = args.ph_hi;
    unsigned char* ws = args.ws;
    const float* x_in = args.in[0]; const float* c_in = args.in[1]; const float* ctx_in = args.in[2]; const float* cctx_in = args.in[3];
    const float* ada_w = args.in[4]; const float* ada_b = args.in[5]; const float* norm_g = args.in[6];
    float* modp = (float*)(ws + OFF_MODP); float* mods = (float*)(ws + OFF_MODS);
    float* cosA = (float*)(ws + OFF_ROPE); float* sinA = cosA + 2048 * 32; float* cosC = sinA + 2048 * 32; float* sinC = cosC + 2048 * 64;
    bf16* Wsb = (bf16*)(ws + OFF_WS);
    unsigned char* Wb = ws + OFF_W;
#ifndef XBF16
#define XBF16 0
#endif
    void* XC = (void*)(ws + OFF_XC); void* XL = XBF16 ? (void*)(ws + OFF_XLB) : (void*)args.out;
    bf16* Hb = (bf16*)(ws + OFF_H); bf16* Yb = (bf16*)(ws + OFF_Y); bf16* QKV = (bf16*)(ws + OFF_BIG); bf16* Ob = (bf16*)(ws + OFF_O); bf16* HID = (bf16*)(ws + OFF_BIG);
    if (threadIdx.x < 16) ((LAS unsigned*)((LAS unsigned char*)lds + LDS_XB))[threadIdx.x] = 0u;
    __syncthreads();
    const XcdBarrier xbar = xcd_barrier_post((unsigned*)(ws + OFF_CTL), (volatile LAS unsigned*)((LAS unsigned char*)lds + LDS_XB));
    bool first_seam = false;
    int ph = 0;
#define GSYNC() do { if (first_seam) { grid.sync(); first_seam = false; } else xcd_barrier(xbar); } while (0)
    first_seam = args.ph_hi < 0;
#ifndef PH_MASK
#define PH_MASK 0xffff
#endif
#define RUN(p) (lo <= (p) && (p) < hi)
#define ON(b) ((PH_MASK >> (b)) & 1)
#ifndef G1MASK
#define G1MASK 7
#endif
#ifndef ATMASK
#define ATMASK 3
#endif
#define ATK(k) ((ATMASK >> (k)) & 1)
#define G1K(k) ((G1MASK >> (k)) & 1)
#define SEAM(p) do { if (RUN(p) && RUN((p) + 1)) GSYNC(); } while (0)

#ifndef NPRO
#define NPRO 1
#endif
#ifndef CMB_F1
#define CMB_F1 5
#endif
#ifndef CMB_F2
#define CMB_F2 6
#endif
#ifndef EPI_SKIP_ON_REP
#define EPI_SKIP_ON_REP 0
#endif
#ifdef EXTRA_SYNCS
    for (int es = 0; es < EXTRA_SYNCS; ++es) GSYNC();
#endif
    for (int prep = 0; prep < NPRO; ++prep) {
    if (prep) { GSYNC(); ph -= 3; }
    int tid = threadIdx.x; asm volatile("" : "+v"(tid));
    const int lane = tid & 63, wave = __builtin_amdgcn_readfirstlane(tid >> 6), gw = vcu * 8 + wave;
    if (ON(0) && RUN(ph)) {
        LAS float* scr = (LAS float*)((LAS unsigned char*)lds + wave * 16896);
        for (int it = gw; it < 96 * 8; it += NGW) {
            const int cb = it % 96, ks = it / 96, k0 = ks * 128;
            for (int idx = lane; idx < NMODROW * 128; idx += 64) { const int r = idx >> 7, kk = idx & 127; const float v = r < 32 ? c_in[r * DM + k0 + kk] : cctx_in[k0 + kk];
                scr[idx] = v / (1.0f + __expf(-v)); }
            asm volatile("s_waitcnt lgkmcnt(0)" ::: "memory");
            f32x4 acc[NMODROW];
#pragma unroll
            for (int r = 0; r < NMODROW; ++r) acc[r] = (f32x4){0.f, 0.f, 0.f, 0.f};
            const int li = cb / 24, col0 = (cb % 24) * 256 + lane * 4;
            const float* wp = ada_w + ((size_t)li * DM + k0) * MODW + col0;
#pragma unroll 2
            for (int kk = 0; kk < 128; ++kk) { const f32x4 w4 = *(const f32x4*)(wp + (size_t)kk * MODW);
#pragma unroll
                for (int r = 0; r < NMODROW; ++r) { const float s = scr[r * 128 + kk]; acc[r] = acc[r] + w4 * s; } }
#pragma unroll
            for (int r = 0; r < NMODROW; ++r) *(f32x4*)(modp + ((size_t)ks * NMODROW + r) * (4 * MODW) + li * MODW + col0) = acc[r];
            asm volatile("s_waitcnt lgkmcnt(0)" ::: "memory");
        }
        {
            constexpr int I_FI = 16 * 176, I_FO = 44 * 32, I_AQ = 16 * 48, I_AO = 16 * 32, I_BI = 16 * 64, I_BO = 16 * 32, I_CQ = 16 * 64, I_CO = 16 * 32;
            constexpr int NIT = 4 * I_FI + 4 * I_FO + 2 * I_AQ + 2 * I_AO + I_BI + I_BO + I_CQ + I_CO;
            const int ntw = NGW > 1024 ? NGW - 768 : NGW, tw = NGW > 1024 ? gw - 768 : gw;
            if (tw >= 0) for (int it = tw; it < NIT; it += ntw) {
                int r = it;
                if (r < 4 * I_FI) { const int l = r / I_FI; r %= I_FI; const int kb = r / 176, nb = r % 176;
                    transpose_item(args.in[7] + (size_t)l * DM * 2 * FFH, DM, 2 * FFH, (bf16*)(Wb + W_FI) + (size_t)l * 2 * FFH * DM, kb * 64, nb * 32, ffn_in_row(nb * 32), scr, lane); continue; } r -= 4 * I_FI;
                if (r < 4 * I_FO) { const int l = r / I_FO; r %= I_FO; const int kb = r / 32, nb = r % 32;
                    transpose_item(args.in[8] + (size_t)l * FFH * DM, FFH, DM, (bf16*)(Wb + W_FO) + (size_t)l * DM * FFH, kb * 64, nb * 32, nb * 32, scr, lane); continue; } r -= 4 * I_FO;
                if (r < 2 * I_AQ) { const int l = r / I_AQ; r %= I_AQ; const int kb = r / 48, nb = r % 48;
                    transpose_item(args.in[9] + (size_t)l * DM * 1536, DM, 1536, (bf16*)(Wb + W_AQ) + (size_t)l * 1536 * DM, kb * 64, nb * 32, nb * 32, scr, lane); continue; } r -= 2 * I_AQ;
                if (r < 2 * I_AO) { const int l = r / I_AO; r %= I_AO; const int kb = r / 32, nb = r % 32;
                    transpose_item(args.in[10] + (size_t)l * DM * DM, DM, DM, (bf16*)(Wb + W_AO) + (size_t)l * DM * DM, kb * 64, nb * 32, nb * 32, scr, lane); continue; } r -= 2 * I_AO;
                if (r < I_BI) { const int kb = r / 64, nb = r % 64; transpose_item(args.in[12], DM, 2048, (bf16*)(Wb + W_BI), kb * 64, nb * 32, nb * 32, scr, lane); continue; } r -= I_BI;
                if (r < I_BO) { const int kb = r / 32, nb = r % 32; transpose_item(args.in[18], DM, DM, (bf16*)(Wb + W_BO), kb * 64, nb * 32, nb * 32, scr, lane); continue; } r -= I_BO;
                if (r < I_CQ) { const int kb = r / 64, nb = r % 64; transpose_item(args.in[19], DM, 2048, (bf16*)(Wb + W_CQ), kb * 64, nb * 32, nb * 32, scr, lane); continue; } r -= I_CQ;
                { const int kb = r / 32, nb = r % 32; transpose_item(args.in[20], DM, DM, (bf16*)(Wb + W_CO), kb * 64, nb * 32, nb * 32, scr, lane); }
            }
        }
        {
            const int gt = gw * 64 + lane, NGT = NGW * 64;
            const float* wsf = args.in[16];
            for (int e = gt; e < 8 * 128 * 128 / 2; e += NGT) ((unsigned*)Wsb)[e] = cvtpk(wsf[2 * e], wsf[2 * e + 1]);
            for (int e = gt; e < 2048 * 32; e += NGT) { const int t = e >> 5, p = e & 31, j = p & 15; const float pos = (float)(p < 16 ? (t >> 6) : (t & 63));
                const float inv = exp2f(-(float)j * (13.287712379549449f / 16.0f)); const float a = pos * inv; cosA[e] = cosf(a); sinA[e] = sinf(a); }
            for (int e = gt; e < 2048 * 64; e += NGT) { const int t = e >> 6, p = e & 63, j = p & 31; const float pos = (float)(p < 32 ? (t >> 6) : (t & 63));
                const float inv = exp2f(-(float)j * (13.287712379549449f / 32.0f)); const float a = pos * inv; cosC[e] = cosf(a); sinC[e] = sinf(a); }
        }
    }
    SEAM(ph); ++ph;
    if (ON(1) && RUN(ph)) {
        const int gt = gw * 64 + lane, NGT = NGW * 64;
        for (int e = gt; e < DEPTH * NMODROW * MODW / 4; e += NGT) {
            const int c4 = e % (MODW / 4), rr = (e / (MODW / 4)) % NMODROW, li = e / (MODW / 4 * NMODROW);
            f32x4 s = *(const f32x4*)(ada_b + li * MODW + c4 * 4);
#pragma unroll
            for (int k = 0; k < 8; ++k) s = s + *(const f32x4*)(modp + ((size_t)k * NMODROW + rr) * (4 * MODW) + li * MODW + c4 * 4);
            *(f32x4*)(mods + ((size_t)li * NMODROW + rr) * MODW + c4 * 4) = s;
        }
    }
    SEAM(ph); ++ph;
    if (ON(2) && RUN(ph)) {
        { const int rpw = (MTOT + NGW - 1) / NGW, mb = gw * rpw, me = mb + rpw < MTOT ? mb + rpw : MTOT;
          combine_span<false, true>(mb, me, x_in, ctx_in, nullptr, nullptr, nullptr, Hb, nullptr, nullptr, mods, mods + DM, norm_g, lane, 1.0f); }
    }
    SEAM(ph); ++ph;
    }

    constexpr int NOPS = 10;
    for (int step = 3, rep = 0; step < 3 + NOPS * DEPTH; ) {
        const int li = (step - 3) / NOPS, op = (step - 3) % NOPS;
        int tid = threadIdx.x; asm volatile("" : "+v"(tid));
        const int lane = tid & 63, wave = __builtin_amdgcn_readfirstlane(tid >> 6), gw = vcu * 8 + wave;
        const int kind = li % 3; const int ja = li / 3; const bool ctx_out = li < DEPTH - 1; const int Mact = ctx_out ? MTOT : MLAT;
        const float* ng = norm_g + (size_t)li * 4 * DM;
        const bool noop = (op == 1 && kind == 1) || ((op == 5 || op == 9) && !ctx_out);
        if (RUN(ph) && !noop) {
#ifdef STAGGER_US
            if (op == 0 || op == 3 || op == 5 || op == 6) {
                const unsigned long long t0 = __builtin_amdgcn_s_memrealtime(); const unsigned long long dl = (unsigned long long)(((bx >> 3) & 3) * STAGGER_US * 100);
                while (__builtin_amdgcn_s_memrealtime() - t0 < dl) __builtin_amdgcn_s_sleep(32);
            }
#endif
            if (ON(3) && ((op == 0 && kind != 1) || op == 3 || op == 7 || ((op == 4 || op == 8) && ctx_out))) {
                pg8::Gemm g; pg8::EpiBf16<0> E; E.bias = nullptr; E.split_cols = 0; E.split_stride = 0; E.scale0 = 1.f; E.skip = EPI_SKIP_ON_REP ? rep * EPI_SKIP_ON_REP : 0; E.scratch = Ob;
                if (op == 0) { const int N1 = kind == 0 ? 1536 : 2048; g.A = Hb; g.Bt = kind == 0 ? (const bf16*)(Wb + W_AQ) + (size_t)ja * 1536 * DM : (const bf16*)(Wb + W_CQ); g.M = MTOT; g.N = N1; g.K = DM; E.O = QKV; E.ldc = N1; }
                else if (op == 3 || op == 4) { const size_t ro = op == 4 ? (size_t)MLAT * DM : 0;
                    g.A = Ob + ro; g.Bt = kind == 0 ? (const bf16*)(Wb + W_AO) + (size_t)ja * DM * DM : kind == 1 ? (const bf16*)(Wb + W_BO) : (const bf16*)(Wb + W_CO); g.M = op == 4 ? MCTX : MLAT; g.N = DM; g.K = DM; E.O = Yb + ro; E.ldc = DM; }
                else { const bool cx = op == 8;
                    g.A = HID + (cx ? (size_t)MLAT * FFH : 0); g.Bt = (const bf16*)(Wb + W_FO) + (size_t)li * DM * FFH; g.M = cx ? MCTX : MLAT; g.N = DM; g.K = FFH; E.O = Yb + (cx ? (size_t)MLAT * DM : 0); E.ldc = DM; }
                pg8::StaticOrder S; S.init(g.M, g.N, G, bx);
                pg8::gemm_phase<pg8::EpiBf16<0>, pg8::StaticOrder, true, true>((PG8_LAS unsigned char*)lds, g, S, E);
            }
            else if (ON(4) && op == 0) {
                pg8::Gemm g{Hb, (const bf16*)(Wb + W_BI), MTOT, 2048, DM}; pg8::StaticOrder S; S.init(MTOT, 2048, G, bx);
                pg8::EpiBf16<1> E{QKV, 2048, args.in[13], 0, 0, 1.f, EPI_SKIP_ON_REP ? rep * EPI_SKIP_ON_REP : 0, Ob}; pg8::gemm_phase<pg8::EpiBf16<1>, pg8::StaticOrder, true, true>((PG8_LAS unsigned char*)lds, g, S, E);
            }
            else if (ON(5) && op == 6) {
                pg8::Gemm g{Hb, (const bf16*)(Wb + W_FI) + (size_t)li * 2 * FFH * DM, Mact, 2 * FFH, DM}; pg8::StaticOrder S; S.init(Mact, 2 * FFH, G, bx);
                pg8::EpiSwiglu E{HID, FFH}; pg8::gemm_phase<pg8::EpiSwiglu, pg8::StaticOrder, true, true>((PG8_LAS unsigned char*)lds, g, S, E);
            }
            else if (ON(6) && op == 1) {
                if (kind == 0) {
                    for (int m = gw; m < MLAT; m += NGW) { const int t = m & 2047; bf16* kp = QKV + (size_t)m * 1536 + 1024 + (lane >> 4) * 64 + (lane & 15) * 2;
                        const unsigned w1 = *(const unsigned*)kp, w2 = *(const unsigned*)(kp + 32);
                        const f32x2 c = *(const f32x2*)(cosA + t * 32 + (lane & 15) * 2), s = *(const f32x2*)(sinA + t * 32 + (lane & 15) * 2);
                        const float a0 = bflo(w1), a1 = bfhi(w1), b0 = bflo(w2), b1 = bfhi(w2);
                        *(unsigned*)kp = cvtpk(a0 * c.x - b0 * s.x, a1 * c.y - b1 * s.y); *(unsigned*)(kp + 32) = cvtpk(b0 * c.x + a0 * s.x, b1 * c.y + a1 * s.y); }
                } else {
                    const float* kg = args.in[22];
                    for (int m = gw; m < MTOT; m += NGW) { bf16* kp = QKV + (size_t)m * 2048 + 1024 + (lane >> 4) * 128 + (lane & 15) * 4; const int i0 = (lane & 15) * 4;
                        const u32x2 w1 = *(const u32x2*)kp, w2 = *(const u32x2*)(kp + 64);
                        float a[4] = {bflo(w1.x), bfhi(w1.x), bflo(w1.y), bfhi(w1.y)}, b[4] = {bflo(w2.x), bfhi(w2.x), bflo(w2.y), bfhi(w2.y)};
                        float ss = 0.f;
#pragma unroll
                        for (int j = 0; j < 4; ++j) ss += a[j] * a[j] + b[j] * b[j];
                        ss += __shfl_xor(ss, 1); ss += __shfl_xor(ss, 2); ss += __shfl_xor(ss, 4); ss += __shfl_xor(ss, 8);
                        const float rstd = rsqrtf(ss * (1.0f / 128.0f) + 1e-6f);
                        const f32x4 g1 = *(const f32x4*)(kg + i0), g2 = *(const f32x4*)(kg + 64 + i0);
#pragma unroll
                        for (int j = 0; j < 4; ++j) { a[j] *= rstd * g1[j]; b[j] *= rstd * g2[j]; }
                        if (m < MLAT) { const int t = m & 2047; const f32x4 c = *(const f32x4*)(cosC + t * 64 + i0), s = *(const f32x4*)(sinC + t * 64 + i0);
#pragma unroll
                            for (int j = 0; j < 4; ++j) { const float x1 = a[j], x2 = b[j]; a[j] = x1 * c[j] - x2 * s[j]; b[j] = x2 * c[j] + x1 * s[j]; } }
                        u32x2 o1, o2; o1.x = cvtpk(a[0], a[1]); o1.y = cvtpk(a[2], a[3]); o2.x = cvtpk(b[0], b[1]); o2.y = cvtpk(b[2], b[3]);
                        *(u32x2*)kp = o1; *(u32x2*)(kp + 64) = o2; }
                }

            }
            else if (ON(7) && op == 2 && kind != 1) {
                if (kind == 0) {
                    const float* sink = args.in[11] + ja * 16;
                    const int nlat = 4096, ntot = nlat + (ctx_out ? 512 : 0);
                    for (int u = bx; u < ntot; u += G) {
                        att::UnitDesc d; d.nctx = 4; d.cosT = cosA; d.sinT = sinA; d.qg = nullptr;
                        int b, h;
                        if (u < nlat) { const int x = u & 7, j = (u >> 3) & 31, gi = (u >> 8) * 8 + x; b = gi >> 2; const int kvh = gi & 3; h = kvh * 4 + (j >> 3); const int q0 = (j & 7) * 256;
                            d.Q = QKV + ((size_t)b * SEQ + q0) * 1536 + h * 64; d.O = Ob + ((size_t)b * SEQ + q0) * DM + h * 64; d.qpos0 = q0;
                            const int klo = q0 - 128 < 0 ? 0 : q0 - 128, khi = q0 + 384 > SEQ ? SEQ : q0 + 384; d.band_kp0 = klo; d.NT = 4 + (khi - klo) / 64; }
                        else { const int cu = u - nlat; b = cu >> 4; h = cu & 15;
                            d.Q = QKV + ((size_t)MLAT + b * CTXL) * 1536 + h * 64; d.O = Ob + ((size_t)MLAT + b * CTXL) * DM + h * 64; d.qpos0 = -1; d.band_kp0 = 0; d.NT = 4; }
                        d.Kc = QKV + 1024 + (h >> 2) * 64; d.Vc = QKV + 1280 + (h >> 2) * 64; d.ctx_row0 = MLAT + b * CTXL; d.lat_row0 = (long)b * SEQ;
                        d.sink_l2 = sink[h] * 1.4426950408889634f;
                        att::attn_unit<64, 1536, false, true>(d, (char*)lds);
                    }
                } else {
                    const int nlat = 2048, ntot = nlat + (ctx_out ? 256 : 0);
                    for (int u = bx; u < ntot; u += G) {
                        att::UnitDesc d; d.nctx = 4; d.cosT = cosC; d.sinT = sinC; d.qg = args.in[21]; d.band_kp0 = 0;
                        int b, h;
                        if (u < nlat) { const int x = u & 7, j = (u >> 3) & 31, gi = ((u >> 8) * 8 + x) * 2 + (j >> 4); b = gi >> 2; const int kvh = gi & 3; h = kvh * 2 + ((j & 15) >> 3); const int q0 = (j & 7) * 256;
                            d.Q = QKV + ((size_t)b * SEQ + q0) * 2048 + h * 128; d.O = Ob + ((size_t)b * SEQ + q0) * DM + h * 128; d.qpos0 = q0; d.NT = 36; }
                        else { const int cu = u - nlat; b = cu >> 3; h = cu & 7;
                            d.Q = QKV + ((size_t)MLAT + b * CTXL) * 2048 + h * 128; d.O = Ob + ((size_t)MLAT + b * CTXL) * DM + h * 128; d.qpos0 = -1; d.NT = 4; }
                        d.Kc = QKV + 1024 + (h >> 1) * 128; d.Vc = QKV + 1536 + (h >> 1) * 128; d.ctx_row0 = MLAT + b * CTXL; d.lat_row0 = (long)b * SEQ;
                        d.sink_l2 = -INFINITY;
                        att::attn_unit<128, 2048, true, false>(d, (char*)lds);
                    }
                }

            }
            else if (ON(8) && op == 2) {
                constexpr int TB = 16384;
                char* V_lds = (char*)lds; f32x2* stat = (f32x2*)((char*)lds + 2 * TB);
                const float* lng = args.in[14]; const float* lnb = args.in[15]; const float* bsb = args.in[17];
                const int r32 = lane & 31, hh = lane >> 5, rb = wave & 3, chh = wave >> 2;
                const int sr = tid >> 4, sc = (tid & 15) * 8;
                const int vb0 = (int)(uintptr_t)V_lds + att::v_rd_base(lane);
                for (int u = bx; u < (MTOT / 128) * 2; u += G) {
                    const int chunk = u >> 1, gh = u & 1; const size_t row0 = (size_t)chunk * 128;
                    for (int rr = 0; rr < 16; ++rr) { const bf16* vp = QKV + (row0 + wave * 16 + rr) * 2048 + 1024 + lane * 16;
                        const bf16x8 v0 = *(const bf16x8*)vp, v1 = *(const bf16x8*)(vp + 8); float f[16];
#pragma unroll
                        for (int j = 0; j < 8; ++j) { f[j] = bf2f(v0[j]); f[8 + j] = bf2f(v1[j]); }
                        float s = 0.f;
#pragma unroll
                        for (int j = 0; j < 16; ++j) s += f[j];
                        const float mean = wave_sum(s) * (1.0f / 1024.0f); float q = 0.f;
#pragma unroll
                        for (int j = 0; j < 16; ++j) { const float dd = f[j] - mean; q += dd * dd; }
                        const float rstd = rsqrtf(wave_sum(q) * (1.0f / 1024.0f) + 1e-5f);
                        if (lane == 0) stat[wave * 16 + rr] = (f32x2){mean, rstd}; }
                    __syncthreads();
                    for (int gi = 0; gi < 4; ++gi) {
                        const int g = gh * 4 + gi;
                        const f32x4 lg0 = *(const f32x4*)(lng + g * 128 + sc), lg1 = *(const f32x4*)(lng + g * 128 + sc + 4), lb0 = *(const f32x4*)(lnb + g * 128 + sc), lb1 = *(const f32x4*)(lnb + g * 128 + sc + 4);
#pragma unroll
                        for (int l = 0; l < 4; ++l) { const int rl = sr + 32 * l; const bf16x8 raw = *(const bf16x8*)(QKV + (row0 + rl) * 2048 + 1024 + g * 128 + sc);
                            const f32x2 st = stat[rl]; float f[8];
#pragma unroll
                            for (int j = 0; j < 8; ++j) f[j] = (bf2f(raw[j]) - st.x) * st.y * (j < 4 ? lg0[j & 3] : lg1[j & 3]) + (j < 4 ? lb0[j & 3] : lb1[j & 3]);
                            u32x4 w = {cvtpk(f[0], f[1]), cvtpk(f[2], f[3]), cvtpk(f[4], f[5]), cvtpk(f[6], f[7])};
                            *(u32x4*)(V_lds + (l >> 1) * TB + att::v_st<128>(sr + 32 * (l & 1), sc)) = w; }
                        bf16x8 pa[2][4];
#pragma unroll
                        for (int T = 0; T < 2; ++T)
#pragma unroll
                            for (int ks = 0; ks < 4; ++ks) pa[T][ks] = *(const bf16x8*)(Wsb + (size_t)g * 16384 + (32 * rb + r32) * 128 + 64 * T + 16 * ks + 8 * hh);
                        __syncthreads();
                        f32x16 o[2]; o[0] = f32x16{}; o[1] = f32x16{};
                        if (chh == 0) {
                            att::pv_one<128, 0>(o[0], vb0, pa[0][0], pa[0][1], pa[0][2], pa[0][3]); att::pv_one<128, 1>(o[1], vb0, pa[0][0], pa[0][1], pa[0][2], pa[0][3]);
                            att::pv_one<128, 0>(o[0], vb0 + TB, pa[1][0], pa[1][1], pa[1][2], pa[1][3]); att::pv_one<128, 1>(o[1], vb0 + TB, pa[1][0], pa[1][1], pa[1][2], pa[1][3]);
                        } else {
                            att::pv_one<128, 2>(o[0], vb0, pa[0][0], pa[0][1], pa[0][2], pa[0][3]); att::pv_one<128, 3>(o[1], vb0, pa[0][0], pa[0][1], pa[0][2], pa[0][3]);
                            att::pv_one<128, 2>(o[0], vb0 + TB, pa[1][0], pa[1][1], pa[1][2], pa[1][3]); att::pv_one<128, 3>(o[1], vb0 + TB, pa[1][0], pa[1][1], pa[1][2], pa[1][3]);
                        }
                        { bf16* stg = (bf16*)((char*)lds + 2 * TB + 1024) + wave * 2048;
#pragma unroll
                          for (int r = 0; r < 16; ++r) { const int pr = att::crow(r, hh); const float bias = bsb[g * 128 + 32 * rb + pr];
#pragma unroll
                            for (int d = 0; d < 2; ++d) { const float v = o[d][r] + bias; stg[pr * 64 + d * 32 + r32] = (bf16)(cvtpk(v, v) & 0xffffu); } }
                          asm volatile("s_waitcnt lgkmcnt(0)" ::: "memory");
#pragma unroll
                          for (int i = 0; i < 4; ++i) { const int row = i * 8 + (lane >> 3), ch = lane & 7; const bf16x8 mv = *(const bf16x8*)(stg + row * 64 + ch * 8);
                            const size_t gr = row0 + 32 * rb + row; const int col = g * 128 + 64 * chh + ch * 8;
                            const bf16x8 uv = *(const bf16x8*)(QKV + gr * 2048 + col); float f[8];
#pragma unroll
                            for (int e = 0; e < 8; ++e) f[e] = bf2f(uv[e]) * bf2f(mv[e]);
                            u32x4 w = {cvtpk(f[0], f[1]), cvtpk(f[2], f[3]), cvtpk(f[4], f[5]), cvtpk(f[6], f[7])};
                            *(u32x4*)(Ob + gr * DM + col) = w; } }
                        __syncthreads();
                    }
                }

            }
            if (ON(9) && (op == 4 || op == 5 || op == 8 || op == 9)) {
                const bool c2 = op >= 8, last = li == DEPTH - 1, first = li == 0 && !c2 && !rep;
                const int rbase = (op == 5 || op == 9) ? MLAT : 0, nrows = rbase ? MCTX : MLAT;
                const float* ml = mods + (size_t)li * NMODROW * MODW; const float* mn = ml + (size_t)NMODROW * MODW;
                int mb, me;
                if (ctx_out && !rbase && G == 256) {
                    const int F = c2 ? CMB_F2 : CMB_F1; int r0, nr;
                    if (bx >= 128) { nr = F * 64; r0 = (bx - 128) * nr; } else { nr = (8 - F) * 64; r0 = 128 * F * 64 + bx * nr; }
                    mb = r0 + wave * (nr >> 3); me = mb + (nr >> 3);
                } else { const int rpw = (nrows + NGW - 1) / NGW; mb = gw * rpw; me = mb + rpw < nrows ? mb + rpw : nrows; mb += rbase; me += rbase; }
                {
                    if (!c2) {
                        if (first) combine_span<true, true, true, !XBF16>(mb, me, x_in, ctx_in, XL, XC, Yb, Hb, ml + 2 * DM, ng + DM, ml + 3 * DM, ml + 4 * DM, ng + 2 * DM, lane, 1.0f);
                        else combine_span<true, true, !XBF16, !XBF16>(mb, me, XL, XC, XL, XC, Yb, Hb, ml + 2 * DM, ng + DM, ml + 3 * DM, ml + 4 * DM, ng + 2 * DM, lane, rep ? 0.0f : 1.0f);
                    } else {
                        if (last) combine_span<true, false, !XBF16, true>(mb, me, XL, XC, args.out, XC, Yb, Hb, ml + 5 * DM, ng + 3 * DM, nullptr, nullptr, nullptr, lane, rep ? 0.0f : 1.0f);
                        else combine_span<true, true, !XBF16, !XBF16>(mb, me, XL, XC, XL, XC, Yb, Hb, ml + 5 * DM, ng + 3 * DM, mn, mn + DM, ng + 4 * DM, lane, rep ? 0.0f : 1.0f);
                    }
                }
            }
        }
        if (!noop && step + 1 < 3 + NOPS * DEPTH) { if (RUN(ph) && RUN(ph + 1)) GSYNC(); }
#ifdef REP_MASK
        if ((((unsigned long long)(REP_MASK) >> (step - 3)) & 1ull) && rep == 0) { rep = 1; continue; }
        rep = 0;
#endif
        ++step; ++ph;
    }
#undef RUN
#undef SEAM
}

#ifndef MK_MULTI
#define MK_MULTI 0
#endif
extern "C" void kernel_launch(void* const* d_in, const int* in_sizes, int n_in, void* d_out, int out_size, void* d_ws, size_t ws_size, hipStream_t stream) {
    static int grid = 0;
    if (grid == 0) {
        if (n_in != 23 || ws_size < WS_END) { fprintf(stderr, "kernel_launch: unexpected n_in %d / ws_size %zu (need %zu)\n", n_in, ws_size, (size_t)WS_END); grid = -1; return; }
        int dev = 0, cus = 0, per_cu = 0;
        hipGetDevice(&dev); hipDeviceGetAttribute(&cus, hipDeviceAttributeMultiprocessorCount, dev);
        if (hipFuncSetAttribute((const void*)mega, hipFuncAttributeMaxDynamicSharedMemorySize, LDS_BYTES) != hipSuccess) { fprintf(stderr, "kernel_launch: hipFuncSetAttribute failed\n"); grid = -1; return; }
        if (hipOccupancyMaxActiveBlocksPerMultiprocessor(&per_cu, (const void*)mega, 512, LDS_BYTES) != hipSuccess || per_cu < 1) { fprintf(stderr, "kernel_launch: occupancy query says %d\n", per_cu); per_cu = 1; }
        (void)hipGetLastError();
        grid = cus * per_cu;
        fprintf(stderr, "kernel_launch: grid %d (cus %d x %d)\n", grid, cus, per_cu);
    }
    if (grid < 0) return;
    if (hipMemsetAsync((char*)d_ws + OFF_CTL, 0, CTL_BYTES, stream) != hipSuccess) { fprintf(stderr, "kernel_launch: memset failed\n"); return; }
    Args a{};
    for (int i = 0; i < 23; ++i) a.in[i] = (const float*)d_in[i];
    a.out = (float*)d_out; a.ws = (unsigned char*)d_ws;
#if MK_MULTI
    const int nph = 3 + 10 * DEPTH;
    for (int p = 0; p < nph; ++p) { a.ph_lo = p; a.ph_hi = p + 1; hipLaunchKernelGGL(mega, dim3(grid), dim3(512), LDS_BYTES, stream, a); }
#else
    a.ph_lo = 0; a.ph_hi = 1000;
    void* params[] = {&a};
    hipError_t e = hipLaunchCooperativeKernel((const void*)mega, dim3(grid), dim3(512), params, LDS_BYTES, stream);
    if (e != hipSuccess) fprintf(stderr, "kernel_launch: cooperative launch failed: %s (grid %d)\n", hipGetErrorString(e), grid);
#endif
}
```

```cpp
#ifndef XBF16
#define XBF16 1
#endif
#include <hip/hip_runtime.h>
#include <hip/hip_cooperative_groups.h>
#include <cstdio>
#include <cstdint>
namespace cg = cooperative_groups;
namespace pg8 {
#define PG8_LAS __attribute__((address_space(3)))
typedef unsigned short bf16_t;
typedef short bf16x8 __attribute__((ext_vector_type(8)));
typedef float f32x4 __attribute__((ext_vector_type(4)));
typedef unsigned u32x4 __attribute__((ext_vector_type(4)));
constexpr int BM = 256, BK = 64, HALF = 128, HTB = HALF * BK * 2  , STAGE_BYTES = 8 * HTB, NXCD = 8, WGM = 8;

__host__ __device__ __forceinline__ int lds_byte(int r, int c) { const int st = (r >> 4) * 2 + (c >> 5), rr = r & 15, cc = c & 31, ob = rr * 64 + cc * 2; return st * 1024 + (ob ^ (((ob >> 9) & 1) << 5)); }
__host__ __device__ __forceinline__ void stage_rc(int b, int& R, int& C) { const int st = b / 1024, sb = b % 1024, swz = sb ^ (((sb >> 9) & 1) << 5); R = (st >> 1) * 16 + swz / 64; C = (st & 1) * 32 + (swz % 64) / 2; }
__host__ __device__ __forceinline__ int perm32(int rho) { const int n = rho >> 4, i = rho & 15; return 8 * (i >> 2) + 4 * n + (i & 3); }

struct Unit { int pm, pn; };
struct Gemm { const bf16_t* A; const bf16_t* Bt; int M, N, K; };

struct StaticOrder {
    int nM, nN, nwg, G, c;
    __host__ __device__ void init(int M, int N, int G_, int c_) { nM = M / BM; nN = N / BM; nwg = nM * nN; G = G_; c = c_; }
    __host__ __device__ bool next(int i, Unit& u) const {
        const long L = (long)i * G + c; if (L >= nwg) return false;
        int wgid = (int)L; { const int q = nwg / NXCD, r = nwg % NXCD, xcd = wgid % NXCD, off = wgid / NXCD; wgid = (xcd < r ? xcd * (q + 1) : r * (q + 1) + (xcd - r) * q) + off; }
        const int nig = WGM * nN, gid = wgid / nig, fm = gid * WGM, gsz = (nM - fm) < WGM ? (nM - fm) : WGM;
        u.pm = fm + ((wgid % nig) % gsz); u.pn = (wgid % nig) / gsz; return true;
    }
    __device__ __forceinline__ void a_ready(const Unit&) const {}
    __device__ __forceinline__ void done(const Unit&) const {}
};

__device__ __forceinline__ unsigned cvt_pk_bf16(float lo, float hi) { unsigned r; asm volatile("v_cvt_pk_bf16_f32 %0, %1, %2" : "=v"(r) : "v"(lo), "v"(hi)); return r; }
typedef float f32x2 __attribute__((ext_vector_type(2)));
__device__ __forceinline__ f32x2 gelu_pk(f32x2 v) {
    const f32x2 av = __builtin_elementwise_abs(v), d = av * 0.2316418882f + 1.0f;
    f32x2 t; t.x = __builtin_amdgcn_rcpf(d.x); t.y = __builtin_amdgcn_rcpf(d.y);
    f32x2 q = t * 0.5307027145f + (-0.7265760135f); q = q * t + 0.7107068705f; q = q * t + (-0.142248368f); q = q * t + 0.127414796f; q = q * t;
    const f32x2 s = (v * v) * (-0.72134752044f);
    f32x2 e; e.x = __builtin_amdgcn_exp2f(s.x); e.y = __builtin_amdgcn_exp2f(s.y);
    const f32x2 m = v * (q * e), r = v - m;
    f32x2 o; o.x = v.x < 0.f ? m.x : r.x; o.y = v.y < 0.f ? m.y : r.y; return o;
}

#ifndef PG8_STMODE
#define PG8_STMODE 0
#endif
#if PG8_STMODE == 1
#define PG8_ST16(p, v) asm volatile("global_store_dwordx4 %0, %1, off sc1\n\ts_nop 1" :: "v"(p), "v"(v) : "memory")
#elif PG8_STMODE == 2
#define PG8_ST16(p, v) asm volatile("global_store_dwordx4 %0, %1, off nt\n\ts_nop 1" :: "v"(p), "v"(v) : "memory")
#elif PG8_STMODE == 4
#define PG8_ST16(p, v) asm volatile("global_store_dwordx4 %0, %1, off\n\ts_nop 1" :: "v"(p), "v"(v) : "memory")
#elif PG8_STMODE == 3
#define PG8_ST16(p, v) asm volatile("global_store_dwordx4 %0, %1, off sc0 sc1\n\ts_nop 1" :: "v"(p), "v"(v) : "memory")
#else
#define PG8_ST16(p, v) (*(u32x4*)(p) = (v))
#endif
template <int ACT  > struct EpiBf16 {
    static constexpr bool PERM = true, AFTER_DRAIN = false; static_assert(ACT == 0 || ACT == 1, "EpiBf16: ACT is 0 (none) or 1 (gelu_pk)");
    bf16_t* O; int ldc; const float* bias; int split_cols; size_t split_stride; float scale0; int skip; bf16_t* scratch;
    __device__ __forceinline__ void operator()(const f32x4 (&acc)[2][2][4][2], const Unit& u, int wr, int wc, int fr, int fq) const {
        if (skip == 1) return;
        const int row0 = u.pm * BM + wr * 64 + fr; int colt = u.pn * BM; bf16_t* base = O;
        float sc = 1.f; if (split_cols) { const int t = colt / split_cols; base += (size_t)t * split_stride; colt -= t * split_cols; if (t == 0) sc = scale0; }
        const int col0 = colt + wc * 32 + 8 * fq, bcol0 = u.pn * BM + wc * 32 + 8 * fq;
        f32x4 bv[2][2];
#pragma unroll
        for (int bj = 0; bj < 2; ++bj)
#pragma unroll
            for (int n = 0; n < 2; ++n) bv[bj][n] = bias ? *(const f32x4*)(bias + bcol0 + bj * HALF + 4 * n) : (f32x4){0.f, 0.f, 0.f, 0.f};
#pragma unroll
        for (int ai = 0; ai < 2; ++ai)
#pragma unroll
            for (int m = 0; m < 4; ++m) { bf16_t* rowp = base + (size_t)(row0 + ai * HALF + m * 16) * ldc + col0; int bjs = HALF;
                if (skip == 2) { rowp = scratch + ((size_t)((((u.pm * 8 + u.pn) & 1023) * 8 + wr * 4 + wc) * 16 + (ai * 4 + m) * 2)) * 512 + (fq * 16 + fr) * 8; bjs = 512; }
#pragma unroll
                for (int bj = 0; bj < 2; ++bj) { f32x4 v0 = acc[ai][bj][m][0] + bv[bj][0], v1 = acc[ai][bj][m][1] + bv[bj][1];
                    if (ACT == 1) { f32x2 a = gelu_pk((f32x2){v0[0], v0[1]}), b = gelu_pk((f32x2){v0[2], v0[3]}), c = gelu_pk((f32x2){v1[0], v1[1]}), d = gelu_pk((f32x2){v1[2], v1[3]});
                        v0 = (f32x4){a.x, a.y, b.x, b.y}; v1 = (f32x4){c.x, c.y, d.x, d.y}; }
                    v0 = v0 * sc; v1 = v1 * sc; u32x4 w; w.x = cvt_pk_bf16(v0[0], v0[1]); w.y = cvt_pk_bf16(v0[2], v0[3]); w.z = cvt_pk_bf16(v1[0], v1[1]); w.w = cvt_pk_bf16(v1[2], v1[3]);
                    PG8_ST16(rowp + bj * bjs, w); } }
    }
};
template <class Epi, class Sched, bool ALIGN_EPI = false, bool SP2 = false>
__device__ __forceinline__ void gemm_phase(PG8_LAS unsigned char* lds, const Gemm g, const Sched& S, const Epi& E) {
    int tid = threadIdx.x; asm volatile("" : "+v"(tid));
    const int wid = __builtin_amdgcn_readfirstlane(tid >> 6), lane = tid & 63, wr = wid >> 2, wc = wid & 3, fr = lane & 15, fq = lane >> 4;
    const int K = g.K, nt = K / BK;
    unsigned voffA[2], voffB[2];
#pragma unroll
    for (int i = 0; i < 2; ++i) { int R, C; stage_rc(tid * 16 + i * 8192, R, C); const int Rb = Epi::PERM ? ((R & ~31) + perm32(R & 31)) : R;
        voffA[i] = (unsigned)(R * K + C) * 2u; voffB[i] = (unsigned)(Rb * K + C) * 2u; }
    const size_t kstep = (size_t)(BK * 2);
    const size_t hstep = (size_t)HALF * K * 2;
    const size_t tstep = 2 * hstep;
    const unsigned ldsw = (unsigned)wid * 1024u;
    const int aoff = lds_byte(wr * 64 + fr, fq * 8), boff = lds_byte(wc * 32 + fr, fq * 8);
#define PG8_SA(b, h) (((b) * 2 + (h)) * HTB)
#define PG8_SB(b, h) ((4 + (b) * 2 + (h)) * HTB)
#define PG8_STAGE(bufoff, gbase, voff) do { _Pragma("unroll") for (int _i = 0; _i < 2; ++_i) \
        __builtin_amdgcn_global_load_lds((const unsigned*)((const char*)(gbase) + (voff)[_i]), (PG8_LAS unsigned*)(lds + (bufoff) + ldsw + _i * 8192), 16, 0, 0); } while (0)
#define PG8_LDA(dst, b, h) do { _Pragma("unroll") for (int m = 0; m < 4; ++m) _Pragma("unroll") for (int k = 0; k < 2; ++k) dst[m][k] = *(const PG8_LAS bf16x8*)(lds + PG8_SA(b, h) + aoff + m * 2048 + k * 1024); } while (0)
#define PG8_LDB(dst, b, h) do { _Pragma("unroll") for (int n = 0; n < 2; ++n) _Pragma("unroll") for (int k = 0; k < 2; ++k) dst[n][k] = *(const PG8_LAS bf16x8*)(lds + PG8_SB(b, h) + boff + n * 2048 + k * 1024); } while (0)
#define PG8_MMA(ai, bj, At, Bt) do { __builtin_amdgcn_s_setprio(1); _Pragma("unroll") for (int m = 0; m < 4; ++m) _Pragma("unroll") for (int n = 0; n < 2; ++n) _Pragma("unroll") for (int k = 0; k < 2; ++k) \
        acc[ai][bj][m][n] = __builtin_amdgcn_mfma_f32_16x16x32_bf16(Bt[n][k], At[m][k], acc[ai][bj][m][n], 0, 0, 0); __builtin_amdgcn_s_setprio(0); } while (0)
#define PG8_WAIT_V(n) asm volatile("s_waitcnt vmcnt(" #n ")" ::: "memory")
#define PG8_WAIT_L(n) asm volatile("s_waitcnt lgkmcnt(" #n ")" ::: "memory")
#define PG8_BAR __builtin_amdgcn_s_barrier()
#define PG8_SCHED __builtin_amdgcn_sched_barrier(0)
    Unit cur, nxt; int ui = 0;
    if (!S.next(0, cur)) return;
    f32x4 acc[2][2][4][2];
#pragma unroll
    for (int a = 0; a < 2; ++a)
#pragma unroll
        for (int b = 0; b < 2; ++b)
#pragma unroll
            for (int m = 0; m < 4; ++m)
#pragma unroll
                for (int n = 0; n < 2; ++n) acc[a][b][m][n] = (f32x4){0.f, 0.f, 0.f, 0.f};
    bf16x8 At[4][2], B0[2][2], B1[2][2];
    const char* cA = (const char*)g.A + (size_t)cur.pm * tstep; const char* cB = (const char*)g.Bt + (size_t)cur.pn * tstep;
    S.a_ready(cur);
    if constexpr (SP2) {
        PG8_STAGE(PG8_SB(0, 0), cB, voffB); PG8_STAGE(PG8_SB(0, 1), cB + hstep, voffB); PG8_STAGE(PG8_SA(0, 0), cA, voffA); PG8_STAGE(PG8_SA(0, 1), cA + hstep, voffA);
        if (wr == 1) PG8_BAR;
        PG8_WAIT_V(2); PG8_BAR;
        PG8_STAGE(PG8_SB(1, 0), cB + kstep, voffB); PG8_STAGE(PG8_SA(1, 0), cA + kstep, voffA); PG8_STAGE(PG8_SB(1, 1), cB + hstep + kstep, voffB);
        PG8_WAIT_V(6); PG8_BAR;
    } else {
        PG8_STAGE(PG8_SB(0, 0), cB, voffB); PG8_STAGE(PG8_SA(0, 0), cA, voffA); PG8_STAGE(PG8_SB(0, 1), cB + hstep, voffB); PG8_STAGE(PG8_SA(0, 1), cA + hstep, voffA);
        if (wr == 1) PG8_BAR;
        PG8_WAIT_V(4); PG8_BAR;
        PG8_STAGE(PG8_SB(1, 0), cB + kstep, voffB); PG8_STAGE(PG8_SA(1, 0), cA + kstep, voffA); PG8_STAGE(PG8_SB(1, 1), cB + hstep + kstep, voffB);
        PG8_WAIT_V(6); PG8_BAR;
    }
    for (;;) {
        const bool has_next = S.next(ui + 1, nxt);
        const char* nA = has_next ? (const char*)g.A + (size_t)nxt.pm * tstep : cA; const char* nB = has_next ? (const char*)g.Bt + (size_t)nxt.pn * tstep : cB;
        for (int t = 0; t < nt; t += 2) {
            const bool last = (t == nt - 2);
            const char* a1 = cA + (size_t)(t + 1) * kstep;
            const char* a2 = last ? nA : cA + (size_t)(t + 2) * kstep; const char* b2 = last ? nB : cB + (size_t)(t + 2) * kstep;
            const char* a3 = a2 + kstep; const char* b3 = b2 + kstep;
            if (last && has_next) S.a_ready(nxt);
            if constexpr (SP2) {
            PG8_LDB(B0, 0, 0); PG8_LDB(B1, 0, 1); PG8_SCHED; PG8_LDA(At, 0, 0); PG8_STAGE(PG8_SA(1, 1), a1 + hstep, voffA);
            PG8_WAIT_V(8); PG8_WAIT_L(0); PG8_BAR; PG8_MMA(0, 0, At, B0); PG8_MMA(0, 1, At, B1); PG8_BAR; PG8_SCHED;
            PG8_LDA(At, 0, 1); PG8_STAGE(PG8_SB(0, 0), b2, voffB); PG8_STAGE(PG8_SB(0, 1), b2 + hstep, voffB); PG8_STAGE(PG8_SA(0, 0), a2, voffA);
            PG8_WAIT_V(8); PG8_WAIT_L(0); PG8_BAR; PG8_MMA(1, 0, At, B0); PG8_MMA(1, 1, At, B1); PG8_BAR; PG8_SCHED;
            PG8_LDB(B0, 1, 0); PG8_LDB(B1, 1, 1); PG8_SCHED; PG8_LDA(At, 1, 0); PG8_STAGE(PG8_SA(0, 1), a2 + hstep, voffA);
            PG8_WAIT_V(8); PG8_WAIT_L(0); PG8_BAR; PG8_MMA(0, 0, At, B0); PG8_MMA(0, 1, At, B1); PG8_BAR; PG8_SCHED;
            PG8_LDA(At, 1, 1); PG8_STAGE(PG8_SB(1, 0), b3, voffB); PG8_STAGE(PG8_SB(1, 1), b3 + hstep, voffB); PG8_STAGE(PG8_SA(1, 0), a3, voffA);
            PG8_WAIT_V(8); PG8_WAIT_L(0); PG8_BAR; PG8_MMA(1, 0, At, B0); PG8_MMA(1, 1, At, B1); PG8_BAR; PG8_SCHED;
            } else {
            PG8_LDB(B0, 0, 0); PG8_SCHED; PG8_LDA(At, 0, 0); PG8_STAGE(PG8_SA(1, 1), a1 + hstep, voffA);
            PG8_WAIT_L(8); PG8_BAR; PG8_WAIT_L(0); PG8_MMA(0, 0, At, B0); PG8_BAR; PG8_SCHED;
            PG8_LDB(B1, 0, 1); PG8_STAGE(PG8_SB(0, 0), b2, voffB);
            PG8_BAR; PG8_WAIT_L(0); PG8_MMA(0, 1, At, B1); PG8_BAR;
            PG8_LDA(At, 0, 1); PG8_STAGE(PG8_SA(0, 0), a2, voffA);
            PG8_BAR; PG8_WAIT_L(0); PG8_MMA(1, 0, At, B0); PG8_BAR; PG8_SCHED;
            PG8_STAGE(PG8_SB(0, 1), b2 + hstep, voffB);
            PG8_WAIT_V(6); PG8_BAR; PG8_MMA(1, 1, At, B1); PG8_BAR;
            PG8_LDB(B0, 1, 0); PG8_SCHED; PG8_LDA(At, 1, 0); PG8_STAGE(PG8_SA(0, 1), a2 + hstep, voffA);
            PG8_WAIT_L(8); PG8_BAR; PG8_WAIT_L(0); PG8_MMA(0, 0, At, B0); PG8_BAR; PG8_SCHED;
            PG8_LDB(B1, 1, 1); PG8_STAGE(PG8_SB(1, 0), b3, voffB);
            PG8_BAR; PG8_WAIT_L(0); PG8_MMA(0, 1, At, B1); PG8_BAR;
            PG8_LDA(At, 1, 1); PG8_STAGE(PG8_SA(1, 0), a3, voffA);
            PG8_BAR; PG8_WAIT_L(0); PG8_MMA(1, 0, At, B0); PG8_BAR; PG8_SCHED;
            PG8_STAGE(PG8_SB(1, 1), b3 + hstep, voffB);
            PG8_WAIT_V(6); PG8_BAR; PG8_MMA(1, 1, At, B1); PG8_BAR;
            }
        }
        if constexpr (ALIGN_EPI) { if (wr == 0) PG8_BAR; }
        if constexpr (!Epi::AFTER_DRAIN) { E(acc, cur, wr, wc, fr, fq); S.done(cur); }
        if (!has_next) break;
#pragma unroll
        for (int a = 0; a < 2; ++a)
#pragma unroll
            for (int b = 0; b < 2; ++b)
#pragma unroll
                for (int m = 0; m < 4; ++m)
#pragma unroll
                    for (int n = 0; n < 2; ++n) acc[a][b][m][n] = (f32x4){0.f, 0.f, 0.f, 0.f};
        cur = nxt; cA = nA; cB = nB; ++ui;
        if constexpr (ALIGN_EPI) { if (wr == 1) PG8_BAR; }
    }
    PG8_WAIT_V(0);
    if constexpr (!ALIGN_EPI) { if (wr == 0) PG8_BAR; }
    PG8_BAR;
    if constexpr (Epi::AFTER_DRAIN) { E.fused(acc, cur, wr, wc, fr, fq, lds, wid, lane); S.done(cur); }
#undef PG8_SA
#undef PG8_SB
#undef PG8_STAGE
#undef PG8_LDA
#undef PG8_LDB
#undef PG8_MMA
#undef PG8_WAIT_V
#undef PG8_WAIT_L
#undef PG8_BAR
#undef PG8_SCHED
}
}
namespace pg8 {
struct EpiSwiglu {
    static constexpr bool PERM = true, AFTER_DRAIN = false;
    bf16_t* O; int ldc;
    __device__ __forceinline__ void operator()(const f32x4 (&acc)[2][2][4][2], const Unit& u, int wr, int wc, int fr, int fq) const {
        const int row0 = u.pm * BM + wr * 64 + fr; const int col0 = u.pn * HALF + wc * 32 + 8 * fq;
#pragma unroll
        for (int ai = 0; ai < 2; ++ai)
#pragma unroll
            for (int m = 0; m < 4; ++m) { bf16_t* rowp = O + (size_t)(row0 + ai * HALF + m * 16) * ldc + col0;
                float o[8];
#pragma unroll
                for (int n = 0; n < 2; ++n)
#pragma unroll
                    for (int e = 0; e < 4; ++e) { const float g = acc[ai][0][m][n][e], up = acc[ai][1][m][n][e];
                        o[n * 4 + e] = g * __builtin_amdgcn_rcpf(1.0f + __expf(-g)) * up; }
                u32x4 w; w.x = cvt_pk_bf16(o[0], o[1]); w.y = cvt_pk_bf16(o[2], o[3]); w.z = cvt_pk_bf16(o[4], o[5]); w.w = cvt_pk_bf16(o[6], o[7]);
                PG8_ST16(rowp, w); }
    }
};
}

constexpr int DM = 1024, NBATCH = 32, SEQ = 2048, CTXL = 256, MLAT = NBATCH * SEQ, MCTX = NBATCH * CTXL, MTOT = MLAT + MCTX, FFH = 2816, DEPTH = 4;
constexpr int NMODROW = 33, MODW = 6 * DM;
constexpr int LDS_BYTES = 147456;
constexpr size_t MiB = 1u << 20;
constexpr size_t OFF_MODP = 0;
constexpr size_t OFF_MODS = 26 * MiB;
constexpr size_t OFF_ROPE = 30 * MiB;
constexpr size_t OFF_WS = 32 * MiB;
constexpr size_t OFF_W = 33 * MiB;
constexpr size_t W_FI = 0, W_FO = 44 * MiB, W_AQ = 66 * MiB, W_AO = 72 * MiB, W_BI = 76 * MiB, W_BO = 80 * MiB, W_CQ = 82 * MiB, W_CO = 86 * MiB;
constexpr size_t OFF_XC = 121 * MiB;
constexpr size_t OFF_H = 153 * MiB;
constexpr size_t OFF_Y = 297 * MiB;
constexpr size_t OFF_BIG = 441 * MiB;
constexpr size_t OFF_O = OFF_BIG + 288 * MiB;
constexpr size_t OFF_CTL = OFF_BIG + 432 * MiB;
constexpr size_t CTL_BYTES = 65536;
constexpr size_t OFF_XLB = OFF_CTL + 1 * MiB;
constexpr size_t WS_END = OFF_XLB + 128 * MiB;
constexpr int LDS_XB = LDS_BYTES - 64;

typedef unsigned short bf16;
typedef short bf16x8 __attribute__((ext_vector_type(8)));
typedef short s16x4 __attribute__((ext_vector_type(4)));
typedef float f32x16 __attribute__((ext_vector_type(16)));
typedef float f32x4 __attribute__((ext_vector_type(4)));
typedef float f32x2 __attribute__((ext_vector_type(2)));
typedef unsigned u32x4 __attribute__((ext_vector_type(4)));
typedef unsigned u32x2 __attribute__((ext_vector_type(2)));
#define LAS __attribute__((address_space(3)))

__device__ __forceinline__ unsigned cvtpk(float lo, float hi) { unsigned r; asm volatile("v_cvt_pk_bf16_f32 %0, %1, %2" : "=v"(r) : "v"(lo), "v"(hi)); return r; }
__device__ __forceinline__ float bf2f(short s) { return __uint_as_float(((unsigned)(unsigned short)s) << 16); }
__device__ __forceinline__ float bflo(unsigned w) { return __uint_as_float(w << 16); }
__device__ __forceinline__ float bfhi(unsigned w) { return __uint_as_float(w & 0xffff0000u); }
__device__ __forceinline__ float wave_sum(float v) {
#pragma unroll
    for (int o = 1; o < 64; o <<= 1) v += __shfl_xor(v, o);
    return v;
}

namespace att {
#define SBAR() __builtin_amdgcn_sched_barrier(0)
__device__ __forceinline__ int crow(int r, int hi) { return (r & 3) + 8 * (r >> 2) + 4 * hi; }
template <int DH> __device__ __forceinline__ int kswz(int row, int colB) { return row * (DH * 2) + (colB ^ ((row & 7) << 4)); }
template <int DH> __device__ __forceinline__ int v_st(int k, int c) { const int kk = (k & ~0xC) | ((k & 4) << 1) | ((k & 8) >> 1); return ((kk >> 3) * (DH / 32) + (c >> 5)) * 512 + ((kk & 7) * 32 + (c & 31)) * 2; }
__device__ __forceinline__ int v_rd_base(int lane) { return ((lane & 3) << 3) | (((lane >> 2) & 3) << 6) | (((lane >> 4) & 1) << 5) | (((lane >> 5) & 1) << 8); }
template <int DH> constexpr int v_rd_off(int d0, int ks, int half) { return d0 * 512 + ks * (DH / 32) * 1024 + half * (DH / 32) * 512; }
template <int OFF> __device__ __forceinline__ s16x4 tr_read(int vb) { s16x4 r; asm volatile("ds_read_b64_tr_b16 %0, %1 offset:%2" : "=&v"(r) : "v"(vb), "i"(OFF) : "memory"); return r; }
template <int DH, int D0> __device__ __forceinline__ void pv_one(f32x16& od, int vb, bf16x8 pa0, bf16x8 pa1, bf16x8 pa2, bf16x8 pa3) {
  const s16x4 l0 = tr_read<v_rd_off<DH>(D0, 0, 0)>(vb), h0 = tr_read<v_rd_off<DH>(D0, 0, 1)>(vb), l1 = tr_read<v_rd_off<DH>(D0, 1, 0)>(vb), h1 = tr_read<v_rd_off<DH>(D0, 1, 1)>(vb);
  const s16x4 l2 = tr_read<v_rd_off<DH>(D0, 2, 0)>(vb), h2 = tr_read<v_rd_off<DH>(D0, 2, 1)>(vb), l3 = tr_read<v_rd_off<DH>(D0, 3, 0)>(vb), h3 = tr_read<v_rd_off<DH>(D0, 3, 1)>(vb);
  asm volatile("s_waitcnt lgkmcnt(0)" ::: "memory"); SBAR();
#define PK(L, H) (bf16x8){L[0], L[1], L[2], L[3], H[0], H[1], H[2], H[3]}
  od = __builtin_amdgcn_mfma_f32_32x32x16_bf16(pa0, PK(l0, h0), od, 0, 0, 0);
  od = __builtin_amdgcn_mfma_f32_32x32x16_bf16(pa1, PK(l1, h1), od, 0, 0, 0);
  od = __builtin_amdgcn_mfma_f32_32x32x16_bf16(pa2, PK(l2, h2), od, 0, 0, 0);
  od = __builtin_amdgcn_mfma_f32_32x32x16_bf16(pa3, PK(l3, h3), od, 0, 0, 0);
#undef PK
}
template <int DH> __device__ __forceinline__ void pv_all(f32x16* o, int vb, bf16x8 pa0, bf16x8 pa1, bf16x8 pa2, bf16x8 pa3) {
  pv_one<DH, 0>(o[0], vb, pa0, pa1, pa2, pa3); pv_one<DH, 1>(o[1], vb, pa0, pa1, pa2, pa3);
  if constexpr (DH == 128) { pv_one<DH, 2>(o[2], vb, pa0, pa1, pa2, pa3); pv_one<DH, 3>(o[3], vb, pa0, pa1, pa2, pa3); }
}
template <int DH> struct SC { static constexpr float SCALE = DH == 128 ? 0.088388347648318440f : 0.125f; static constexpr float C = SCALE * 1.4426950408889634f; static constexpr float THRS = 8.f / SCALE; };
template <int DH> __device__ __forceinline__ void partialSM(f32x16& p0, f32x16& p1, float& m_reg, float& mn, float& alpha) {
  constexpr float C = SC<DH>::C;
  float pmax = p0[0];
#pragma unroll
  for (int r = 1; r < 16; ++r) pmax = fmaxf(pmax, p0[r]);
#pragma unroll
  for (int r = 0; r < 16; ++r) pmax = fmaxf(pmax, p1[r]);
  { auto rr = __builtin_amdgcn_permlane32_swap(__float_as_uint(pmax), __float_as_uint(pmax), false, false);
    pmax = fmaxf(__uint_as_float(rr[0]), __uint_as_float(rr[1])); }
  if (__builtin_expect(__all(pmax - m_reg <= SC<DH>::THRS), 1)) { mn = m_reg; alpha = 1.f; }
  else { mn = fmaxf(m_reg, pmax); alpha = __builtin_amdgcn_exp2f((m_reg - mn) * C); m_reg = mn; }
  const float mnC = -mn * C;
#pragma unroll
  for (int r = 0; r < 16; ++r) p0[r] = fmaf(p0[r], C, mnC);
#pragma unroll
  for (int r = 0; r < 16; ++r) p1[r] = fmaf(p1[r], C, mnC);
#pragma unroll
  for (int r = 0; r < 16; ++r) p0[r] = __builtin_amdgcn_exp2f(p0[r]);
}
__device__ __forceinline__ void finishSM(f32x16& p0, f32x16& p1, float alpha, float& l_reg, bf16x8& pa0, bf16x8& pa1, bf16x8& pa2, bf16x8& pa3) {
#pragma unroll
  for (int r = 0; r < 16; ++r) p1[r] = __builtin_amdgcn_exp2f(p1[r]);
  float ps = 0;
#pragma unroll
  for (int r = 0; r < 16; ++r) ps += p0[r];
#pragma unroll
  for (int r = 0; r < 16; ++r) ps += p1[r];
  { auto rr = __builtin_amdgcn_permlane32_swap(__float_as_uint(ps), __float_as_uint(ps), false, false);
    ps = __uint_as_float(rr[0]) + __uint_as_float(rr[1]); }
  l_reg = l_reg * alpha + ps;
#define PK4(P, BASE, OUT) do { unsigned a0 = cvtpk(P[BASE + 0], P[BASE + 1]), a1 = cvtpk(P[BASE + 2], P[BASE + 3]);   \
    unsigned b0 = cvtpk(P[BASE + 4], P[BASE + 5]), b1 = cvtpk(P[BASE + 6], P[BASE + 7]);                              \
    auto r0 = __builtin_amdgcn_permlane32_swap(a0, b0, false, false); auto r1 = __builtin_amdgcn_permlane32_swap(a1, b1, false, false); \
    u32x4 w = {r0[0], r1[0], r0[1], r1[1]}; OUT = *reinterpret_cast<bf16x8*>(&w); } while (0)
  PK4(p0, 0, pa0); PK4(p0, 8, pa1); PK4(p1, 0, pa2); PK4(p1, 8, pa3);
#undef PK4
}
template <int DH> __device__ __forceinline__ void qkt(f32x16& p0, f32x16& p1, const char* Ks, const bf16x8* qr, int r32, int hi) {
  p0 = f32x16{}; p1 = f32x16{};
#pragma unroll
  for (int d0 = 0; d0 < DH / 16; ++d0) { const int cb = (d0 * 16 + hi * 8) * 2;
    const bf16x8 b0 = *reinterpret_cast<const bf16x8*>(Ks + kswz<DH>(r32, cb));
    const bf16x8 b1 = *reinterpret_cast<const bf16x8*>(Ks + kswz<DH>(32 + r32, cb));
    p0 = __builtin_amdgcn_mfma_f32_32x32x16_bf16(b0, qr[d0], p0, 0, 0, 0);
    p1 = __builtin_amdgcn_mfma_f32_32x32x16_bf16(b1, qr[d0], p1, 0, 0, 0); }
}
__device__ __forceinline__ void wmask(f32x16& p0, f32x16& p1, int kp0, int qp, int hi) {
  const int d0 = kp0 + 4 * hi - qp;
#pragma unroll
  for (int r = 0; r < 16; ++r) { const int d = d0 + (r & 3) + 8 * (r >> 2); if (d > 128 || d < -128) p0[r] = -1e30f; if (d + 32 > 128 || d + 32 < -128) p1[r] = -1e30f; }
}
struct UnitDesc {
  const bf16* Q; const bf16* Kc; const bf16* Vc; bf16* O;
  long ctx_row0, lat_row0; int nctx, band_kp0, NT, qpos0;
  const float* cosT; const float* sinT; const float* qg; float sink_l2;
};
template <int DH, int PITCH, bool QKNORM, bool MASK>
__device__ __forceinline__ void attn_unit(const UnitDesc& u, char* lds) {
  constexpr int NB = DH / 16, NO = DH / 32, TB = 64 * DH * 2, NLD = DH / 64, SDEPTH = DH == 128 ? 1 : 2;
  int tid = threadIdx.x; asm volatile("" : "+v"(tid));
  const int wid = tid >> 6, lane = tid & 63, r32 = lane & 31, hi = lane >> 5;
  char* V_lds = lds; char* K_lds = lds + 2 * TB;
  float* ws = (float*)(lds + 4 * TB) + wid * 64; float* li_l = ws; float* al_l = ws + 32;
  float m_reg = -1e30f, l_reg = 0; f32x16 o[NO];
#pragma unroll
  for (int d = 0; d < NO; ++d) o[d] = f32x16{};
  bf16x8 qr[NB];
  {
    const bf16* Qw = u.Q + (long)(wid * 32 + r32) * PITCH + hi * 8;
    float qf[NB][8];
#pragma unroll
    for (int d0 = 0; d0 < NB; ++d0) { const bf16x8 raw = *reinterpret_cast<const bf16x8*>(Qw + d0 * 16);
#pragma unroll
      for (int j = 0; j < 8; ++j) qf[d0][j] = bf2f(raw[j]); }
    if constexpr (QKNORM) {
      float ss = 0.f;
#pragma unroll
      for (int d0 = 0; d0 < NB; ++d0)
#pragma unroll
        for (int j = 0; j < 8; ++j) ss += qf[d0][j] * qf[d0][j];
      ss += __shfl_xor(ss, 32);
      const float rstd = rsqrtf(ss * (1.0f / DH) + 1e-6f);
#pragma unroll
      for (int d0 = 0; d0 < NB; ++d0) { const f32x4 g0 = *(const f32x4*)(u.qg + d0 * 16 + hi * 8), g1 = *(const f32x4*)(u.qg + d0 * 16 + hi * 8 + 4);
#pragma unroll
        for (int j = 0; j < 4; ++j) { qf[d0][j] *= rstd * g0[j]; qf[d0][4 + j] *= rstd * g1[j]; } }
    }
    if (u.qpos0 >= 0) {
      const int pos = u.qpos0 + wid * 32 + r32;
      const float* cp = u.cosT + (long)pos * (DH / 2) + hi * 8; const float* sp = u.sinT + (long)pos * (DH / 2) + hi * 8;
#pragma unroll
      for (int d0 = 0; d0 < NB / 2; ++d0) {
        const f32x4 c0 = *(const f32x4*)(cp + d0 * 16), c1 = *(const f32x4*)(cp + d0 * 16 + 4), s0 = *(const f32x4*)(sp + d0 * 16), s1 = *(const f32x4*)(sp + d0 * 16 + 4);
#pragma unroll
        for (int j = 0; j < 8; ++j) { const float c = j < 4 ? c0[j & 3] : c1[j & 3], s = j < 4 ? s0[j & 3] : s1[j & 3];
          const float x1 = qf[d0][j], x2 = qf[d0 + NB / 2][j]; qf[d0][j] = x1 * c - x2 * s; qf[d0 + NB / 2][j] = x2 * c + x1 * s; }
      }
    }
#pragma unroll
    for (int d0 = 0; d0 < NB; ++d0) { u32x4 w = {cvtpk(qf[d0][0], qf[d0][1]), cvtpk(qf[d0][2], qf[d0][3]), cvtpk(qf[d0][4], qf[d0][5]), cvtpk(qf[d0][6], qf[d0][7])}; qr[d0] = *reinterpret_cast<bf16x8*>(&w); }
  }
  const int sr = DH == 128 ? (tid >> 4) : (tid >> 3), sc = DH == 128 ? (tid & 15) * 8 : (tid & 7) * 8;
  const int vb0 = (int)(uintptr_t)V_lds + v_rd_base(lane);
  struct { bf16x8 v[NLD], k[NLD]; } st_[SDEPTH];
  const int qp = u.qpos0 + wid * 32 + r32;
#define TROW(t) ((t) < u.nctx ? u.ctx_row0 + 64 * (t) : u.lat_row0 + u.band_kp0 + 64 * ((t) - u.nctx))
#define TKP(t) (u.band_kp0 + 64 * ((t) - u.nctx))
#define SLOAD(i, t) do { const long row_ = TROW(t); _Pragma("unroll") for (int l_ = 0; l_ < NLD; ++l_) { \
    st_[i].v[l_] = *reinterpret_cast<const bf16x8*>(u.Vc + (row_ + sr + 32 * l_) * PITCH + sc); st_[i].k[l_] = *reinterpret_cast<const bf16x8*>(u.Kc + (row_ + sr + 32 * l_) * PITCH + sc); } } while (0)
#define SWRITE(b, i) do { _Pragma("unroll") for (int l_ = 0; l_ < NLD; ++l_) { *(bf16x8*)(V_lds + (b) * TB + v_st<DH>(sr + 32 * l_, sc)) = st_[i].v[l_]; \
    *(bf16x8*)(K_lds + (b) * TB + kswz<DH>(sr + 32 * l_, sc * 2)) = st_[i].k[l_]; } } while (0)
#define SWAIT() do { if constexpr (SDEPTH == 1) asm volatile("s_waitcnt vmcnt(0)" ::: "memory"); else if constexpr (NLD == 2) asm volatile("s_waitcnt vmcnt(4)" ::: "memory"); else asm volatile("s_waitcnt vmcnt(2)" ::: "memory"); } while (0)
#define RESC(a) do { if (__any((a) < 1.f)) { if (hi == 0) al_l[r32] = (a); asm volatile("s_waitcnt lgkmcnt(0)" ::: "memory"); \
    _Pragma("unroll") for (int d = 0; d < NO; ++d) _Pragma("unroll") for (int r = 0; r < 16; ++r) o[d][r] *= al_l[crow(r, hi)]; } } while (0)
#define AMASK(P0, P1, t) do { if constexpr (MASK) { if ((t) >= u.nctx && (TKP(t) < qw - 97 || TKP(t) + 63 > qw + 128)) wmask(P0, P1, TKP(t), qp, hi); } } while (0)
  f32x16 pA0, pA1, pB0, pB1; float mnA, mnB, alA, alB; bf16x8 pa0, pa1, pa2, pa3; const int NT = u.NT;
  constexpr int SE = 0, SO = SDEPTH - 1;
  const int qw = __builtin_amdgcn_readfirstlane(u.qpos0 + wid * 32);
#define ACT(t) (!MASK || (t) < u.nctx || (TKP(t) <= qw + 159 && TKP(t) + 63 >= qw - 128))
  bool actA = true, actB = true;
  SLOAD(SE, 0); asm volatile("s_waitcnt vmcnt(0)" ::: "memory"); SWRITE(0, SE); __syncthreads();
  qkt<DH>(pA0, pA1, K_lds, qr, r32, hi); AMASK(pA0, pA1, 0); partialSM<DH>(pA0, pA1, m_reg, mnA, alA);
  SLOAD(SO, 1); if constexpr (SDEPTH == 2) { if (2 < NT) SLOAD(SE, 2); }
  SWAIT(); SWRITE(1, SO); __syncthreads();
  for (int j = 1; j + 1 < NT; j += 2) {
    actB = ACT(j);
    SBAR(); if (actB) { qkt<DH>(pB0, pB1, K_lds + TB, qr, r32, hi); AMASK(pB0, pB1, j); }
    if (actA) finishSM(pA0, pA1, alA, l_reg, pa0, pa1, pa2, pa3); SBAR();
    SLOAD(SO, j + SDEPTH); SBAR();
    if (actA) pv_all<DH>(o, vb0, pa0, pa1, pa2, pa3);
    if (actB) partialSM<DH>(pB0, pB1, m_reg, mnB, alB); else alB = 1.f;
    __syncthreads(); SWAIT(); SWRITE(0, SE);
    RESC(alB); __syncthreads();
    actA = ACT(j + 1);
    SBAR(); if (actA) { qkt<DH>(pA0, pA1, K_lds, qr, r32, hi); AMASK(pA0, pA1, j + 1); }
    if (actB) finishSM(pB0, pB1, alB, l_reg, pa0, pa1, pa2, pa3); SBAR();
    if (SDEPTH == 1 || j + 3 < NT) SLOAD(SE, j + 1 + SDEPTH); SBAR();
    if (actB) pv_all<DH>(o, vb0 + TB, pa0, pa1, pa2, pa3);
    if (actA) partialSM<DH>(pA0, pA1, m_reg, mnA, alA); else alA = 1.f;
    __syncthreads(); SWAIT(); SWRITE(1, SO);
    RESC(alA); __syncthreads();
  }
  actB = ACT(NT - 1);
  SBAR(); if (actB) { qkt<DH>(pB0, pB1, K_lds + TB, qr, r32, hi); AMASK(pB0, pB1, NT - 1); }
  if (actA) finishSM(pA0, pA1, alA, l_reg, pa0, pa1, pa2, pa3); SBAR();
  if (actA) pv_all<DH>(o, vb0, pa0, pa1, pa2, pa3);
  if (actB) partialSM<DH>(pB0, pB1, m_reg, mnB, alB); else alB = 1.f;
  __syncthreads(); RESC(alB);
  if (actB) { finishSM(pB0, pB1, alB, l_reg, pa0, pa1, pa2, pa3); SBAR();
    pv_all<DH>(o, vb0 + TB, pa0, pa1, pa2, pa3); }
#undef ACT
  l_reg += __builtin_amdgcn_exp2f(u.sink_l2 - m_reg * SC<DH>::C);
  if (hi == 0) li_l[r32] = l_reg; asm volatile("s_waitcnt lgkmcnt(0)" ::: "memory");
  float rli[16];
#pragma unroll
  for (int r = 0; r < 16; ++r) rli[r] = __builtin_amdgcn_rcpf(li_l[crow(r, hi)]);
  { bf16* stg = (bf16*)(lds + 4 * TB + 2048) + wid * (32 * DH);
#pragma unroll
    for (int r = 0; r < 16; ++r) { const int orow = crow(r, hi);
#pragma unroll
      for (int d0 = 0; d0 < NO; ++d0) { const float v = o[d0][r] * rli[r]; const unsigned w = cvtpk(v, v); stg[orow * DH + d0 * 32 + r32] = (bf16)(w & 0xffffu); } }
    asm volatile("s_waitcnt lgkmcnt(0)" ::: "memory");
    constexpr int CPR = DH / 8, RPI = 64 / CPR;
    bf16* Ow = u.O + (long)(wid * 32) * DM;
#pragma unroll
    for (int i = 0; i < 32 / RPI; ++i) { const int row = i * RPI + lane / CPR, ch = lane % CPR; const u32x4 v = *(const u32x4*)(stg + row * DH + ch * 8); *(u32x4*)(Ow + (long)row * DM + ch * 8) = v; } }
  __syncthreads();
#undef TROW
#undef TKP
#undef SLOAD
#undef SWRITE
#undef SWAIT
#undef RESC
#undef AMASK
}
}

__device__ __forceinline__ void transpose_item(const float* W, int K, int N, bf16* WT, int k0, int n0, int drow0, LAS float* scr, int lane) {
    float tv[32];
#pragma unroll
    for (int i = 0; i < 32; ++i) tv[i] = W[(size_t)(k0 + 2 * i + (lane >> 5)) * N + n0 + (lane & 31)];
#pragma unroll
    for (int i = 0; i < 32; ++i) scr[(2 * i + (lane >> 5)) * 33 + (lane & 31)] = tv[i];
    asm volatile("s_waitcnt lgkmcnt(0)" ::: "memory");
    const int c = lane & 7;
#pragma unroll
    for (int j = 0; j < 4; ++j) { const int n = (lane >> 3) + 8 * j; const LAS float* s = scr + (8 * c) * 33 + n;
        u32x4 o; o.x = cvtpk(s[0 * 33], s[1 * 33]); o.y = cvtpk(s[2 * 33], s[3 * 33]); o.z = cvtpk(s[4 * 33], s[5 * 33]); o.w = cvtpk(s[6 * 33], s[7 * 33]);
        *(u32x4*)(WT + (size_t)(drow0 + n) * K + k0 + 8 * c) = o; }
    asm volatile("s_waitcnt lgkmcnt(0)" ::: "memory");
}
__device__ __forceinline__ int ffn_in_row(int n0) { return n0 < FFH ? 256 * (n0 >> 7) + (n0 & 127) : 256 * ((n0 - FFH) >> 7) + 128 + ((n0 - FFH) & 127); }

struct RowJob { const float* xin; const bf16* y; float* xout; bf16* h; const float* gate; const float* sh; const float* sc; };
template <int NR, bool HASY, bool HASH>
__device__ __forceinline__ void combine_rows(const RowJob (&J)[NR], const float* npost, const float* npre, int lane, float gmul) {
    f32x4 xv[NR][4]; u32x2 yv[NR][4];
#pragma unroll
    for (int q = 0; q < NR; ++q)
#pragma unroll
        for (int j = 0; j < 4; ++j) { xv[q][j] = ((const f32x4*)J[q].xin)[lane + 64 * j]; if constexpr (HASY) yv[q][j] = ((const u32x2*)J[q].y)[lane + 64 * j]; }
    if constexpr (HASY) {
        float rstd[NR];
#pragma unroll
        for (int q = 0; q < NR; ++q) { float ss = 0.f;
#pragma unroll
            for (int j = 0; j < 4; ++j) { const float a = bflo(yv[q][j].x), b = bfhi(yv[q][j].x), c = bflo(yv[q][j].y), d = bfhi(yv[q][j].y); ss += (a * a + b * b) + (c * c + d * d); }
            rstd[q] = rsqrtf(wave_sum(ss) * (1.0f / DM) + 1e-6f) * gmul; }
#pragma unroll
        for (int j = 0; j < 4; ++j) { const f32x4 n4 = ((const f32x4*)npost)[lane + 64 * j];
#pragma unroll
            for (int q = 0; q < NR; ++q) { const f32x4 g4 = ((const f32x4*)J[q].gate)[lane + 64 * j];
                const f32x4 yf = {bflo(yv[q][j].x), bfhi(yv[q][j].x), bflo(yv[q][j].y), bfhi(yv[q][j].y)};
                xv[q][j] = xv[q][j] + g4 * (yf * rstd[q] * n4);
                ((f32x4*)J[q].xout)[lane + 64 * j] = xv[q][j]; } }
    }
    if constexpr (HASH) {
        float rstd[NR];
#pragma unroll
        for (int q = 0; q < NR; ++q) { float ss = 0.f;
#pragma unroll
            for (int j = 0; j < 4; ++j) ss += (xv[q][j].x * xv[q][j].x + xv[q][j].y * xv[q][j].y) + (xv[q][j].z * xv[q][j].z + xv[q][j].w * xv[q][j].w);
            rstd[q] = rsqrtf(wave_sum(ss) * (1.0f / DM) + 1e-6f); }
#pragma unroll
        for (int j = 0; j < 4; ++j) { const f32x4 n4 = ((const f32x4*)npre)[lane + 64 * j];
#pragma unroll
            for (int q = 0; q < NR; ++q) { const f32x4 s4 = ((const f32x4*)J[q].sc)[lane + 64 * j], b4 = ((const f32x4*)J[q].sh)[lane + 64 * j];
                const f32x4 hv = (xv[q][j] * rstd[q] * n4) * (s4 + 1.0f) + b4;
                u32x2 w; w.x = cvtpk(hv.x, hv.y); w.y = cvtpk(hv.z, hv.w); ((u32x2*)J[q].h)[lane + 64 * j] = w; } }
    }
}

template <bool HASY, bool HASH, bool XIN32 = true, bool XOUT32 = true>
__device__ __forceinline__ void combine_span(int mb, int me, const void* xin_lat, const void* xin_ctx, void* xout_lat, void* xout_ctx, const bf16* Y, bf16* H,
                                             const float* gate0, const float* npost, const float* sh0, const float* sc0, const float* npre, int lane, float gmul) {
    int cur_r = -1; f32x4 A1[4], A2[4], B2[4];
    for (int m = mb; m < me;) {
        const int r = m < MLAT ? (m >> 11) : 32;
        if (r != cur_r) { cur_r = r;
#pragma unroll
            for (int j = 0; j < 4; ++j) {
                if constexpr (HASY) A1[j] = ((const f32x4*)(gate0 + (size_t)r * MODW))[lane + 64 * j] * ((const f32x4*)npost)[lane + 64 * j] * gmul;
                if constexpr (HASH) { A2[j] = ((const f32x4*)npre)[lane + 64 * j] * (((const f32x4*)(sc0 + (size_t)r * MODW))[lane + 64 * j] + 1.0f); B2[j] = ((const f32x4*)(sh0 + (size_t)r * MODW))[lane + 64 * j]; } } }
        const int mn = m + 1; const bool two = mn < me && (mn < MLAT ? (mn >> 11) : 32) == r;
        const int mq[2] = {m, two ? mn : m};
        f32x4 xv[2][4]; u32x2 yv[2][4];
#pragma unroll
        for (int q = 0; q < 2; ++q) { const int mm = mq[q]; const size_t eo = mm < MLAT ? (size_t)mm * DM : (size_t)(mm - MLAT) * DM; const void* xb = mm < MLAT ? xin_lat : xin_ctx;
#pragma unroll
            for (int j = 0; j < 4; ++j) {
                if constexpr (XIN32) xv[q][j] = ((const f32x4*)((const float*)xb + eo))[lane + 64 * j];
                else { const u32x2 w = ((const u32x2*)((const bf16*)xb + eo))[lane + 64 * j]; xv[q][j] = (f32x4){bflo(w.x), bfhi(w.x), bflo(w.y), bfhi(w.y)}; }
                if constexpr (HASY) yv[q][j] = ((const u32x2*)(Y + (size_t)mm * DM))[lane + 64 * j]; } }
        if constexpr (HASY) {
            float rstd[2];
#pragma unroll
            for (int q = 0; q < 2; ++q) { float ss = 0.f;
#pragma unroll
                for (int j = 0; j < 4; ++j) { const float a = bflo(yv[q][j].x), b = bfhi(yv[q][j].x), c = bflo(yv[q][j].y), d = bfhi(yv[q][j].y); ss += (a * a + b * b) + (c * c + d * d); }
                rstd[q] = rsqrtf(wave_sum(ss) * (1.0f / DM) + 1e-6f); }
#pragma unroll
            for (int q = 0; q < 2; ++q) { const int mm = mq[q]; const size_t eo = mm < MLAT ? (size_t)mm * DM : (size_t)(mm - MLAT) * DM; void* xb = mm < MLAT ? xout_lat : xout_ctx;
#pragma unroll
                for (int j = 0; j < 4; ++j) { const f32x4 yf = {bflo(yv[q][j].x), bfhi(yv[q][j].x), bflo(yv[q][j].y), bfhi(yv[q][j].y)};
                    xv[q][j] = xv[q][j] + A1[j] * (yf * rstd[q]);
                    if constexpr (XOUT32) ((f32x4*)((float*)xb + eo))[lane + 64 * j] = xv[q][j];
                    else { u32x2 w; w.x = cvtpk(xv[q][j].x, xv[q][j].y); w.y = cvtpk(xv[q][j].z, xv[q][j].w); ((u32x2*)((bf16*)xb + eo))[lane + 64 * j] = w;
                        xv[q][j] = (f32x4){bflo(w.x), bfhi(w.x), bflo(w.y), bfhi(w.y)}; } } }
        }
        if constexpr (HASH) {
            float rstd[2];
#pragma unroll
            for (int q = 0; q < 2; ++q) { float ss = 0.f;
#pragma unroll
                for (int j = 0; j < 4; ++j) ss += (xv[q][j].x * xv[q][j].x + xv[q][j].y * xv[q][j].y) + (xv[q][j].z * xv[q][j].z + xv[q][j].w * xv[q][j].w);
                rstd[q] = rsqrtf(wave_sum(ss) * (1.0f / DM) + 1e-6f); }
#pragma unroll
            for (int q = 0; q < 2; ++q) { const int mm = mq[q];
#pragma unroll
                for (int j = 0; j < 4; ++j) { const f32x4 hv = (xv[q][j] * rstd[q]) * A2[j] + B2[j];
                    u32x2 w; w.x = cvtpk(hv.x, hv.y); w.y = cvtpk(hv.z, hv.w); ((u32x2*)(H + (size_t)mm * DM))[lane + 64 * j] = w; } }
        }
        m += two ? 2 : 1;
    }
}

#define XB_TMO      128
#define XB_XCNT(j)  (256  + 64 * (j))
#define XB_XSUB(j)  (1280 + 64 * (j))
#define XB_XGEN(j)  (2304 + 64 * (j))
#define XB_TOP      3328
#define XB_TOPGEN   3392
#define XCD_BAR_WORDS 3456
#define XB_SPIN_CAP (1u << 18)

__device__ __forceinline__ unsigned xb_ld(unsigned* p)              { return __hip_atomic_load(p, __ATOMIC_RELAXED, __HIP_MEMORY_SCOPE_AGENT); }
__device__ __forceinline__ unsigned xb_add(unsigned* p, unsigned v) { return __hip_atomic_fetch_add(p, v, __ATOMIC_RELAXED, __HIP_MEMORY_SCOPE_AGENT); }
__device__ __forceinline__ unsigned xb_xcc_id() { return (unsigned)__builtin_amdgcn_s_getreg((3 << 11) | 20) & 0xFu; }
#define XB_SPIN(cond, bar) do { unsigned _sp = 0; while (cond) { __builtin_amdgcn_s_sleep(1); \
    if ((++_sp & 255u) == 0u) { if (xb_ld(&(bar)[XB_TMO])) break; if (_sp > XB_SPIN_CAP) { atomicAdd(&(bar)[XB_TMO], 1u); break; } } } } while (0)

struct XcdBarrier {
    unsigned* bar; unsigned x;
    volatile LAS unsigned* st;
};

__device__ __forceinline__ XcdBarrier xcd_barrier_post(unsigned* bar, volatile LAS unsigned* st) {
    XcdBarrier b; b.bar = bar; b.x = xb_xcc_id(); b.st = st;
    if (threadIdx.x == 0) (void)xb_add(&bar[XB_XCNT(b.x)], 1u);
    return b;
}
__device__ __forceinline__ void xcd_barrier_complete(unsigned* bar, unsigned x, unsigned& nloc, unsigned& nx) {
    const unsigned G = gridDim.x * gridDim.y * gridDim.z;
    unsigned sum, cnt, mine, sp = 0u;
    for (;;) {
        sum = 0u; cnt = 0u; mine = 0u;
#pragma unroll
        for (unsigned j = 0; j < 16; ++j) { const unsigned c = xb_ld(&bar[XB_XCNT(j)]); sum += c; cnt += (c > 0u) ? 1u : 0u; mine = (j == x) ? c : mine; }
        if (sum == G) break;
        __builtin_amdgcn_s_sleep(1);
        if ((++sp & 255u) == 0u) { if (xb_ld(&bar[XB_TMO])) break; if (sp > XB_SPIN_CAP) { atomicAdd(&bar[XB_TMO], 1u); break; } }
    }
    nloc = mine > 0u ? mine : 1u; nx = cnt > 0u ? cnt : 1u;
}

__device__ __forceinline__ void xcd_barrier(const XcdBarrier& b) {
    asm volatile("s_waitcnt vmcnt(0)" ::: "memory");
    __syncthreads();
    if (threadIdx.x == 0) {
        unsigned* bar = b.bar;
        __builtin_amdgcn_s_waitcnt(0);
        unsigned nloc = b.st[0], nx = b.st[1];
        if (nloc == 0u) { xcd_barrier_complete(bar, b.x, nloc, nx); b.st[0] = nloc; b.st[1] = nx; }
        const unsigned old = xb_add(&bar[XB_XSUB(b.x)], 1u);
        const unsigned gen = old / nloc;
        if (old + 1u == (gen + 1u) * nloc) {
            __builtin_amdgcn_fence(__ATOMIC_RELEASE, "agent");
            asm volatile("s_waitcnt vmcnt(0)" ::: "memory");
            const unsigned og = xb_add(&bar[XB_TOP], 1u);
            const unsigned tg = og / nx;
            if (og + 1u == (tg + 1u) * nx) xb_add(&bar[XB_TOPGEN], 1u);
            else XB_SPIN(xb_ld(&bar[XB_TOPGEN]) == tg, bar);
            __builtin_amdgcn_fence(__ATOMIC_ACQUIRE, "agent");
            xb_add(&bar[XB_XGEN(b.x)], 1u);
            asm volatile("s_waitcnt vmcnt(0)" ::: "memory");
        } else {
            XB_SPIN(xb_ld(&bar[XB_XGEN(b.x)]) == gen, bar);
            __builtin_amdgcn_fence(__ATOMIC_ACQUIRE, "agent");
            asm volatile("s_waitcnt vmcnt(0)" ::: "memory");
        }
    }
    __syncthreads();
}

struct Args { const float* in[23]; float* out; unsigned char* ws; int ph_lo, ph_hi; };

__global__ void __launch_bounds__(512, 2) mega(Args args) {
    extern __shared__ __attribute__((aligned(16))) unsigned char lds[];
    cg::grid_group grid = cg::this_grid();
    const int G = gridDim.x, bx = blockIdx.x;
    const int vcu = (G % 8 == 0) ? (bx % 8) * (G / 8) + bx / 8 : bx;
    const int NGW = G * 8;
    const int lo = args.ph_lo, hi = args.ph_hi;
    unsigned char* ws = args.ws;
    const float* x_in = args.in[0]; const float* c_in = args.in[1]; const float* ctx_in = args.in[2]; const float* cctx_in = args.in[3];
    const float* ada_w = args.in[4]; const float* ada_b = args.in[5]; const float* norm_g = args.in[6];
    float* modp = (float*)(ws + OFF_MODP); float* mods = (float*)(ws + OFF_MODS);
    float* cosA = (float*)(ws + OFF_ROPE); float* sinA = cosA + 2048 * 32; float* cosC = sinA + 2048 * 32; float* sinC = cosC + 2048 * 64;
    bf16* Wsb = (bf16*)(ws + OFF_WS);
    unsigned char* Wb = ws + OFF_W;
#ifndef XBF16
#define XBF16 0
#endif
    void* XC = (void*)(ws + OFF_XC); void* XL = XBF16 ? (void*)(ws + OFF_XLB) : (void*)args.out;
    bf16* Hb = (bf16*)(ws + OFF_H); bf16* Yb = (bf16*)(ws + OFF_Y); bf16* QKV = (bf16*)(ws + OFF_BIG); bf16* Ob = (bf16*)(ws + OFF_O); bf16* HID = (bf16*)(ws + OFF_BIG);
    if (threadIdx.x < 16) ((LAS unsigned*)((LAS unsigned char*)lds + LDS_XB))[threadIdx.x] = 0u;
    __syncthreads();
    const XcdBarrier xbar = xcd_barrier_post((unsigned*)(ws + OFF_CTL), (volatile LAS unsigned*)((LAS unsigned char*)lds + LDS_XB));
    bool first_seam = false;
    int ph = 0;
#define GSYNC() do { if (first_seam) { grid.sync(); first_seam = false; } else xcd_barrier(xbar); } while (0)
    first_seam = args.ph_hi < 0;
#ifndef PH_MASK
#define PH_MASK 0xffff
#endif
#define RUN(p) (lo <= (p) && (p) < hi)
#define ON(b) ((PH_MASK >> (b)) & 1)
#ifndef G1MASK
#define G1MASK 7
#endif
#ifndef ATMASK
#define ATMASK 3
#endif
#define ATK(k) ((ATMASK >> (k)) & 1)
#define G1K(k) ((G1MASK >> (k)) & 1)
#define SEAM(p) do { if (RUN(p) && RUN((p) + 1)) GSYNC(); } while (0)

#ifndef NPRO
#define NPRO 1
#endif
#ifndef CMB_F1
#define CMB_F1 5
#endif
#ifndef CMB_F2
#define CMB_F2 6
#endif
#ifndef EPI_SKIP_ON_REP
#define EPI_SKIP_ON_REP 0
#endif
#ifdef EXTRA_SYNCS
    for (int es = 0; es < EXTRA_SYNCS; ++es) GSYNC();
#endif
    for (int prep = 0; prep < NPRO; ++prep) {
    if (prep) { GSYNC(); ph -= 3; }
    int tid = threadIdx.x; asm volatile("" : "+v"(tid));
    const int lane = tid & 63, wave = __builtin_amdgcn_readfirstlane(tid >> 6), gw = vcu * 8 + wave;
    if (ON(0) && RUN(ph)) {
        LAS float* scr = (LAS float*)((LAS unsigned char*)lds + wave * 16896);
        for (int it = gw; it < 96 * 8; it += NGW) {
            const int cb = it % 96, ks = it / 96, k0 = ks * 128;
            for (int idx = lane; idx < NMODROW * 128; idx += 64) { const int r = idx >> 7, kk = idx & 127; const float v = r < 32 ? c_in[r * DM + k0 + kk] : cctx_in[k0 + kk];
                scr[idx] = v / (1.0f + __expf(-v)); }
            asm volatile("s_waitcnt lgkmcnt(0)" ::: "memory");
            f32x4 acc[NMODROW];
#pragma unroll
            for (int r = 0; r < NMODROW; ++r) acc[r] = (f32x4){0.f, 0.f, 0.f, 0.f};
            const int li = cb / 24, col0 = (cb % 24) * 256 + lane * 4;
            const float* wp = ada_w + ((size_t)li * DM + k0) * MODW + col0;
#pragma unroll 2
            for (int kk = 0; kk < 128; ++kk) { const f32x4 w4 = *(const f32x4*)(wp + (size_t)kk * MODW);
#pragma unroll
                for (int r = 0; r < NMODROW; ++r) { const float s = scr[r * 128 + kk]; acc[r] = acc[r] + w4 * s; } }
#pragma unroll
            for (int r = 0; r < NMODROW; ++r) *(f32x4*)(modp + ((size_t)ks * NMODROW + r) * (4 * MODW) + li * MODW + col0) = acc[r];
            asm volatile("s_waitcnt lgkmcnt(0)" ::: "memory");
        }
        {
            constexpr int I_FI = 16 * 176, I_FO = 44 * 32, I_AQ = 16 * 48, I_AO = 16 * 32, I_BI = 16 * 64, I_BO = 16 * 32, I_CQ = 16 * 64, I_CO = 16 * 32;
            constexpr int NIT = 4 * I_FI + 4 * I_FO + 2 * I_AQ + 2 * I_AO + I_BI + I_BO + I_CQ + I_CO;
            const int ntw = NGW > 1024 ? NGW - 768 : NGW, tw = NGW > 1024 ? gw - 768 : gw;
            if (tw >= 0) for (int it = tw; it < NIT; it += ntw) {
                int r = it;
                if (r < 4 * I_FI) { const int l = r / I_FI; r %= I_FI; const int kb = r / 176, nb = r % 176;
                    transpose_item(args.in[7] + (size_t)l * DM * 2 * FFH, DM, 2 * FFH, (bf16*)(Wb + W_FI) + (size_t)l * 2 * FFH * DM, kb * 64, nb * 32, ffn_in_row(nb * 32), scr, lane); continue; } r -= 4 * I_FI;
                if (r < 4 * I_FO) { const int l = r / I_FO; r %= I_FO; const int kb = r / 32, nb = r % 32;
                    transpose_item(args.in[8] + (size_t)l * FFH * DM, FFH, DM, (bf16*)(Wb + W_FO) + (size_t)l * DM * FFH, kb * 64, nb * 32, nb * 32, scr, lane); continue; } r -= 4 * I_FO;
                if (r < 2 * I_AQ) { const int l = r / I_AQ; r %= I_AQ; const int kb = r / 48, nb = r % 48;
                    transpose_item(args.in[9] + (size_t)l * DM * 1536, DM, 1536, (bf16*)(Wb + W_AQ) + (size_t)l * 1536 * DM, kb * 64, nb * 32, nb * 32, scr, lane); continue; } r -= 2 * I_AQ;
                if (r < 2 * I_AO) { const int l = r / I_AO; r %= I_AO; const int kb = r / 32, nb = r % 32;
                    transpose_item(args.in[10] + (size_t)l * DM * DM, DM, DM, (bf16*)(Wb + W_AO) + (size_t)l * DM * DM, kb * 64, nb * 32, nb * 32, scr, lane); continue; } r -= 2 * I_AO;
                if (r < I_BI) { const int kb = r / 64, nb = r % 64; transpose_item(args.in[12], DM, 2048, (bf16*)(Wb + W_BI), kb * 64, nb * 32, nb * 32, scr, lane); continue; } r -= I_BI;
                if (r < I_BO) { const int kb = r / 32, nb = r % 32; transpose_item(args.in[18], DM, DM, (bf16*)(Wb + W_BO), kb * 64, nb * 32, nb * 32, scr, lane); continue; } r -= I_BO;
                if (r < I_CQ) { const int kb = r / 64, nb = r % 64; transpose_item(args.in[19], DM, 2048, (bf16*)(Wb + W_CQ), kb * 64, nb * 32, nb * 32, scr, lane); continue; } r -= I_CQ;
                { const int kb = r / 32, nb = r % 32; transpose_item(args.in[20], DM, DM, (bf16*)(Wb + W_CO), kb * 64, nb * 32, nb * 32, scr, lane); }
            }
        }
        {
            const int gt = gw * 64 + lane, NGT = NGW * 64;
            const float* wsf = args.in[16];
            for (int e = gt; e < 8 * 128 * 128 / 2; e += NGT) ((unsigned*)Wsb)[e] = cvtpk(wsf[2 * e], wsf[2 * e + 1]);
            for (int e = gt; e < 2048 * 32; e += NGT) { const int t = e >> 5, p = e & 31, j = p & 15; const float pos = (float)(p < 16 ? (t >> 6) : (t & 63));
                const float inv = exp2f(-(float)j * (13.287712379549449f / 16.0f)); const float a = pos * inv; cosA[e] = cosf(a); sinA[e] = sinf(a); }
            for (int e = gt; e < 2048 * 64; e += NGT) { const int t = e >> 6, p = e & 63, j = p & 31; const float pos = (float)(p < 32 ? (t >> 6) : (t & 63));
                const float inv = exp2f(-(float)j * (13.287712379549449f / 32.0f)); const float a = pos * inv; cosC[e] = cosf(a); sinC[e] = sinf(a); }
        }
    }
    SEAM(ph); ++ph;
    if (ON(1) && RUN(ph)) {
        const int gt = gw * 64 + lane, NGT = NGW * 64;
        for (int e = gt; e < DEPTH * NMODROW * MODW / 4; e += NGT) {
            const int c4 = e % (MODW / 4), rr = (e / (MODW / 4)) % NMODROW, li = e / (MODW / 4 * NMODROW);
            f32x4 s = *(const f32x4*)(ada_b + li * MODW + c4 * 4);
#pragma unroll
            for (int k = 0; k < 8; ++k) s = s + *(const f32x4*)(modp + ((size_t)k * NMODROW + rr) * (4 * MODW) + li * MODW + c4 * 4);
            *(f32x4*)(mods + ((size_t)li * NMODROW + rr) * MODW + c4 * 4) = s;
        }
    }
    SEAM(ph); ++ph;
    if (ON(2) && RUN(ph)) {
        { const int rpw = (MTOT + NGW - 1) / NGW, mb = gw * rpw, me = mb + rpw < MTOT ? mb + rpw : MTOT;
          combine_span<false, true>(mb, me, x_in, ctx_in, nullptr, nullptr, nullptr, Hb, nullptr, nullptr, mods, mods + DM, norm_g, lane, 1.0f); }
    }
    SEAM(ph); ++ph;
    }

    constexpr int NOPS = 10;
    for (int step = 3, rep = 0; step < 3 + NOPS * DEPTH; ) {
        const int li = (step - 3) / NOPS, op = (step - 3) % NOPS;
        int tid = threadIdx.x; asm volatile("" : "+v"(tid));
        const int lane = tid & 63, wave = __builtin_amdgcn_readfirstlane(tid >> 6), gw = vcu * 8 + wave;
        const int kind = li % 3; const int ja = li / 3; const bool ctx_out = li < DEPTH - 1; const int Mact = ctx_out ? MTOT : MLAT;
        const float* ng = norm_g + (size_t)li * 4 * DM;
        const bool noop = (op == 1 && kind == 1) || ((op == 5 || op == 9) && !ctx_out);
        if (RUN(ph) && !noop) {
#ifdef STAGGER_US
            if (op == 0 || op == 3 || op == 5 || op == 6) {
                const unsigned long long t0 = __builtin_amdgcn_s_memrealtime(); const unsigned long long dl = (unsigned long long)(((bx >> 3) & 3) * STAGGER_US * 100);
                while (__builtin_amdgcn_s_memrealtime() - t0 < dl) __builtin_amdgcn_s_sleep(32);
            }
#endif
            if (ON(3) && ((op == 0 && kind != 1) || op == 3 || op == 7 || ((op == 4 || op == 8) && ctx_out))) {
                pg8::Gemm g; pg8::EpiBf16<0> E; E.bias = nullptr; E.split_cols = 0; E.split_stride = 0; E.scale0 = 1.f; E.skip = EPI_SKIP_ON_REP ? rep * EPI_SKIP_ON_REP : 0; E.scratch = Ob;
                if (op == 0) { const int N1 = kind == 0 ? 1536 : 2048; g.A = Hb; g.Bt = kind == 0 ? (const bf16*)(Wb + W_AQ) + (size_t)ja * 1536 * DM : (const bf16*)(Wb + W_CQ); g.M = MTOT; g.N = N1; g.K = DM; E.O = QKV; E.ldc = N1; }
                else if (op == 3 || op == 4) { const size_t ro = op == 4 ? (size_t)MLAT * DM : 0;
                    g.A = Ob + ro; g.Bt = kind == 0 ? (const bf16*)(Wb + W_AO) + (size_t)ja * DM * DM : kind == 1 ? (const bf16*)(Wb + W_BO) : (const bf16*)(Wb + W_CO); g.M = op == 4 ? MCTX : MLAT; g.N = DM; g.K = DM; E.O = Yb + ro; E.ldc = DM; }
                else { const bool cx = op == 8;
                    g.A = HID + (cx ? (size_t)MLAT * FFH : 0); g.Bt = (const bf16*)(Wb + W_FO) + (size_t)li * DM * FFH; g.M = cx ? MCTX : MLAT; g.N = DM; g.K = FFH; E.O = Yb + (cx ? (size_t)MLAT * DM : 0); E.ldc = DM; }
                pg8::StaticOrder S; S.init(g.M, g.N, G, bx);
                pg8::gemm_phase<pg8::EpiBf16<0>, pg8::StaticOrder, true, true>((PG8_LAS unsigned char*)lds, g, S, E);
            }
            else if (ON(4) && op == 0) {
                pg8::Gemm g{Hb, (const bf16*)(Wb + W_BI), MTOT, 2048, DM}; pg8::StaticOrder S; S.init(MTOT, 2048, G, bx);
                pg8::EpiBf16<1> E{QKV, 2048, args.in[13], 0, 0, 1.f, EPI_SKIP_ON_REP ? rep * EPI_SKIP_ON_REP : 0, Ob}; pg8::gemm_phase<pg8::EpiBf16<1>, pg8::StaticOrder, true, true>((PG8_LAS unsigned char*)lds, g, S, E);
            }
            else if (ON(5) && op == 6) {
                pg8::Gemm g{Hb, (const bf16*)(Wb + W_FI) + (size_t)li * 2 * FFH * DM, Mact, 2 * FFH, DM}; pg8::StaticOrder S; S.init(Mact, 2 * FFH, G, bx);
                pg8::EpiSwiglu E{HID, FFH}; pg8::gemm_phase<pg8::EpiSwiglu, pg8::StaticOrder, true, true>((PG8_LAS unsigned char*)lds, g, S, E);
            }
            else if (ON(6) && op == 1) {
                if (kind == 0) {
                    const int rs = lane >> 4, l16 = lane & 15, hd = l16 >> 2, i0 = (l16 & 3) * 8;
#pragma nounroll
                    for (int m = gw * 4 + rs; m < MLAT; m += NGW * 4) { const int t = m & 2047; bf16* kp = QKV + (size_t)m * 1536 + 1024 + hd * 64 + i0;
                        const bf16x8 x1 = *(const bf16x8*)kp, x2 = *(const bf16x8*)(kp + 32);
                        const f32x4 c0 = *(const f32x4*)(cosA + t * 32 + i0), c1 = *(const f32x4*)(cosA + t * 32 + i0 + 4), s0 = *(const f32x4*)(sinA + t * 32 + i0), s1 = *(const f32x4*)(sinA + t * 32 + i0 + 4);
                        float o1[8], o2[8];
#pragma unroll
                        for (int j = 0; j < 8; ++j) { const float c = j < 4 ? c0[j & 3] : c1[j & 3], sn = j < 4 ? s0[j & 3] : s1[j & 3]; const float a = bf2f(x1[j]), b = bf2f(x2[j]); o1[j] = a * c - b * sn; o2[j] = b * c + a * sn; }
                        *(u32x4*)kp = (u32x4){cvtpk(o1[0], o1[1]), cvtpk(o1[2], o1[3]), cvtpk(o1[4], o1[5]), cvtpk(o1[6], o1[7])};
                        *(u32x4*)(kp + 32) = (u32x4){cvtpk(o2[0], o2[1]), cvtpk(o2[2], o2[3]), cvtpk(o2[4], o2[5]), cvtpk(o2[6], o2[7])}; }
                } else {
                    const float* kg = args.in[22]; const int rs = lane >> 5, l32 = lane & 31, hd = l32 >> 3, i0 = (l32 & 7) * 8;
                    const f32x4 ga0 = *(const f32x4*)(kg + i0), ga1 = *(const f32x4*)(kg + i0 + 4), gb0 = *(const f32x4*)(kg + 64 + i0), gb1 = *(const f32x4*)(kg + 64 + i0 + 4);
#pragma nounroll
                    for (int m = gw * 2 + rs; m < MTOT; m += NGW * 2) { bf16* kp = QKV + (size_t)m * 2048 + 1024 + hd * 128 + i0;
                        const bf16x8 x1 = *(const bf16x8*)kp, x2 = *(const bf16x8*)(kp + 64);
                        float a[8], b[8]; float ss = 0.f;
#pragma unroll
                        for (int j = 0; j < 8; ++j) { a[j] = bf2f(x1[j]); b[j] = bf2f(x2[j]); ss += a[j] * a[j] + b[j] * b[j]; }
                        ss += __shfl_xor(ss, 1); ss += __shfl_xor(ss, 2); ss += __shfl_xor(ss, 4);
                        const float rstd = rsqrtf(ss * (1.0f / 128.0f) + 1e-6f);
#pragma unroll
                        for (int j = 0; j < 8; ++j) { a[j] *= rstd * (j < 4 ? ga0[j & 3] : ga1[j & 3]); b[j] *= rstd * (j < 4 ? gb0[j & 3] : gb1[j & 3]); }
                        if (m < MLAT) { const int t = m & 2047;
                            const f32x4 c0 = *(const f32x4*)(cosC + t * 64 + i0), c1 = *(const f32x4*)(cosC + t * 64 + i0 + 4), s0 = *(const f32x4*)(sinC + t * 64 + i0), s1 = *(const f32x4*)(sinC + t * 64 + i0 + 4);
#pragma unroll
                            for (int j = 0; j < 8; ++j) { const float c = j < 4 ? c0[j & 3] : c1[j & 3], sn = j < 4 ? s0[j & 3] : s1[j & 3]; const float x1v = a[j], x2v = b[j]; a[j] = x1v * c - x2v * sn; b[j] = x2v * c + x1v * sn; } }
                        *(u32x4*)kp = (u32x4){cvtpk(a[0], a[1]), cvtpk(a[2], a[3]), cvtpk(a[4], a[5]), cvtpk(a[6], a[7])};
                        *(u32x4*)(kp + 64) = (u32x4){cvtpk(b[0], b[1]), cvtpk(b[2], b[3]), cvtpk(b[4], b[5]), cvtpk(b[6], b[7])}; }
                }
            }
            else if (ON(7) && op == 2 && kind != 1) {
                if (kind == 0) {
                    const float* sink = args.in[11] + ja * 16;
                    const int nlat = 4096, ntot = nlat + (ctx_out ? 512 : 0);
                    for (int u = bx; u < ntot; u += G) {
                        att::UnitDesc d; d.nctx = 4; d.cosT = cosA; d.sinT = sinA; d.qg = nullptr;
                        int b, h;
                        if (u < nlat) { const int x = u & 7, j = (u >> 3) & 31, gi = (u >> 8) * 8 + x; b = gi >> 2; const int kvh = gi & 3; h = kvh * 4 + (j >> 3); const int q0 = (((j & 7) + (u >> 8)) & 7) * 256;
                            d.Q = QKV + ((size_t)b * SEQ + q0) * 1536 + h * 64; d.O = Ob + ((size_t)b * SEQ + q0) * DM + h * 64; d.qpos0 = q0;
                            const int klo = q0 - 128 < 0 ? 0 : q0 - 128, khi = q0 + 384 > SEQ ? SEQ : q0 + 384; d.band_kp0 = klo; d.NT = 4 + (khi - klo) / 64; }
                        else { const int cu = u - nlat; b = cu >> 4; h = cu & 15;
                            d.Q = QKV + ((size_t)MLAT + b * CTXL) * 1536 + h * 64; d.O = Ob + ((size_t)MLAT + b * CTXL) * DM + h * 64; d.qpos0 = -1; d.band_kp0 = 0; d.NT = 4; }
                        d.Kc = QKV + 1024 + (h >> 2) * 64; d.Vc = QKV + 1280 + (h >> 2) * 64; d.ctx_row0 = MLAT + b * CTXL; d.lat_row0 = (long)b * SEQ;
                        d.sink_l2 = sink[h] * 1.4426950408889634f;
                        att::attn_unit<64, 1536, false, true>(d, (char*)lds);
                    }
                } else {
                    const int nlat = 2048, ntot = nlat + (ctx_out ? 256 : 0);
                    for (int u = bx; u < ntot; u += G) {
                        att::UnitDesc d; d.nctx = 4; d.cosT = cosC; d.sinT = sinC; d.qg = args.in[21]; d.band_kp0 = 0;
                        int b, h;
                        if (u < nlat) { const int x = u & 7, j = (u >> 3) & 31, gi = ((u >> 8) * 8 + x) * 2 + (j >> 4); b = gi >> 2; const int kvh = gi & 3; h = kvh * 2 + ((j & 15) >> 3); const int q0 = (j & 7) * 256;
                            d.Q = QKV + ((size_t)b * SEQ + q0) * 2048 + h * 128; d.O = Ob + ((size_t)b * SEQ + q0) * DM + h * 128; d.qpos0 = q0; d.NT = 36; }
                        else { const int cu = u - nlat; b = cu >> 3; h = cu & 7;
                            d.Q = QKV + ((size_t)MLAT + b * CTXL) * 2048 + h * 128; d.O = Ob + ((size_t)MLAT + b * CTXL) * DM + h * 128; d.qpos0 = -1; d.NT = 4; }
                        d.Kc = QKV + 1024 + (h >> 1) * 128; d.Vc = QKV + 1536 + (h >> 1) * 128; d.ctx_row0 = MLAT + b * CTXL; d.lat_row0 = (long)b * SEQ;
                        d.sink_l2 = -INFINITY;
                        att::attn_unit<128, 2048, true, false>(d, (char*)lds);
                    }
                }

            }
            else if (ON(8) && op == 2) {
                constexpr int TB = 16384;
                char* V_lds = (char*)lds; f32x2* stat = (f32x2*)((char*)lds + 2 * TB);
                const float* lng = args.in[14]; const float* lnb = args.in[15]; const float* bsb = args.in[17];
                const int r32 = lane & 31, hh = lane >> 5, rb = wave & 3, chh = wave >> 2;
                const int sr = tid >> 4, sc = (tid & 15) * 8;
                const int vb0 = (int)(uintptr_t)V_lds + att::v_rd_base(lane);
                for (int u = bx; u < (MTOT / 128) * 2; u += G) {
                    const int chunk = u >> 1, gh = u & 1; const size_t row0 = (size_t)chunk * 128;
                    for (int rr = 0; rr < 16; ++rr) { const bf16* vp = QKV + (row0 + wave * 16 + rr) * 2048 + 1024 + lane * 16;
                        const bf16x8 v0 = *(const bf16x8*)vp, v1 = *(const bf16x8*)(vp + 8); float f[16];
#pragma unroll
                        for (int j = 0; j < 8; ++j) { f[j] = bf2f(v0[j]); f[8 + j] = bf2f(v1[j]); }
                        float s = 0.f;
#pragma unroll
                        for (int j = 0; j < 16; ++j) s += f[j];
                        const float mean = wave_sum(s) * (1.0f / 1024.0f); float q = 0.f;
#pragma unroll
                        for (int j = 0; j < 16; ++j) { const float dd = f[j] - mean; q += dd * dd; }
                        const float rstd = rsqrtf(wave_sum(q) * (1.0f / 1024.0f) + 1e-5f);
                        if (lane == 0) stat[wave * 16 + rr] = (f32x2){mean, rstd}; }
                    __syncthreads();
                    for (int gi = 0; gi < 4; ++gi) {
                        const int g = gh * 4 + gi;
                        const f32x4 lg0 = *(const f32x4*)(lng + g * 128 + sc), lg1 = *(const f32x4*)(lng + g * 128 + sc + 4), lb0 = *(const f32x4*)(lnb + g * 128 + sc), lb1 = *(const f32x4*)(lnb + g * 128 + sc + 4);
#pragma unroll
                        for (int l = 0; l < 4; ++l) { const int rl = sr + 32 * l; const bf16x8 raw = *(const bf16x8*)(QKV + (row0 + rl) * 2048 + 1024 + g * 128 + sc);
                            const f32x2 st = stat[rl]; float f[8];
#pragma unroll
                            for (int j = 0; j < 8; ++j) f[j] = (bf2f(raw[j]) - st.x) * st.y * (j < 4 ? lg0[j & 3] : lg1[j & 3]) + (j < 4 ? lb0[j & 3] : lb1[j & 3]);
                            u32x4 w = {cvtpk(f[0], f[1]), cvtpk(f[2], f[3]), cvtpk(f[4], f[5]), cvtpk(f[6], f[7])};
                            *(u32x4*)(V_lds + (l >> 1) * TB + att::v_st<128>(sr + 32 * (l & 1), sc)) = w; }
                        bf16x8 pa[2][4];
#pragma unroll
                        for (int T = 0; T < 2; ++T)
#pragma unroll
                            for (int ks = 0; ks < 4; ++ks) pa[T][ks] = *(const bf16x8*)(Wsb + (size_t)g * 16384 + (32 * rb + r32) * 128 + 64 * T + 16 * ks + 8 * hh);
                        __syncthreads();
                        f32x16 o[2]; o[0] = f32x16{}; o[1] = f32x16{};
                        if (chh == 0) {
                            att::pv_one<128, 0>(o[0], vb0, pa[0][0], pa[0][1], pa[0][2], pa[0][3]); att::pv_one<128, 1>(o[1], vb0, pa[0][0], pa[0][1], pa[0][2], pa[0][3]);
                            att::pv_one<128, 0>(o[0], vb0 + TB, pa[1][0], pa[1][1], pa[1][2], pa[1][3]); att::pv_one<128, 1>(o[1], vb0 + TB, pa[1][0], pa[1][1], pa[1][2], pa[1][3]);
                        } else {
                            att::pv_one<128, 2>(o[0], vb0, pa[0][0], pa[0][1], pa[0][2], pa[0][3]); att::pv_one<128, 3>(o[1], vb0, pa[0][0], pa[0][1], pa[0][2], pa[0][3]);
                            att::pv_one<128, 2>(o[0], vb0 + TB, pa[1][0], pa[1][1], pa[1][2], pa[1][3]); att::pv_one<128, 3>(o[1], vb0 + TB, pa[1][0], pa[1][1], pa[1][2], pa[1][3]);
                        }
                        { bf16* stg = (bf16*)((char*)lds + 2 * TB + 1024) + wave * 2048;
#pragma unroll
                          for (int r = 0; r < 16; ++r) { const int pr = att::crow(r, hh); const float bias = bsb[g * 128 + 32 * rb + pr];
#pragma unroll
                            for (int d = 0; d < 2; ++d) { const float v = o[d][r] + bias; stg[pr * 64 + d * 32 + r32] = (bf16)(cvtpk(v, v) & 0xffffu); } }
                          asm volatile("s_waitcnt lgkmcnt(0)" ::: "memory");
#pragma unroll
                          for (int i = 0; i < 4; ++i) { const int row = i * 8 + (lane >> 3), ch = lane & 7; const bf16x8 mv = *(const bf16x8*)(stg + row * 64 + ch * 8);
                            const size_t gr = row0 + 32 * rb + row; const int col = g * 128 + 64 * chh + ch * 8;
                            const bf16x8 uv = *(const bf16x8*)(QKV + gr * 2048 + col); float f[8];
#pragma unroll
                            for (int e = 0; e < 8; ++e) f[e] = bf2f(uv[e]) * bf2f(mv[e]);
                            u32x4 w = {cvtpk(f[0], f[1]), cvtpk(f[2], f[3]), cvtpk(f[4], f[5]), cvtpk(f[6], f[7])};
                            *(u32x4*)(Ob + gr * DM + col) = w; } }
                        __syncthreads();
                    }
                }

            }
            if (ON(9) && (op == 4 || op == 5 || op == 8 || op == 9)) {
                const bool c2 = op >= 8, last = li == DEPTH - 1, first = li == 0 && !c2 && !rep;
                const int rbase = (op == 5 || op == 9) ? MLAT : 0, nrows = rbase ? MCTX : MLAT;
                const float* ml = mods + (size_t)li * NMODROW * MODW; const float* mn = ml + (size_t)NMODROW * MODW;
                int mb, me;
                if (ctx_out && !rbase && G == 256) {
                    const int F = c2 ? CMB_F2 : CMB_F1; int r0, nr;
                    if (bx >= 128) { nr = F * 64; r0 = (bx - 128) * nr; } else { nr = (8 - F) * 64; r0 = 128 * F * 64 + bx * nr; }
                    mb = r0 + wave * (nr >> 3); me = mb + (nr >> 3);
                } else { const int rpw = (nrows + NGW - 1) / NGW; mb = gw * rpw; me = mb + rpw < nrows ? mb + rpw : nrows; mb += rbase; me += rbase; }
                {
                    if (!c2) {
                        if (first) combine_span<true, true, true, !XBF16>(mb, me, x_in, ctx_in, XL, XC, Yb, Hb, ml + 2 * DM, ng + DM, ml + 3 * DM, ml + 4 * DM, ng + 2 * DM, lane, 1.0f);
                        else combine_span<true, true, !XBF16, !XBF16>(mb, me, XL, XC, XL, XC, Yb, Hb, ml + 2 * DM, ng + DM, ml + 3 * DM, ml + 4 * DM, ng + 2 * DM, lane, rep ? 0.0f : 1.0f);
                    } else {
                        if (last) combine_span<true, false, !XBF16, true>(mb, me, XL, XC, args.out, XC, Yb, Hb, ml + 5 * DM, ng + 3 * DM, nullptr, nullptr, nullptr, lane, rep ? 0.0f : 1.0f);
                        else combine_span<true, true, !XBF16, !XBF16>(mb, me, XL, XC, XL, XC, Yb, Hb, ml + 5 * DM, ng + 3 * DM, mn, mn + DM, ng + 4 * DM, lane, rep ? 0.0f : 1.0f);
                    }
                }
            }
        }
        if (!noop && step + 1 < 3 + NOPS * DEPTH) { if (RUN(ph) && RUN(ph + 1)) GSYNC(); }
#ifdef REP_MASK
        if ((((unsigned long long)(REP_MASK) >> (step - 3)) & 1ull) && rep == 0) { rep = 1; continue; }
        rep = 0;
#endif
        ++step; ++ph;
    }
#undef RUN
#undef SEAM
}

#ifndef MK_MULTI
#define MK_MULTI 0
#endif
extern "C" void kernel_launch(void* const* d_in, const int* in_sizes, int n_in, void* d_out, int out_size, void* d_ws, size_t ws_size, hipStream_t stream) {
    static int grid = 0;
    if (grid == 0) {
        if (n_in != 23 || ws_size < WS_END) { fprintf(stderr, "kernel_launch: unexpected n_in %d / ws_size %zu (need %zu)\n", n_in, ws_size, (size_t)WS_END); grid = -1; return; }
        int dev = 0, cus = 0, per_cu = 0;
        hipGetDevice(&dev); hipDeviceGetAttribute(&cus, hipDeviceAttributeMultiprocessorCount, dev);
        if (hipFuncSetAttribute((const void*)mega, hipFuncAttributeMaxDynamicSharedMemorySize, LDS_BYTES) != hipSuccess) { fprintf(stderr, "kernel_launch: hipFuncSetAttribute failed\n"); grid = -1; return; }
        if (hipOccupancyMaxActiveBlocksPerMultiprocessor(&per_cu, (const void*)mega, 512, LDS_BYTES) != hipSuccess || per_cu < 1) { fprintf(stderr, "kernel_launch: occupancy query says %d\n", per_cu); per_cu = 1; }
        (void)hipGetLastError();
        grid = cus * per_cu;
        fprintf(stderr, "kernel_launch: grid %d (cus %d x %d)\n", grid, cus, per_cu);
    }
    if (grid < 0) return;
    if (hipMemsetAsync((char*)d_ws + OFF_CTL, 0, CTL_BYTES, stream) != hipSuccess) { fprintf(stderr, "kernel_launch: memset failed\n"); return; }
    Args a{};
    for (int i = 0; i < 23; ++i) a.in[i] = (const float*)d_in[i];
    a.out = (float*)d_out; a.ws = (unsigned char*)d_ws;
#if MK_MULTI
    const int nph = 3 + 10 * DEPTH;
    for (int p = 0; p < nph; ++p) { a.ph_lo = p; a.ph_hi = p + 1; hipLaunchKernelGGL(mega, dim3(grid), dim3(512), LDS_BYTES, stream, a); }
#else
    a.ph_lo = 0; a.ph_hi = 1000;
    void* params[] = {&a};
    hipError_t e = hipLaunchCooperativeKernel((const void*)mega, dim3(grid), dim3(512), params, LDS_BYTES, stream);
    if (e != hipSuccess) fprintf(stderr, "kernel_launch: cooperative launch failed: %s (grid %d)\n", hipGetErrorString(e), grid);
#endif
}
```

```cpp
#ifndef XBF16
#define XBF16 1
#endif
#include <hip/hip_runtime.h>
#include <hip/hip_cooperative_groups.h>
#include <cstdio>
#include <cstdint>
namespace cg = cooperative_groups;
namespace pg8 {
#define PG8_LAS __attribute__((address_space(3)))
typedef unsigned short bf16_t;
typedef short bf16x8 __attribute__((ext_vector_type(8)));
typedef float f32x4 __attribute__((ext_vector_type(4)));
typedef unsigned u32x4 __attribute__((ext_vector_type(4)));
constexpr int BM = 256, BK = 64, HALF = 128, HTB = HALF * BK * 2  , STAGE_BYTES = 8 * HTB, NXCD = 8, WGM = 8;

__host__ __device__ __forceinline__ int lds_byte(int r, int c) { const int st = (r >> 4) * 2 + (c >> 5), rr = r & 15, cc = c & 31, ob = rr * 64 + cc * 2; return st * 1024 + (ob ^ (((ob >> 9) & 1) << 5)); }
__host__ __device__ __forceinline__ void stage_rc(int b, int& R, int& C) { const int st = b / 1024, sb = b % 1024, swz = sb ^ (((sb >> 9) & 1) << 5); R = (st >> 1) * 16 + swz / 64; C = (st & 1) * 32 + (swz % 64) / 2; }
__host__ __device__ __forceinline__ int perm32(int rho) { const int n = rho >> 4, i = rho & 15; return 8 * (i >> 2) + 4 * n + (i & 3); }

struct Unit { int pm, pn; };
struct Gemm { const bf16_t* A; const bf16_t* Bt; int M, N, K; };

struct StaticOrder {
    int nM, nN, nwg, G, c;
    __host__ __device__ void init(int M, int N, int G_, int c_) { nM = M / BM; nN = N / BM; nwg = nM * nN; G = G_; c = c_; }
    __host__ __device__ bool next(int i, Unit& u) const {
        const long L = (long)i * G + c; if (L >= nwg) return false;
        int wgid = (int)L; { const int q = nwg / NXCD, r = nwg % NXCD, xcd = wgid % NXCD, off = wgid / NXCD; wgid = (xcd < r ? xcd * (q + 1) : r * (q + 1) + (xcd - r) * q) + off; }
        const int nig = WGM * nN, gid = wgid / nig, fm = gid * WGM, gsz = (nM - fm) < WGM ? (nM - fm) : WGM;
        u.pm = fm + ((wgid % nig) % gsz); u.pn = (wgid % nig) / gsz; return true;
    }
    __device__ __forceinline__ void a_ready(const Unit&) const {}
    __device__ __forceinline__ void done(const Unit&) const {}
};

__device__ __forceinline__ unsigned cvt_pk_bf16(float lo, float hi) { unsigned r; asm volatile("v_cvt_pk_bf16_f32 %0, %1, %2" : "=v"(r) : "v"(lo), "v"(hi)); return r; }
typedef float f32x2 __attribute__((ext_vector_type(2)));
__device__ __forceinline__ f32x2 gelu_pk(f32x2 v) {
    const f32x2 av = __builtin_elementwise_abs(v), d = av * 0.2316418882f + 1.0f;
    f32x2 t; t.x = __builtin_amdgcn_rcpf(d.x); t.y = __builtin_amdgcn_rcpf(d.y);
    f32x2 q = t * 0.5307027145f + (-0.7265760135f); q = q * t + 0.7107068705f; q = q * t + (-0.142248368f); q = q * t + 0.127414796f; q = q * t;
    const f32x2 s = (v * v) * (-0.72134752044f);
    f32x2 e; e.x = __builtin_amdgcn_exp2f(s.x); e.y = __builtin_amdgcn_exp2f(s.y);
    const f32x2 m = v * (q * e), r = v - m;
    f32x2 o; o.x = v.x < 0.f ? m.x : r.x; o.y = v.y < 0.f ? m.y : r.y; return o;
}

#ifndef PG8_STMODE
#define PG8_STMODE 0
#endif
#if PG8_STMODE == 1
#define PG8_ST16(p, v) asm volatile("global_store_dwordx4 %0, %1, off sc1\n\ts_nop 1" :: "v"(p), "v"(v) : "memory")
#elif PG8_STMODE == 2
#define PG8_ST16(p, v) asm volatile("global_store_dwordx4 %0, %1, off nt\n\ts_nop 1" :: "v"(p), "v"(v) : "memory")
#elif PG8_STMODE == 4
#define PG8_ST16(p, v) asm volatile("global_store_dwordx4 %0, %1, off\n\ts_nop 1" :: "v"(p), "v"(v) : "memory")
#elif PG8_STMODE == 3
#define PG8_ST16(p, v) asm volatile("global_store_dwordx4 %0, %1, off sc0 sc1\n\ts_nop 1" :: "v"(p), "v"(v) : "memory")
#else
#define PG8_ST16(p, v) (*(u32x4*)(p) = (v))
#endif
template <int ACT  > struct EpiBf16 {
    static constexpr bool PERM = true, AFTER_DRAIN = false; static_assert(ACT == 0 || ACT == 1, "EpiBf16: ACT is 0 (none) or 1 (gelu_pk)");
    bf16_t* O; int ldc; const float* bias; int split_cols; size_t split_stride; float scale0; int skip; bf16_t* scratch;
    __device__ __forceinline__ void operator()(const f32x4 (&acc)[2][2][4][2], const Unit& u, int wr, int wc, int fr, int fq) const {
        if (skip == 1) return;
        const int row0 = u.pm * BM + wr * 64 + fr; int colt = u.pn * BM; bf16_t* base = O;
        float sc = 1.f; if (split_cols) { const int t = colt / split_cols; base += (size_t)t * split_stride; colt -= t * split_cols; if (t == 0) sc = scale0; }
        const int col0 = colt + wc * 32 + 8 * fq, bcol0 = u.pn * BM + wc * 32 + 8 * fq;
        f32x4 bv[2][2];
#pragma unroll
        for (int bj = 0; bj < 2; ++bj)
#pragma unroll
            for (int n = 0; n < 2; ++n) bv[bj][n] = bias ? *(const f32x4*)(bias + bcol0 + bj * HALF + 4 * n) : (f32x4){0.f, 0.f, 0.f, 0.f};
#pragma unroll
        for (int ai = 0; ai < 2; ++ai)
#pragma unroll
            for (int m = 0; m < 4; ++m) { bf16_t* rowp = base + (size_t)(row0 + ai * HALF + m * 16) * ldc + col0; int bjs = HALF;
                if (skip == 2) { rowp = scratch + ((size_t)((((u.pm * 8 + u.pn) & 1023) * 8 + wr * 4 + wc) * 16 + (ai * 4 + m) * 2)) * 512 + (fq * 16 + fr) * 8; bjs = 512; }
#pragma unroll
                for (int bj = 0; bj < 2; ++bj) { f32x4 v0 = acc[ai][bj][m][0] + bv[bj][0], v1 = acc[ai][bj][m][1] + bv[bj][1];
                    if (ACT == 1) { f32x2 a = gelu_pk((f32x2){v0[0], v0[1]}), b = gelu_pk((f32x2){v0[2], v0[3]}), c = gelu_pk((f32x2){v1[0], v1[1]}), d = gelu_pk((f32x2){v1[2], v1[3]});
                        v0 = (f32x4){a.x, a.y, b.x, b.y}; v1 = (f32x4){c.x, c.y, d.x, d.y}; }
                    v0 = v0 * sc; v1 = v1 * sc; u32x4 w; w.x = cvt_pk_bf16(v0[0], v0[1]); w.y = cvt_pk_bf16(v0[2], v0[3]); w.z = cvt_pk_bf16(v1[0], v1[1]); w.w = cvt_pk_bf16(v1[2], v1[3]);
                    PG8_ST16(rowp + bj * bjs, w); } }
    }
};
template <class Epi, class Sched, bool ALIGN_EPI = false, bool SP2 = false>
__device__ __forceinline__ void gemm_phase(PG8_LAS unsigned char* lds, const Gemm g, const Sched& S, const Epi& E) {
    int tid = threadIdx.x; asm volatile("" : "+v"(tid));
    const int wid = __builtin_amdgcn_readfirstlane(tid >> 6), lane = tid & 63, wr = wid >> 2, wc = wid & 3, fr = lane & 15, fq = lane >> 4;
    const int K = g.K, nt = K / BK;
    unsigned voffA[2], voffB[2];
#pragma unroll
    for (int i = 0; i < 2; ++i) { int R, C; stage_rc(tid * 16 + i * 8192, R, C); const int Rb = Epi::PERM ? ((R & ~31) + perm32(R & 31)) : R;
        voffA[i] = (unsigned)(R * K + C) * 2u; voffB[i] = (unsigned)(Rb * K + C) * 2u; }
    const size_t kstep = (size_t)(BK * 2);
    const size_t hstep = (size_t)HALF * K * 2;
    const size_t tstep = 2 * hstep;
    const unsigned ldsw = (unsigned)wid * 1024u;
    const int aoff = lds_byte(wr * 64 + fr, fq * 8), boff = lds_byte(wc * 32 + fr, fq * 8);
#define PG8_SA(b, h) (((b) * 2 + (h)) * HTB)
#define PG8_SB(b, h) ((4 + (b) * 2 + (h)) * HTB)
#define PG8_STAGE(bufoff, gbase, voff) do { _Pragma("unroll") for (int _i = 0; _i < 2; ++_i) \
        __builtin_amdgcn_global_load_lds((const unsigned*)((const char*)(gbase) + (voff)[_i]), (PG8_LAS unsigned*)(lds + (bufoff) + ldsw + _i * 8192), 16, 0, 0); } while (0)
#define PG8_LDA(dst, b, h) do { _Pragma("unroll") for (int m = 0; m < 4; ++m) _Pragma("unroll") for (int k = 0; k < 2; ++k) dst[m][k] = *(const PG8_LAS bf16x8*)(lds + PG8_SA(b, h) + aoff + m * 2048 + k * 1024); } while (0)
#define PG8_LDB(dst, b, h) do { _Pragma("unroll") for (int n = 0; n < 2; ++n) _Pragma("unroll") for (int k = 0; k < 2; ++k) dst[n][k] = *(const PG8_LAS bf16x8*)(lds + PG8_SB(b, h) + boff + n * 2048 + k * 1024); } while (0)
#define PG8_MMA(ai, bj, At, Bt) do { __builtin_amdgcn_s_setprio(1); _Pragma("unroll") for (int m = 0; m < 4; ++m) _Pragma("unroll") for (int n = 0; n < 2; ++n) _Pragma("unroll") for (int k = 0; k < 2; ++k) \
        acc[ai][bj][m][n] = __builtin_amdgcn_mfma_f32_16x16x32_bf16(Bt[n][k], At[m][k], acc[ai][bj][m][n], 0, 0, 0); __builtin_amdgcn_s_setprio(0); } while (0)
#define PG8_WAIT_V(n) asm volatile("s_waitcnt vmcnt(" #n ")" ::: "memory")
#define PG8_WAIT_L(n) asm volatile("s_waitcnt lgkmcnt(" #n ")" ::: "memory")
#define PG8_BAR __builtin_amdgcn_s_barrier()
#define PG8_SCHED __builtin_amdgcn_sched_barrier(0)
    Unit cur, nxt; int ui = 0;
    if (!S.next(0, cur)) return;
    f32x4 acc[2][2][4][2];
#pragma unroll
    for (int a = 0; a < 2; ++a)
#pragma unroll
        for (int b = 0; b < 2; ++b)
#pragma unroll
            for (int m = 0; m < 4; ++m)
#pragma unroll
                for (int n = 0; n < 2; ++n) acc[a][b][m][n] = (f32x4){0.f, 0.f, 0.f, 0.f};
    bf16x8 At[4][2], B0[2][2], B1[2][2];
    const char* cA = (const char*)g.A + (size_t)cur.pm * tstep; const char* cB = (const char*)g.Bt + (size_t)cur.pn * tstep;
    S.a_ready(cur);
    if constexpr (SP2) {
        PG8_STAGE(PG8_SB(0, 0), cB, voffB); PG8_STAGE(PG8_SB(0, 1), cB + hstep, voffB); PG8_STAGE(PG8_SA(0, 0), cA, voffA); PG8_STAGE(PG8_SA(0, 1), cA + hstep, voffA);
        if (wr == 1) PG8_BAR;
        PG8_WAIT_V(2); PG8_BAR;
        PG8_STAGE(PG8_SB(1, 0), cB + kstep, voffB); PG8_STAGE(PG8_SA(1, 0), cA + kstep, voffA); PG8_STAGE(PG8_SB(1, 1), cB + hstep + kstep, voffB);
        PG8_WAIT_V(6); PG8_BAR;
    } else {
        PG8_STAGE(PG8_SB(0, 0), cB, voffB); PG8_STAGE(PG8_SA(0, 0), cA, voffA); PG8_STAGE(PG8_SB(0, 1), cB + hstep, voffB); PG8_STAGE(PG8_SA(0, 1), cA + hstep, voffA);
        if (wr == 1) PG8_BAR;
        PG8_WAIT_V(4); PG8_BAR;
        PG8_STAGE(PG8_SB(1, 0), cB + kstep, voffB); PG8_STAGE(PG8_SA(1, 0), cA + kstep, voffA); PG8_STAGE(PG8_SB(1, 1), cB + hstep + kstep, voffB);
        PG8_WAIT_V(6); PG8_BAR;
    }
    for (;;) {
        const bool has_next = S.next(ui + 1, nxt);
        const char* nA = has_next ? (const char*)g.A + (size_t)nxt.pm * tstep : cA; const char* nB = has_next ? (const char*)g.Bt + (size_t)nxt.pn * tstep : cB;
        for (int t = 0; t < nt; t += 2) {
            const bool last = (t == nt - 2);
            const char* a1 = cA + (size_t)(t + 1) * kstep;
            const char* a2 = last ? nA : cA + (size_t)(t + 2) * kstep; const char* b2 = last ? nB : cB + (size_t)(t + 2) * kstep;
            const char* a3 = a2 + kstep; const char* b3 = b2 + kstep;
            if (last && has_next) S.a_ready(nxt);
            if constexpr (SP2) {
            PG8_LDB(B0, 0, 0); PG8_LDB(B1, 0, 1); PG8_SCHED; PG8_LDA(At, 0, 0); PG8_STAGE(PG8_SA(1, 1), a1 + hstep, voffA);
            PG8_WAIT_V(8); PG8_WAIT_L(0); PG8_BAR; PG8_MMA(0, 0, At, B0); PG8_MMA(0, 1, At, B1); PG8_BAR; PG8_SCHED;
            PG8_LDA(At, 0, 1); PG8_STAGE(PG8_SB(0, 0), b2, voffB); PG8_STAGE(PG8_SB(0, 1), b2 + hstep, voffB); PG8_STAGE(PG8_SA(0, 0), a2, voffA);
            PG8_WAIT_V(8); PG8_WAIT_L(0); PG8_BAR; PG8_MMA(1, 0, At, B0); PG8_MMA(1, 1, At, B1); PG8_BAR; PG8_SCHED;
            PG8_LDB(B0, 1, 0); PG8_LDB(B1, 1, 1); PG8_SCHED; PG8_LDA(At, 1, 0); PG8_STAGE(PG8_SA(0, 1), a2 + hstep, voffA);
            PG8_WAIT_V(8); PG8_WAIT_L(0); PG8_BAR; PG8_MMA(0, 0, At, B0); PG8_MMA(0, 1, At, B1); PG8_BAR; PG8_SCHED;
            PG8_LDA(At, 1, 1); PG8_STAGE(PG8_SB(1, 0), b3, voffB); PG8_STAGE(PG8_SB(1, 1), b3 + hstep, voffB); PG8_STAGE(PG8_SA(1, 0), a3, voffA);
            PG8_WAIT_V(8); PG8_WAIT_L(0); PG8_BAR; PG8_MMA(1, 0, At, B0); PG8_MMA(1, 1, At, B1); PG8_BAR; PG8_SCHED;
            } else {
            PG8_LDB(B0, 0, 0); PG8_SCHED; PG8_LDA(At, 0, 0); PG8_STAGE(PG8_SA(1, 1), a1 + hstep, voffA);
            PG8_WAIT_L(8); PG8_BAR; PG8_WAIT_L(0); PG8_MMA(0, 0, At, B0); PG8_BAR; PG8_SCHED;
            PG8_LDB(B1, 0, 1); PG8_STAGE(PG8_SB(0, 0), b2, voffB);
            PG8_BAR; PG8_WAIT_L(0); PG8_MMA(0, 1, At, B1); PG8_BAR;
            PG8_LDA(At, 0, 1); PG8_STAGE(PG8_SA(0, 0), a2, voffA);
            PG8_BAR; PG8_WAIT_L(0); PG8_MMA(1, 0, At, B0); PG8_BAR; PG8_SCHED;
            PG8_STAGE(PG8_SB(0, 1), b2 + hstep, voffB);
            PG8_WAIT_V(6); PG8_BAR; PG8_MMA(1, 1, At, B1); PG8_BAR;
            PG8_LDB(B0, 1, 0); PG8_SCHED; PG8_LDA(At, 1, 0); PG8_STAGE(PG8_SA(0, 1), a2 + hstep, voffA);
            PG8_WAIT_L(8); PG8_BAR; PG8_WAIT_L(0); PG8_MMA(0, 0, At, B0); PG8_BAR; PG8_SCHED;
            PG8_LDB(B1, 1, 1); PG8_STAGE(PG8_SB(1, 0), b3, voffB);
            PG8_BAR; PG8_WAIT_L(0); PG8_MMA(0, 1, At, B1); PG8_BAR;
            PG8_LDA(At, 1, 1); PG8_STAGE(PG8_SA(1, 0), a3, voffA);
            PG8_BAR; PG8_WAIT_L(0); PG8_MMA(1, 0, At, B0); PG8_BAR; PG8_SCHED;
            PG8_STAGE(PG8_SB(1, 1), b3 + hstep, voffB);
            PG8_WAIT_V(6); PG8_BAR; PG8_MMA(1, 1, At, B1); PG8_BAR;
            }
        }
        if constexpr (ALIGN_EPI) { if (wr == 0) PG8_BAR; }
        if constexpr (!Epi::AFTER_DRAIN) { E(acc, cur, wr, wc, fr, fq); S.done(cur); }
        if (!has_next) break;
#pragma unroll
        for (int a = 0; a < 2; ++a)
#pragma unroll
            for (int b = 0; b < 2; ++b)
#pragma unroll
                for (int m = 0; m < 4; ++m)
#pragma unroll
                    for (int n = 0; n < 2; ++n) acc[a][b][m][n] = (f32x4){0.f, 0.f, 0.f, 0.f};
        cur = nxt; cA = nA; cB = nB; ++ui;
        if constexpr (ALIGN_EPI) { if (wr == 1) PG8_BAR; }
    }
    PG8_WAIT_V(0);
    if constexpr (!ALIGN_EPI) { if (wr == 0) PG8_BAR; }
    PG8_BAR;
    if constexpr (Epi::AFTER_DRAIN) { E.fused(acc, cur, wr, wc, fr, fq, lds, wid, lane); S.done(cur); }
#undef PG8_SA
#undef PG8_SB
#undef PG8_STAGE
#undef PG8_LDA
#undef PG8_LDB
#undef PG8_MMA
#undef PG8_WAIT_V
#undef PG8_WAIT_L
#undef PG8_BAR
#undef PG8_SCHED
}
}
namespace pg8 {
struct EpiSwiglu {
    static constexpr bool PERM = true, AFTER_DRAIN = false;
    bf16_t* O; int ldc;
    __device__ __forceinline__ void operator()(const f32x4 (&acc)[2][2][4][2], const Unit& u, int wr, int wc, int fr, int fq) const {
        const int row0 = u.pm * BM + wr * 64 + fr; const int col0 = u.pn * HALF + wc * 32 + 8 * fq;
#pragma unroll
        for (int ai = 0; ai < 2; ++ai)
#pragma unroll
            for (int m = 0; m < 4; ++m) { bf16_t* rowp = O + (size_t)(row0 + ai * HALF + m * 16) * ldc + col0;
                float o[8];
#pragma unroll
                for (int n = 0; n < 2; ++n)
#pragma unroll
                    for (int e = 0; e < 4; ++e) { const float g = acc[ai][0][m][n][e], up = acc[ai][1][m][n][e];
                        o[n * 4 + e] = g * __builtin_amdgcn_rcpf(1.0f + __expf(-g)) * up; }
                u32x4 w; w.x = cvt_pk_bf16(o[0], o[1]); w.y = cvt_pk_bf16(o[2], o[3]); w.z = cvt_pk_bf16(o[4], o[5]); w.w = cvt_pk_bf16(o[6], o[7]);
                PG8_ST16(rowp, w); }
    }
};
}

constexpr int DM = 1024, NBATCH = 32, SEQ = 2048, CTXL = 256, MLAT = NBATCH * SEQ, MCTX = NBATCH * CTXL, MTOT = MLAT + MCTX, FFH = 2816, DEPTH = 4;
constexpr int NMODROW = 33, MODW = 6 * DM;
constexpr int LDS_BYTES = 147456;
constexpr size_t MiB = 1u << 20;
constexpr size_t OFF_MODP = 0;
constexpr size_t OFF_MODS = 26 * MiB;
constexpr size_t OFF_ROPE = 30 * MiB;
constexpr size_t OFF_WS = 32 * MiB;
constexpr size_t OFF_W = 33 * MiB;
constexpr size_t W_FI = 0, W_FO = 44 * MiB, W_AQ = 66 * MiB, W_AO = 72 * MiB, W_BI = 76 * MiB, W_BO = 80 * MiB, W_CQ = 82 * MiB, W_CO = 86 * MiB;
constexpr size_t OFF_XC = 121 * MiB;
constexpr size_t OFF_H = 153 * MiB;
constexpr size_t OFF_Y = 297 * MiB;
constexpr size_t OFF_BIG = 441 * MiB;
constexpr size_t OFF_O = OFF_BIG + 288 * MiB;
constexpr size_t OFF_CTL = OFF_BIG + 432 * MiB;
constexpr size_t CTL_BYTES = 65536;
constexpr size_t OFF_XLB = OFF_CTL + 1 * MiB;
constexpr size_t WS_END = OFF_XLB + 128 * MiB;
constexpr int LDS_XB = LDS_BYTES - 64;

typedef unsigned short bf16;
typedef short bf16x8 __attribute__((ext_vector_type(8)));
typedef short s16x4 __attribute__((ext_vector_type(4)));
typedef float f32x16 __attribute__((ext_vector_type(16)));
typedef float f32x4 __attribute__((ext_vector_type(4)));
typedef float f32x2 __attribute__((ext_vector_type(2)));
typedef unsigned u32x4 __attribute__((ext_vector_type(4)));
typedef unsigned u32x2 __attribute__((ext_vector_type(2)));
#define LAS __attribute__((address_space(3)))

__device__ __forceinline__ unsigned cvtpk(float lo, float hi) { unsigned r; asm volatile("v_cvt_pk_bf16_f32 %0, %1, %2" : "=v"(r) : "v"(lo), "v"(hi)); return r; }
__device__ __forceinline__ float bf2f(short s) { return __uint_as_float(((unsigned)(unsigned short)s) << 16); }
__device__ __forceinline__ float bflo(unsigned w) { return __uint_as_float(w << 16); }
__device__ __forceinline__ float bfhi(unsigned w) { return __uint_as_float(w & 0xffff0000u); }
__device__ __forceinline__ float wave_sum(float v) {
#pragma unroll
    for (int o = 1; o < 64; o <<= 1) v += __shfl_xor(v, o);
    return v;
}

namespace att {
#define SBAR() __builtin_amdgcn_sched_barrier(0)
__device__ __forceinline__ int crow(int r, int hi) { return (r & 3) + 8 * (r >> 2) + 4 * hi; }
template <int DH> __device__ __forceinline__ int kswz(int row, int colB) { return row * (DH * 2) + (colB ^ ((row & 7) << 4)); }
template <int DH> __device__ __forceinline__ int v_st(int k, int c) { const int kk = (k & ~0xC) | ((k & 4) << 1) | ((k & 8) >> 1); return ((kk >> 3) * (DH / 32) + (c >> 5)) * 512 + ((kk & 7) * 32 + (c & 31)) * 2; }
__device__ __forceinline__ int v_rd_base(int lane) { return ((lane & 3) << 3) | (((lane >> 2) & 3) << 6) | (((lane >> 4) & 1) << 5) | (((lane >> 5) & 1) << 8); }
template <int DH> constexpr int v_rd_off(int d0, int ks, int half) { return d0 * 512 + ks * (DH / 32) * 1024 + half * (DH / 32) * 512; }
template <int OFF> __device__ __forceinline__ s16x4 tr_read(int vb) { s16x4 r; asm volatile("ds_read_b64_tr_b16 %0, %1 offset:%2" : "=&v"(r) : "v"(vb), "i"(OFF) : "memory"); return r; }
template <int DH, int D0> __device__ __forceinline__ void pv_one(f32x16& od, int vb, bf16x8 pa0, bf16x8 pa1, bf16x8 pa2, bf16x8 pa3) {
  const s16x4 l0 = tr_read<v_rd_off<DH>(D0, 0, 0)>(vb), h0 = tr_read<v_rd_off<DH>(D0, 0, 1)>(vb), l1 = tr_read<v_rd_off<DH>(D0, 1, 0)>(vb), h1 = tr_read<v_rd_off<DH>(D0, 1, 1)>(vb);
  const s16x4 l2 = tr_read<v_rd_off<DH>(D0, 2, 0)>(vb), h2 = tr_read<v_rd_off<DH>(D0, 2, 1)>(vb), l3 = tr_read<v_rd_off<DH>(D0, 3, 0)>(vb), h3 = tr_read<v_rd_off<DH>(D0, 3, 1)>(vb);
  asm volatile("s_waitcnt lgkmcnt(0)" ::: "memory"); SBAR();
#define PK(L, H) (bf16x8){L[0], L[1], L[2], L[3], H[0], H[1], H[2], H[3]}
  od = __builtin_amdgcn_mfma_f32_32x32x16_bf16(pa0, PK(l0, h0), od, 0, 0, 0);
  od = __builtin_amdgcn_mfma_f32_32x32x16_bf16(pa1, PK(l1, h1), od, 0, 0, 0);
  od = __builtin_amdgcn_mfma_f32_32x32x16_bf16(pa2, PK(l2, h2), od, 0, 0, 0);
  od = __builtin_amdgcn_mfma_f32_32x32x16_bf16(pa3, PK(l3, h3), od, 0, 0, 0);
#undef PK
}
template <int DH> __device__ __forceinline__ void pv_all(f32x16* o, int vb, bf16x8 pa0, bf16x8 pa1, bf16x8 pa2, bf16x8 pa3) {
  pv_one<DH, 0>(o[0], vb, pa0, pa1, pa2, pa3); pv_one<DH, 1>(o[1], vb, pa0, pa1, pa2, pa3);
  if constexpr (DH == 128) { pv_one<DH, 2>(o[2], vb, pa0, pa1, pa2, pa3); pv_one<DH, 3>(o[3], vb, pa0, pa1, pa2, pa3); }
}
template <int DH> struct SC { static constexpr float SCALE = DH == 128 ? 0.088388347648318440f : 0.125f; static constexpr float C = SCALE * 1.4426950408889634f; static constexpr float THRS = 8.f / SCALE; };
template <int DH> __device__ __forceinline__ void partialSM(f32x16& p0, f32x16& p1, float& m_reg, float& mn, float& alpha) {
  constexpr float C = SC<DH>::C;
  float pmax = p0[0];
#pragma unroll
  for (int r = 1; r < 16; ++r) pmax = fmaxf(pmax, p0[r]);
#pragma unroll
  for (int r = 0; r < 16; ++r) pmax = fmaxf(pmax, p1[r]);
  { auto rr = __builtin_amdgcn_permlane32_swap(__float_as_uint(pmax), __float_as_uint(pmax), false, false);
    pmax = fmaxf(__uint_as_float(rr[0]), __uint_as_float(rr[1])); }
  if (__builtin_expect(__all(pmax - m_reg <= SC<DH>::THRS), 1)) { mn = m_reg; alpha = 1.f; }
  else { mn = fmaxf(m_reg, pmax); alpha = __builtin_amdgcn_exp2f((m_reg - mn) * C); m_reg = mn; }
  const float mnC = -mn * C;
#pragma unroll
  for (int r = 0; r < 16; ++r) p0[r] = fmaf(p0[r], C, mnC);
#pragma unroll
  for (int r = 0; r < 16; ++r) p1[r] = fmaf(p1[r], C, mnC);
#pragma unroll
  for (int r = 0; r < 16; ++r) p0[r] = __builtin_amdgcn_exp2f(p0[r]);
}
__device__ __forceinline__ void finishSM(f32x16& p0, f32x16& p1, float alpha, float& l_reg, bf16x8& pa0, bf16x8& pa1, bf16x8& pa2, bf16x8& pa3) {
#pragma unroll
  for (int r = 0; r < 16; ++r) p1[r] = __builtin_amdgcn_exp2f(p1[r]);
  float ps = 0;
#pragma unroll
  for (int r = 0; r < 16; ++r) ps += p0[r];
#pragma unroll
  for (int r = 0; r < 16; ++r) ps += p1[r];
  { auto rr = __builtin_amdgcn_permlane32_swap(__float_as_uint(ps), __float_as_uint(ps), false, false);
    ps = __uint_as_float(rr[0]) + __uint_as_float(rr[1]); }
  l_reg = l_reg * alpha + ps;
#define PK4(P, BASE, OUT) do { unsigned a0 = cvtpk(P[BASE + 0], P[BASE + 1]), a1 = cvtpk(P[BASE + 2], P[BASE + 3]);   \
    unsigned b0 = cvtpk(P[BASE + 4], P[BASE + 5]), b1 = cvtpk(P[BASE + 6], P[BASE + 7]);                              \
    auto r0 = __builtin_amdgcn_permlane32_swap(a0, b0, false, false); auto r1 = __builtin_amdgcn_permlane32_swap(a1, b1, false, false); \
    u32x4 w = {r0[0], r1[0], r0[1], r1[1]}; OUT = *reinterpret_cast<bf16x8*>(&w); } while (0)
  PK4(p0, 0, pa0); PK4(p0, 8, pa1); PK4(p1, 0, pa2); PK4(p1, 8, pa3);
#undef PK4
}
template <int DH> __device__ __forceinline__ void qkt(f32x16& p0, f32x16& p1, const char* Ks, const bf16x8* qr, int r32, int hi) {
  p0 = f32x16{}; p1 = f32x16{};
#pragma unroll
  for (int d0 = 0; d0 < DH / 16; ++d0) { const int cb = (d0 * 16 + hi * 8) * 2;
    const bf16x8 b0 = *reinterpret_cast<const bf16x8*>(Ks + kswz<DH>(r32, cb));
    const bf16x8 b1 = *reinterpret_cast<const bf16x8*>(Ks + kswz<DH>(32 + r32, cb));
    p0 = __builtin_amdgcn_mfma_f32_32x32x16_bf16(b0, qr[d0], p0, 0, 0, 0);
    p1 = __builtin_amdgcn_mfma_f32_32x32x16_bf16(b1, qr[d0], p1, 0, 0, 0); }
}
__device__ __forceinline__ void wmask(f32x16& p0, f32x16& p1, int kp0, int qp, int hi) {
  const int d0 = kp0 + 4 * hi - qp;
#pragma unroll
  for (int r = 0; r < 16; ++r) { const int d = d0 + (r & 3) + 8 * (r >> 2); if (d > 128 || d < -128) p0[r] = -1e30f; if (d + 32 > 128 || d + 32 < -128) p1[r] = -1e30f; }
}
struct UnitDesc {
  const bf16* Q; const bf16* Kc; const bf16* Vc; bf16* O;
  long ctx_row0, lat_row0; int nctx, band_kp0, NT, qpos0;
  const float* cosT; const float* sinT; const float* qg; float sink_l2;
};
template <int DH, int PITCH, bool QKNORM, bool MASK>
__device__ __forceinline__ void attn_unit(const UnitDesc& u, char* lds) {
  constexpr int NB = DH / 16, NO = DH / 32, TB = 64 * DH * 2, NLD = DH / 64, SDEPTH = DH == 128 ? 1 : 2;
  int tid = threadIdx.x; asm volatile("" : "+v"(tid));
  const int wid = tid >> 6, lane = tid & 63, r32 = lane & 31, hi = lane >> 5;
  char* V_lds = lds; char* K_lds = lds + 2 * TB;
  float* ws = (float*)(lds + 4 * TB) + wid * 64; float* li_l = ws; float* al_l = ws + 32;
  float m_reg = -1e30f, l_reg = 0; f32x16 o[NO];
#pragma unroll
  for (int d = 0; d < NO; ++d) o[d] = f32x16{};
  bf16x8 qr[NB];
  {
    const bf16* Qw = u.Q + (long)(wid * 32 + r32) * PITCH + hi * 8;
    float qf[NB][8];
#pragma unroll
    for (int d0 = 0; d0 < NB; ++d0) { const bf16x8 raw = *reinterpret_cast<const bf16x8*>(Qw + d0 * 16);
#pragma unroll
      for (int j = 0; j < 8; ++j) qf[d0][j] = bf2f(raw[j]); }
    if constexpr (QKNORM) {
      float ss = 0.f;
#pragma unroll
      for (int d0 = 0; d0 < NB; ++d0)
#pragma unroll
        for (int j = 0; j < 8; ++j) ss += qf[d0][j] * qf[d0][j];
      ss += __shfl_xor(ss, 32);
      const float rstd = rsqrtf(ss * (1.0f / DH) + 1e-6f);
#pragma unroll
      for (int d0 = 0; d0 < NB; ++d0) { const f32x4 g0 = *(const f32x4*)(u.qg + d0 * 16 + hi * 8), g1 = *(const f32x4*)(u.qg + d0 * 16 + hi * 8 + 4);
#pragma unroll
        for (int j = 0; j < 4; ++j) { qf[d0][j] *= rstd * g0[j]; qf[d0][4 + j] *= rstd * g1[j]; } }
    }
    if (u.qpos0 >= 0) {
      const int pos = u.qpos0 + wid * 32 + r32;
      const float* cp = u.cosT + (long)pos * (DH / 2) + hi * 8; const float* sp = u.sinT + (long)pos * (DH / 2) + hi * 8;
#pragma unroll
      for (int d0 = 0; d0 < NB / 2; ++d0) {
        const f32x4 c0 = *(const f32x4*)(cp + d0 * 16), c1 = *(const f32x4*)(cp + d0 * 16 + 4), s0 = *(const f32x4*)(sp + d0 * 16), s1 = *(const f32x4*)(sp + d0 * 16 + 4);
#pragma unroll
        for (int j = 0; j < 8; ++j) { const float c = j < 4 ? c0[j & 3] : c1[j & 3], s = j < 4 ? s0[j & 3] : s1[j & 3];
          const float x1 = qf[d0][j], x2 = qf[d0 + NB / 2][j]; qf[d0][j] = x1 * c - x2 * s; qf[d0 + NB / 2][j] = x2 * c + x1 * s; }
      }
    }
#pragma unroll
    for (int d0 = 0; d0 < NB; ++d0) { u32x4 w = {cvtpk(qf[d0][0], qf[d0][1]), cvtpk(qf[d0][2], qf[d0][3]), cvtpk(qf[d0][4], qf[d0][5]), cvtpk(qf[d0][6], qf[d0][7])}; qr[d0] = *reinterpret_cast<bf16x8*>(&w); }
  }
  const int sr = DH == 128 ? (tid >> 4) : (tid >> 3), sc = DH == 128 ? (tid & 15) * 8 : (tid & 7) * 8;
  const int vb0 = (int)(uintptr_t)V_lds + v_rd_base(lane);
  struct { bf16x8 v[NLD], k[NLD]; } st_[SDEPTH];
  const int qp = u.qpos0 + wid * 32 + r32;
#define TROW(t) ((t) < u.nctx ? u.ctx_row0 + 64 * (t) : u.lat_row0 + u.band_kp0 + 64 * ((t) - u.nctx))
#define TKP(t) (u.band_kp0 + 64 * ((t) - u.nctx))
#define SLOAD(i, t) do { const long row_ = TROW(t); _Pragma("unroll") for (int l_ = 0; l_ < NLD; ++l_) { \
    st_[i].v[l_] = *reinterpret_cast<const bf16x8*>(u.Vc + (row_ + sr + 32 * l_) * PITCH + sc); st_[i].k[l_] = *reinterpret_cast<const bf16x8*>(u.Kc + (row_ + sr + 32 * l_) * PITCH + sc); } } while (0)
#define SWRITE(b, i) do { _Pragma("unroll") for (int l_ = 0; l_ < NLD; ++l_) { *(bf16x8*)(V_lds + (b) * TB + v_st<DH>(sr + 32 * l_, sc)) = st_[i].v[l_]; \
    *(bf16x8*)(K_lds + (b) * TB + kswz<DH>(sr + 32 * l_, sc * 2)) = st_[i].k[l_]; } } while (0)
#define SWAIT() do { if constexpr (SDEPTH == 1) asm volatile("s_waitcnt vmcnt(0)" ::: "memory"); else if constexpr (NLD == 2) asm volatile("s_waitcnt vmcnt(4)" ::: "memory"); else asm volatile("s_waitcnt vmcnt(2)" ::: "memory"); } while (0)
#define RESC(a) do { if (__any((a) < 1.f)) { if (hi == 0) al_l[r32] = (a); asm volatile("s_waitcnt lgkmcnt(0)" ::: "memory"); \
    _Pragma("unroll") for (int d = 0; d < NO; ++d) _Pragma("unroll") for (int r = 0; r < 16; ++r) o[d][r] *= al_l[crow(r, hi)]; } } while (0)
#define AMASK(P0, P1, t) do { if constexpr (MASK) { if ((t) >= u.nctx && (TKP(t) < qw - 97 || TKP(t) + 63 > qw + 128)) wmask(P0, P1, TKP(t), qp, hi); } } while (0)
  f32x16 pA0, pA1, pB0, pB1; float mnA, mnB, alA, alB; bf16x8 pa0, pa1, pa2, pa3; const int NT = u.NT;
  constexpr int SE = 0, SO = SDEPTH - 1;
  const int qw = __builtin_amdgcn_readfirstlane(u.qpos0 + wid * 32);
#define ACT(t) (!MASK || (t) < u.nctx || (TKP(t) <= qw + 159 && TKP(t) + 63 >= qw - 128))
  bool actA = true, actB = true;
  SLOAD(SE, 0); asm volatile("s_waitcnt vmcnt(0)" ::: "memory"); SWRITE(0, SE); __syncthreads();
  qkt<DH>(pA0, pA1, K_lds, qr, r32, hi); AMASK(pA0, pA1, 0); partialSM<DH>(pA0, pA1, m_reg, mnA, alA);
  SLOAD(SO, 1); if constexpr (SDEPTH == 2) { if (2 < NT) SLOAD(SE, 2); }
  SWAIT(); SWRITE(1, SO); __syncthreads();
  for (int j = 1; j + 1 < NT; j += 2) {
    actB = ACT(j);
    SBAR(); if (actB) { qkt<DH>(pB0, pB1, K_lds + TB, qr, r32, hi); AMASK(pB0, pB1, j); }
    if (actA) finishSM(pA0, pA1, alA, l_reg, pa0, pa1, pa2, pa3); SBAR();
    SLOAD(SO, j + SDEPTH); SBAR();
    if (actA) pv_all<DH>(o, vb0, pa0, pa1, pa2, pa3);
    if (actB) partialSM<DH>(pB0, pB1, m_reg, mnB, alB); else alB = 1.f;
    __syncthreads(); SWAIT(); SWRITE(0, SE);
    RESC(alB); __syncthreads();
    actA = ACT(j + 1);
    SBAR(); if (actA) { qkt<DH>(pA0, pA1, K_lds, qr, r32, hi); AMASK(pA0, pA1, j + 1); }
    if (actB) finishSM(pB0, pB1, alB, l_reg, pa0, pa1, pa2, pa3); SBAR();
    if (SDEPTH == 1 || j + 3 < NT) SLOAD(SE, j + 1 + SDEPTH); SBAR();
    if (actB) pv_all<DH>(o, vb0 + TB, pa0, pa1, pa2, pa3);
    if (actA) partialSM<DH>(pA0, pA1, m_reg, mnA, alA); else alA = 1.f;
    __syncthreads(); SWAIT(); SWRITE(1, SO);
    RESC(alA); __syncthreads();
  }
  actB = ACT(NT - 1);
  SBAR(); if (actB) { qkt<DH>(pB0, pB1, K_lds + TB, qr, r32, hi); AMASK(pB0, pB1, NT - 1); }
  if (actA) finishSM(pA0, pA1, alA, l_reg, pa0, pa1, pa2, pa3); SBAR();
  if (actA) pv_all<DH>(o, vb0, pa0, pa1, pa2, pa3);
  if (actB) partialSM<DH>(pB0, pB1, m_reg, mnB, alB); else alB = 1.f;
  __syncthreads(); RESC(alB);
  if (actB) { finishSM(pB0, pB1, alB, l_reg, pa0, pa1, pa2, pa3); SBAR();
    pv_all<DH>(o, vb0 + TB, pa0, pa1, pa2, pa3); }
#undef ACT
  l_reg += __builtin_amdgcn_exp2f(u.sink_l2 - m_reg * SC<DH>::C);
  if (hi == 0) li_l[r32] = l_reg; asm volatile("s_waitcnt lgkmcnt(0)" ::: "memory");
  float rli[16];
#pragma unroll
  for (int r = 0; r < 16; ++r) rli[r] = __builtin_amdgcn_rcpf(li_l[crow(r, hi)]);
  { bf16* stg = (bf16*)(lds + 4 * TB + 2048) + wid * (32 * DH);
#pragma unroll
    for (int r = 0; r < 16; ++r) { const int orow = crow(r, hi);
#pragma unroll
      for (int d0 = 0; d0 < NO; ++d0) { const float v = o[d0][r] * rli[r]; const unsigned w = cvtpk(v, v); stg[orow * DH + d0 * 32 + r32] = (bf16)(w & 0xffffu); } }
    asm volatile("s_waitcnt lgkmcnt(0)" ::: "memory");
    constexpr int CPR = DH / 8, RPI = 64 / CPR;
    bf16* Ow = u.O + (long)(wid * 32) * DM;
#pragma unroll
    for (int i = 0; i < 32 / RPI; ++i) { const int row = i * RPI + lane / CPR, ch = lane % CPR; const u32x4 v = *(const u32x4*)(stg + row * DH + ch * 8); *(u32x4*)(Ow + (long)row * DM + ch * 8) = v; } }
  __syncthreads();
#undef TROW
#undef TKP
#undef SLOAD
#undef SWRITE
#undef SWAIT
#undef RESC
#undef AMASK
}
}

__device__ __forceinline__ void transpose_item(const float* W, int K, int N, bf16* WT, int k0, int n0, int drow0, LAS float* scr, int lane) {
    float tv[32];
#pragma unroll
    for (int i = 0; i < 32; ++i) tv[i] = W[(size_t)(k0 + 2 * i + (lane >> 5)) * N + n0 + (lane & 31)];
#pragma unroll
    for (int i = 0; i < 32; ++i) scr[(2 * i + (lane >> 5)) * 33 + (lane & 31)] = tv[i];
    asm volatile("s_waitcnt lgkmcnt(0)" ::: "memory");
    const int c = lane & 7;
#pragma unroll
    for (int j = 0; j < 4; ++j) { const int n = (lane >> 3) + 8 * j; const LAS float* s = scr + (8 * c) * 33 + n;
        u32x4 o; o.x = cvtpk(s[0 * 33], s[1 * 33]); o.y = cvtpk(s[2 * 33], s[3 * 33]); o.z = cvtpk(s[4 * 33], s[5 * 33]); o.w = cvtpk(s[6 * 33], s[7 * 33]);
        *(u32x4*)(WT + (size_t)(drow0 + n) * K + k0 + 8 * c) = o; }
    asm volatile("s_waitcnt lgkmcnt(0)" ::: "memory");
}
__device__ __forceinline__ int ffn_in_row(int n0) { return n0 < FFH ? 256 * (n0 >> 7) + (n0 & 127) : 256 * ((n0 - FFH) >> 7) + 128 + ((n0 - FFH) & 127); }

struct RowJob { const float* xin; const bf16* y; float* xout; bf16* h; const float* gate; const float* sh; const float* sc; };
template <int NR, bool HASY, bool HASH>
__device__ __forceinline__ void combine_rows(const RowJob (&J)[NR], const float* npost, const float* npre, int lane, float gmul) {
    f32x4 xv[NR][4]; u32x2 yv[NR][4];
#pragma unroll
    for (int q = 0; q < NR; ++q)
#pragma unroll
        for (int j = 0; j < 4; ++j) { xv[q][j] = ((const f32x4*)J[q].xin)[lane + 64 * j]; if constexpr (HASY) yv[q][j] = ((const u32x2*)J[q].y)[lane + 64 * j]; }
    if constexpr (HASY) {
        float rstd[NR];
#pragma unroll
        for (int q = 0; q < NR; ++q) { float ss = 0.f;
#pragma unroll
            for (int j = 0; j < 4; ++j) { const float a = bflo(yv[q][j].x), b = bfhi(yv[q][j].x), c = bflo(yv[q][j].y), d = bfhi(yv[q][j].y); ss += (a * a + b * b) + (c * c + d * d); }
            rstd[q] = rsqrtf(wave_sum(ss) * (1.0f / DM) + 1e-6f) * gmul; }
#pragma unroll
        for (int j = 0; j < 4; ++j) { const f32x4 n4 = ((const f32x4*)npost)[lane + 64 * j];
#pragma unroll
            for (int q = 0; q < NR; ++q) { const f32x4 g4 = ((const f32x4*)J[q].gate)[lane + 64 * j];
                const f32x4 yf = {bflo(yv[q][j].x), bfhi(yv[q][j].x), bflo(yv[q][j].y), bfhi(yv[q][j].y)};
                xv[q][j] = xv[q][j] + g4 * (yf * rstd[q] * n4);
                ((f32x4*)J[q].xout)[lane + 64 * j] = xv[q][j]; } }
    }
    if constexpr (HASH) {
        float rstd[NR];
#pragma unroll
        for (int q = 0; q < NR; ++q) { float ss = 0.f;
#pragma unroll
            for (int j = 0; j < 4; ++j) ss += (xv[q][j].x * xv[q][j].x + xv[q][j].y * xv[q][j].y) + (xv[q][j].z * xv[q][j].z + xv[q][j].w * xv[q][j].w);
            rstd[q] = rsqrtf(wave_sum(ss) * (1.0f / DM) + 1e-6f); }
#pragma unroll
        for (int j = 0; j < 4; ++j) { const f32x4 n4 = ((const f32x4*)npre)[lane + 64 * j];
#pragma unroll
            for (int q = 0; q < NR; ++q) { const f32x4 s4 = ((const f32x4*)J[q].sc)[lane + 64 * j], b4 = ((const f32x4*)J[q].sh)[lane + 64 * j];
                const f32x4 hv = (xv[q][j] * rstd[q] * n4) * (s4 + 1.0f) + b4;
                u32x2 w; w.x = cvtpk(hv.x, hv.y); w.y = cvtpk(hv.z, hv.w); ((u32x2*)J[q].h)[lane + 64 * j] = w; } }
    }
}

template <bool HASY, bool HASH, bool XIN32 = true, bool XOUT32 = true>
__device__ __forceinline__ void combine_span(int mb, int me, const void* xin_lat, const void* xin_ctx, void* xout_lat, void* xout_ctx, const bf16* Y, bf16* H,
                                             const float* gate0, const float* npost, const float* sh0, const float* sc0, const float* npre, int lane, float gmul) {
    int cur_r = -1; f32x4 A1[4], A2[4], B2[4];
    for (int m = mb; m < me;) {
        const int r = m < MLAT ? (m >> 11) : 32;
        if (r != cur_r) { cur_r = r;
#pragma unroll
            for (int j = 0; j < 4; ++j) {
                if constexpr (HASY) A1[j] = ((const f32x4*)(gate0 + (size_t)r * MODW))[lane + 64 * j] * ((const f32x4*)npost)[lane + 64 * j] * gmul;
                if constexpr (HASH) { A2[j] = ((const f32x4*)npre)[lane + 64 * j] * (((const f32x4*)(sc0 + (size_t)r * MODW))[lane + 64 * j] + 1.0f); B2[j] = ((const f32x4*)(sh0 + (size_t)r * MODW))[lane + 64 * j]; } } }
        const int mn = m + 1; const bool two = mn < me && (mn < MLAT ? (mn >> 11) : 32) == r;
        const int mq[2] = {m, two ? mn : m};
        f32x4 xv[2][4]; u32x2 yv[2][4];
#pragma unroll
        for (int q = 0; q < 2; ++q) { const int mm = mq[q]; const size_t eo = mm < MLAT ? (size_t)mm * DM : (size_t)(mm - MLAT) * DM; const void* xb = mm < MLAT ? xin_lat : xin_ctx;
#pragma unroll
            for (int j = 0; j < 4; ++j) {
                if constexpr (XIN32) xv[q][j] = ((const f32x4*)((const float*)xb + eo))[lane + 64 * j];
                else { const u32x2 w = ((const u32x2*)((const bf16*)xb + eo))[lane + 64 * j]; xv[q][j] = (f32x4){bflo(w.x), bfhi(w.x), bflo(w.y), bfhi(w.y)}; }
                if constexpr (HASY) yv[q][j] = ((const u32x2*)(Y + (size_t)mm * DM))[lane + 64 * j]; } }
        if constexpr (HASY) {
            float rstd[2];
#pragma unroll
            for (int q = 0; q < 2; ++q) { float ss = 0.f;
#pragma unroll
                for (int j = 0; j < 4; ++j) { const float a = bflo(yv[q][j].x), b = bfhi(yv[q][j].x), c = bflo(yv[q][j].y), d = bfhi(yv[q][j].y); ss += (a * a + b * b) + (c * c + d * d); }
                rstd[q] = rsqrtf(wave_sum(ss) * (1.0f / DM) + 1e-6f); }
#pragma unroll
            for (int q = 0; q < 2; ++q) { const int mm = mq[q]; const size_t eo = mm < MLAT ? (size_t)mm * DM : (size_t)(mm - MLAT) * DM; void* xb = mm < MLAT ? xout_lat : xout_ctx;
#pragma unroll
                for (int j = 0; j < 4; ++j) { const f32x4 yf = {bflo(yv[q][j].x), bfhi(yv[q][j].x), bflo(yv[q][j].y), bfhi(yv[q][j].y)};
                    xv[q][j] = xv[q][j] + A1[j] * (yf * rstd[q]);
                    if constexpr (XOUT32) ((f32x4*)((float*)xb + eo))[lane + 64 * j] = xv[q][j];
                    else { u32x2 w; w.x = cvtpk(xv[q][j].x, xv[q][j].y); w.y = cvtpk(xv[q][j].z, xv[q][j].w); ((u32x2*)((bf16*)xb + eo))[lane + 64 * j] = w;
                        xv[q][j] = (f32x4){bflo(w.x), bfhi(w.x), bflo(w.y), bfhi(w.y)}; } } }
        }
        if constexpr (HASH) {
            float rstd[2];
#pragma unroll
            for (int q = 0; q < 2; ++q) { float ss = 0.f;
#pragma unroll
                for (int j = 0; j < 4; ++j) ss += (xv[q][j].x * xv[q][j].x + xv[q][j].y * xv[q][j].y) + (xv[q][j].z * xv[q][j].z + xv[q][j].w * xv[q][j].w);
                rstd[q] = rsqrtf(wave_sum(ss) * (1.0f / DM) + 1e-6f); }
#pragma unroll
            for (int q = 0; q < 2; ++q) { const int mm = mq[q];
#pragma unroll
                for (int j = 0; j < 4; ++j) { const f32x4 hv = (xv[q][j] * rstd[q]) * A2[j] + B2[j];
                    u32x2 w; w.x = cvtpk(hv.x, hv.y); w.y = cvtpk(hv.z, hv.w); ((u32x2*)(H + (size_t)mm * DM))[lane + 64 * j] = w; } }
        }
        m += two ? 2 : 1;
    }
}

#define XB_TMO      128
#define XB_XCNT(j)  (256  + 64 * (j))
#define XB_XSUB(j)  (1280 + 64 * (j))
#define XB_XGEN(j)  (2304 + 64 * (j))
#define XB_TOP      3328
#define XB_TOPGEN   3392
#define XCD_BAR_WORDS 3456
#define XB_SPIN_CAP (1u << 18)

__device__ __forceinline__ unsigned xb_ld(unsigned* p)              { return __hip_atomic_load(p, __ATOMIC_RELAXED, __HIP_MEMORY_SCOPE_AGENT); }
__device__ __forceinline__ unsigned xb_add(unsigned* p, unsigned v) { return __hip_atomic_fetch_add(p, v, __ATOMIC_RELAXED, __HIP_MEMORY_SCOPE_AGENT); }
__device__ __forceinline__ unsigned xb_xcc_id() { return (unsigned)__builtin_amdgcn_s_getreg((3 << 11) | 20) & 0xFu; }
#define XB_SPIN(cond, bar) do { unsigned _sp = 0; while (cond) { __builtin_amdgcn_s_sleep(1); \
    if ((++_sp & 255u) == 0u) { if (xb_ld(&(bar)[XB_TMO])) break; if (_sp > XB_SPIN_CAP) { atomicAdd(&(bar)[XB_TMO], 1u); break; } } } } while (0)

struct XcdBarrier {
    unsigned* bar; unsigned x;
    volatile LAS unsigned* st;
};

__device__ __forceinline__ XcdBarrier xcd_barrier_post(unsigned* bar, volatile LAS unsigned* st) {
    XcdBarrier b; b.bar = bar; b.x = xb_xcc_id(); b.st = st;
    if (threadIdx.x == 0) (void)xb_add(&bar[XB_XCNT(b.x)], 1u);
    return b;
}
__device__ __forceinline__ void xcd_barrier_complete(unsigned* bar, unsigned x, unsigned& nloc, unsigned& nx) {
    const unsigned G = gridDim.x * gridDim.y * gridDim.z;
    unsigned sum, cnt, mine, sp = 0u;
    for (;;) {
        sum = 0u; cnt = 0u; mine = 0u;
#pragma unroll
        for (unsigned j = 0; j < 16; ++j) { const unsigned c = xb_ld(&bar[XB_XCNT(j)]); sum += c; cnt += (c > 0u) ? 1u : 0u; mine = (j == x) ? c : mine; }
        if (sum == G) break;
        __builtin_amdgcn_s_sleep(1);
        if ((++sp & 255u) == 0u) { if (xb_ld(&bar[XB_TMO])) break; if (sp > XB_SPIN_CAP) { atomicAdd(&bar[XB_TMO], 1u); break; } }
    }
    nloc = mine > 0u ? mine : 1u; nx = cnt > 0u ? cnt : 1u;
}

__device__ __forceinline__ void xcd_barrier(const XcdBarrier& b) {
    asm volatile("s_waitcnt vmcnt(0)" ::: "memory");
    __syncthreads();
    if (threadIdx.x == 0) {
        unsigned* bar = b.bar;
        __builtin_amdgcn_s_waitcnt(0);
        unsigned nloc = b.st[0], nx = b.st[1];
        if (nloc == 0u) { xcd_barrier_complete(bar, b.x, nloc, nx); b.st[0] = nloc; b.st[1] = nx; }
        const unsigned old = xb_add(&bar[XB_XSUB(b.x)], 1u);
        const unsigned gen = old / nloc;
        if (old + 1u == (gen + 1u) * nloc) {
            __builtin_amdgcn_fence(__ATOMIC_RELEASE, "agent");
            asm volatile("s_waitcnt vmcnt(0)" ::: "memory");
            const unsigned og = xb_add(&bar[XB_TOP], 1u);
            const unsigned tg = og / nx;
            if (og + 1u == (tg + 1u) * nx) xb_add(&bar[XB_TOPGEN], 1u);
            else XB_SPIN(xb_ld(&bar[XB_TOPGEN]) == tg, bar);
            __builtin_amdgcn_fence(__ATOMIC_ACQUIRE, "agent");
            xb_add(&bar[XB_XGEN(b.x)], 1u);
            asm volatile("s_waitcnt vmcnt(0)" ::: "memory");
        } else {
            XB_SPIN(xb_ld(&bar[XB_XGEN(b.x)]) == gen, bar);
            __builtin_amdgcn_fence(__ATOMIC_ACQUIRE, "agent");
            asm volatile("s_waitcnt vmcnt(0)" ::: "memory");
        }
    }
    __syncthreads();
}

struct Args { const float* in[23]; float* out; unsigned char* ws; int ph_lo, ph_hi; };

__global__ void __launch_bounds__(512, 2) mega(Args args) {
    extern __shared__ __attribute__((aligned(16))) unsigned char lds[];
    cg::grid_group grid = cg::this_grid();
    const int G = gridDim.x, bx = blockIdx.x;
    const int vcu = (G % 8 == 0) ? (bx % 8) * (G / 8) + bx / 8 : bx;
    const int NGW = G * 8;
    const int lo = args.ph_lo, hi = args.ph_hi;
    unsigned char* ws = args.ws;
    const float* x_in = args.in[0]; const float* c_in = args.in[1]; const float* ctx_in = args.in[2]; const float* cctx_in = args.in[3];
    const float* ada_w = args.in[4]; const float* ada_b = args.in[5]; const float* norm_g = args.in[6];
    float* modp = (float*)(ws + OFF_MODP); float* mods = (float*)(ws + OFF_MODS);
    float* cosA = (float*)(ws + OFF_ROPE); float* sinA = cosA + 2048 * 32; float* cosC = sinA + 2048 * 32; float* sinC = cosC + 2048 * 64;
    bf16* Wsb = (bf16*)(ws + OFF_WS);
    unsigned char* Wb = ws + OFF_W;
#ifndef XBF16
#define XBF16 0
#endif
    void* XC = (void*)(ws + OFF_XC); void* XL = XBF16 ? (void*)(ws + OFF_XLB) : (void*)args.out;
    bf16* Hb = (bf16*)(ws + OFF_H); bf16* Yb = (bf16*)(ws + OFF_Y); bf16* QKV = (bf16*)(ws + OFF_BIG); bf16* Ob = (bf16*)(ws + OFF_O); bf16* HID = (bf16*)(ws + OFF_BIG);
    if (threadIdx.x < 16) ((LAS unsigned*)((LAS unsigned char*)lds + LDS_XB))[threadIdx.x] = 0u;
    __syncthreads();
    const XcdBarrier xbar = xcd_barrier_post((unsigned*)(ws + OFF_CTL), (volatile LAS unsigned*)((LAS unsigned char*)lds + LDS_XB));
    bool first_seam = false;
    int ph = 0;
#define GSYNC() do { if (first_seam) { grid.sync(); first_seam = false; } else xcd_barrier(xbar); } while (0)
    first_seam = args.ph_hi < 0;
#ifndef PH_MASK
#define PH_MASK 0xffff
#endif
#define RUN(p) (lo <= (p) && (p) < hi)
#define ON(b) ((PH_MASK >> (b)) & 1)
#ifndef G1MASK
#define G1MASK 7
#endif
#ifndef ATMASK
#define ATMASK 3
#endif
#define ATK(k) ((ATMASK >> (k)) & 1)
#define G1K(k) ((G1MASK >> (k)) & 1)
#define SEAM(p) do { if (RUN(p) && RUN((p) + 1)) GSYNC(); } while (0)

#ifndef NPRO
#define NPRO 1
#endif
#ifndef CMB_F1
#define CMB_F1 5
#endif
#ifndef CMB_F2
#define CMB_F2 6
#endif
#ifndef EPI_SKIP_ON_REP
#define EPI_SKIP_ON_REP 0
#endif
#ifdef EXTRA_SYNCS
    for (int es = 0; es < EXTRA_SYNCS; ++es) GSYNC();
#endif
    for (int prep = 0; prep < NPRO; ++prep) {
    if (prep) { GSYNC(); ph -= 3; }
    int tid = threadIdx.x; asm volatile("" : "+v"(tid));
    const int lane = tid & 63, wave = __builtin_amdgcn_readfirstlane(tid >> 6), gw = vcu * 8 + wave;
    if (ON(0) && RUN(ph)) {
        LAS float* scr = (LAS float*)((LAS unsigned char*)lds + wave * 16896);
        for (int it = gw; it < 96 * 8; it += NGW) {
            const int cb = it % 96, ks = it / 96, k0 = ks * 128;
            { float cv[NMODROW][2];
#pragma unroll
              for (int r = 0; r < NMODROW; ++r) { const float* cp = r < 32 ? c_in + r * DM + k0 : cctx_in + k0; cv[r][0] = cp[lane]; cv[r][1] = cp[lane + 64]; }
#pragma unroll
              for (int r = 0; r < NMODROW; ++r) { scr[r * 128 + lane] = cv[r][0] / (1.0f + __expf(-cv[r][0])); scr[r * 128 + lane + 64] = cv[r][1] / (1.0f + __expf(-cv[r][1])); } }
            asm volatile("s_waitcnt lgkmcnt(0)" ::: "memory");
            f32x4 acc[NMODROW];
#pragma unroll
            for (int r = 0; r < NMODROW; ++r) acc[r] = (f32x4){0.f, 0.f, 0.f, 0.f};
            const int li = cb / 24, col0 = (cb % 24) * 256 + lane * 4;
            const float* wp = ada_w + ((size_t)li * DM + k0) * MODW + col0;
#pragma nounroll
            for (int kk = 0; kk < 128; kk += 8) {
                f32x4 w4[8];
#pragma unroll
                for (int u = 0; u < 8; ++u) w4[u] = *(const f32x4*)(wp + (size_t)(kk + u) * MODW);
#pragma unroll
                for (int r = 0; r < NMODROW; ++r) { const f32x4 s0 = *(const LAS f32x4*)(scr + r * 128 + kk), s1 = *(const LAS f32x4*)(scr + r * 128 + kk + 4);
                    acc[r] = acc[r] + w4[0] * s0.x + w4[1] * s0.y + w4[2] * s0.z + w4[3] * s0.w + w4[4] * s1.x + w4[5] * s1.y + w4[6] * s1.z + w4[7] * s1.w; } }
#pragma unroll
            for (int r = 0; r < NMODROW; ++r) *(f32x4*)(modp + ((size_t)ks * NMODROW + r) * (4 * MODW) + li * MODW + col0) = acc[r];
            asm volatile("s_waitcnt lgkmcnt(0)" ::: "memory");
        }
        {
            constexpr int I_FI = 16 * 176, I_FO = 44 * 32, I_AQ = 16 * 48, I_AO = 16 * 32, I_BI = 16 * 64, I_BO = 16 * 32, I_CQ = 16 * 64, I_CO = 16 * 32;
            constexpr int NIT = 4 * I_FI + 4 * I_FO + 2 * I_AQ + 2 * I_AO + I_BI + I_BO + I_CQ + I_CO;
            const int ntw = NGW > 1024 ? NGW - 768 : NGW, tw = NGW > 1024 ? gw - 768 : gw;
            if (tw >= 0) for (int it = tw; it < NIT; it += ntw) {
                int r = it;
                if (r < 4 * I_FI) { const int l = r / I_FI; r %= I_FI; const int kb = r / 176, nb = r % 176;
                    transpose_item(args.in[7] + (size_t)l * DM * 2 * FFH, DM, 2 * FFH, (bf16*)(Wb + W_FI) + (size_t)l * 2 * FFH * DM, kb * 64, nb * 32, ffn_in_row(nb * 32), scr, lane); continue; } r -= 4 * I_FI;
                if (r < 4 * I_FO) { const int l = r / I_FO; r %= I_FO; const int kb = r / 32, nb = r % 32;
                    transpose_item(args.in[8] + (size_t)l * FFH * DM, FFH, DM, (bf16*)(Wb + W_FO) + (size_t)l * DM * FFH, kb * 64, nb * 32, nb * 32, scr, lane); continue; } r -= 4 * I_FO;
                if (r < 2 * I_AQ) { const int l = r / I_AQ; r %= I_AQ; const int kb = r / 48, nb = r % 48;
                    transpose_item(args.in[9] + (size_t)l * DM * 1536, DM, 1536, (bf16*)(Wb + W_AQ) + (size_t)l * 1536 * DM, kb * 64, nb * 32, nb * 32, scr, lane); continue; } r -= 2 * I_AQ;
                if (r < 2 * I_AO) { const int l = r / I_AO; r %= I_AO; const int kb = r / 32, nb = r % 32;
                    transpose_item(args.in[10] + (size_t)l * DM * DM, DM, DM, (bf16*)(Wb + W_AO) + (size_t)l * DM * DM, kb * 64, nb * 32, nb * 32, scr, lane); continue; } r -= 2 * I_AO;
                if (r < I_BI) { const int kb = r / 64, nb = r % 64; transpose_item(args.in[12], DM, 2048, (bf16*)(Wb + W_BI), kb * 64, nb * 32, nb * 32, scr, lane); continue; } r -= I_BI;
                if (r < I_BO) { const int kb = r / 32, nb = r % 32; transpose_item(args.in[18], DM, DM, (bf16*)(Wb + W_BO), kb * 64, nb * 32, nb * 32, scr, lane); continue; } r -= I_BO;
                if (r < I_CQ) { const int kb = r / 64, nb = r % 64; transpose_item(args.in[19], DM, 2048, (bf16*)(Wb + W_CQ), kb * 64, nb * 32, nb * 32, scr, lane); continue; } r -= I_CQ;
                { const int kb = r / 32, nb = r % 32; transpose_item(args.in[20], DM, DM, (bf16*)(Wb + W_CO), kb * 64, nb * 32, nb * 32, scr, lane); }
            }
        }
        {
            const int gt = gw * 64 + lane, NGT = NGW * 64;
            const float* wsf = args.in[16];
            for (int e = gt; e < 8 * 128 * 128 / 2; e += NGT) ((unsigned*)Wsb)[e] = cvtpk(wsf[2 * e], wsf[2 * e + 1]);
            for (int e = gt; e < 2048 * 32; e += NGT) { const int t = e >> 5, p = e & 31, j = p & 15; const float pos = (float)(p < 16 ? (t >> 6) : (t & 63));
                const float inv = exp2f(-(float)j * (13.287712379549449f / 16.0f)); const float a = pos * inv; cosA[e] = cosf(a); sinA[e] = sinf(a); }
            for (int e = gt; e < 2048 * 64; e += NGT) { const int t = e >> 6, p = e & 63, j = p & 31; const float pos = (float)(p < 32 ? (t >> 6) : (t & 63));
                const float inv = exp2f(-(float)j * (13.287712379549449f / 32.0f)); const float a = pos * inv; cosC[e] = cosf(a); sinC[e] = sinf(a); }
        }
    }
    SEAM(ph); ++ph;
    if (ON(1) && RUN(ph)) {
        const int gt = gw * 64 + lane, NGT = NGW * 64;
        for (int e = gt; e < DEPTH * NMODROW * MODW / 4; e += NGT) {
            const int c4 = e % (MODW / 4), rr = (e / (MODW / 4)) % NMODROW, li = e / (MODW / 4 * NMODROW);
            f32x4 s = *(const f32x4*)(ada_b + li * MODW + c4 * 4);
#pragma unroll
            for (int k = 0; k < 8; ++k) s = s + *(const f32x4*)(modp + ((size_t)k * NMODROW + rr) * (4 * MODW) + li * MODW + c4 * 4);
            *(f32x4*)(mods + ((size_t)li * NMODROW + rr) * MODW + c4 * 4) = s;
        }
    }
    SEAM(ph); ++ph;
    if (ON(2) && RUN(ph)) {
        { const int rpw = (MTOT + NGW - 1) / NGW, mb = gw * rpw, me = mb + rpw < MTOT ? mb + rpw : MTOT;
          combine_span<false, true>(mb, me, x_in, ctx_in, nullptr, nullptr, nullptr, Hb, nullptr, nullptr, mods, mods + DM, norm_g, lane, 1.0f); }
    }
    SEAM(ph); ++ph;
    }

    constexpr int NOPS = 10;
    for (int step = 3, rep = 0; step < 3 + NOPS * DEPTH; ) {
        const int li = (step - 3) / NOPS, op = (step - 3) % NOPS;
        int tid = threadIdx.x; asm volatile("" : "+v"(tid));
        const int lane = tid & 63, wave = __builtin_amdgcn_readfirstlane(tid >> 6), gw = vcu * 8 + wave;
        const int kind = li % 3; const int ja = li / 3; const bool ctx_out = li < DEPTH - 1; const int Mact = ctx_out ? MTOT : MLAT;
        const float* ng = norm_g + (size_t)li * 4 * DM;
        const bool noop = (op == 1 && kind == 1) || ((op == 5 || op == 9) && !ctx_out);
        if (RUN(ph) && !noop) {
#ifdef STAGGER_US
            if (op == 0 || op == 3 || op == 5 || op == 6) {
                const unsigned long long t0 = __builtin_amdgcn_s_memrealtime(); const unsigned long long dl = (unsigned long long)(((bx >> 3) & 3) * STAGGER_US * 100);
                while (__builtin_amdgcn_s_memrealtime() - t0 < dl) __builtin_amdgcn_s_sleep(32);
            }
#endif
            if (ON(3) && ((op == 0 && kind != 1) || op == 3 || op == 7 || ((op == 4 || op == 8) && ctx_out))) {
                pg8::Gemm g; pg8::EpiBf16<0> E; E.bias = nullptr; E.split_cols = 0; E.split_stride = 0; E.scale0 = 1.f; E.skip = EPI_SKIP_ON_REP ? rep * EPI_SKIP_ON_REP : 0; E.scratch = Ob;
                if (op == 0) { const int N1 = kind == 0 ? 1536 : 2048; g.A = Hb; g.Bt = kind == 0 ? (const bf16*)(Wb + W_AQ) + (size_t)ja * 1536 * DM : (const bf16*)(Wb + W_CQ); g.M = MTOT; g.N = N1; g.K = DM; E.O = QKV; E.ldc = N1; }
                else if (op == 3 || op == 4) { const size_t ro = op == 4 ? (size_t)MLAT * DM : 0;
                    g.A = Ob + ro; g.Bt = kind == 0 ? (const bf16*)(Wb + W_AO) + (size_t)ja * DM * DM : kind == 1 ? (const bf16*)(Wb + W_BO) : (const bf16*)(Wb + W_CO); g.M = op == 4 ? MCTX : MLAT; g.N = DM; g.K = DM; E.O = Yb + ro; E.ldc = DM; }
                else { const bool cx = op == 8;
                    g.A = HID + (cx ? (size_t)MLAT * FFH : 0); g.Bt = (const bf16*)(Wb + W_FO) + (size_t)li * DM * FFH; g.M = cx ? MCTX : MLAT; g.N = DM; g.K = FFH; E.O = Yb + (cx ? (size_t)MLAT * DM : 0); E.ldc = DM; }
                pg8::StaticOrder S; S.init(g.M, g.N, G, bx);
                pg8::gemm_phase<pg8::EpiBf16<0>, pg8::StaticOrder, true, true>((PG8_LAS unsigned char*)lds, g, S, E);
            }
            else if (ON(4) && op == 0) {
                pg8::Gemm g{Hb, (const bf16*)(Wb + W_BI), MTOT, 2048, DM}; pg8::StaticOrder S; S.init(MTOT, 2048, G, bx);
                pg8::EpiBf16<1> E{QKV, 2048, args.in[13], 0, 0, 1.f, EPI_SKIP_ON_REP ? rep * EPI_SKIP_ON_REP : 0, Ob}; pg8::gemm_phase<pg8::EpiBf16<1>, pg8::StaticOrder, true, true>((PG8_LAS unsigned char*)lds, g, S, E);
            }
            else if (ON(5) && op == 6) {
                pg8::Gemm g{Hb, (const bf16*)(Wb + W_FI) + (size_t)li * 2 * FFH * DM, Mact, 2 * FFH, DM}; pg8::StaticOrder S; S.init(Mact, 2 * FFH, G, bx);
                pg8::EpiSwiglu E{HID, FFH}; pg8::gemm_phase<pg8::EpiSwiglu, pg8::StaticOrder, true, true>((PG8_LAS unsigned char*)lds, g, S, E);
            }
            else if (ON(6) && op == 1) {
                if (kind == 0) {
                    const int rs = lane >> 4, l16 = lane & 15, hd = l16 >> 2, i0 = (l16 & 3) * 8;
#pragma nounroll
                    for (int m = gw * 4 + rs; m < MLAT; m += NGW * 4) { const int t = m & 2047; bf16* kp = QKV + (size_t)m * 1536 + 1024 + hd * 64 + i0;
                        const bf16x8 x1 = *(const bf16x8*)kp, x2 = *(const bf16x8*)(kp + 32);
                        const f32x4 c0 = *(const f32x4*)(cosA + t * 32 + i0), c1 = *(const f32x4*)(cosA + t * 32 + i0 + 4), s0 = *(const f32x4*)(sinA + t * 32 + i0), s1 = *(const f32x4*)(sinA + t * 32 + i0 + 4);
                        float o1[8], o2[8];
#pragma unroll
                        for (int j = 0; j < 8; ++j) { const float c = j < 4 ? c0[j & 3] : c1[j & 3], sn = j < 4 ? s0[j & 3] : s1[j & 3]; const float a = bf2f(x1[j]), b = bf2f(x2[j]); o1[j] = a * c - b * sn; o2[j] = b * c + a * sn; }
                        *(u32x4*)kp = (u32x4){cvtpk(o1[0], o1[1]), cvtpk(o1[2], o1[3]), cvtpk(o1[4], o1[5]), cvtpk(o1[6], o1[7])};
                        *(u32x4*)(kp + 32) = (u32x4){cvtpk(o2[0], o2[1]), cvtpk(o2[2], o2[3]), cvtpk(o2[4], o2[5]), cvtpk(o2[6], o2[7])}; }
                } else {
                    const float* kg = args.in[22]; const int rs = lane >> 5, l32 = lane & 31, hd = l32 >> 3, i0 = (l32 & 7) * 8;
                    const f32x4 ga0 = *(const f32x4*)(kg + i0), ga1 = *(const f32x4*)(kg + i0 + 4), gb0 = *(const f32x4*)(kg + 64 + i0), gb1 = *(const f32x4*)(kg + 64 + i0 + 4);
#pragma nounroll
                    for (int m = gw * 2 + rs; m < MTOT; m += NGW * 2) { bf16* kp = QKV + (size_t)m * 2048 + 1024 + hd * 128 + i0;
                        const bf16x8 x1 = *(const bf16x8*)kp, x2 = *(const bf16x8*)(kp + 64);
                        float a[8], b[8]; float ss = 0.f;
#pragma unroll
                        for (int j = 0; j < 8; ++j) { a[j] = bf2f(x1[j]); b[j] = bf2f(x2[j]); ss += a[j] * a[j] + b[j] * b[j]; }
                        ss += __shfl_xor(ss, 1); ss += __shfl_xor(ss, 2); ss += __shfl_xor(ss, 4);
                        const float rstd = rsqrtf(ss * (1.0f / 128.0f) + 1e-6f);
#pragma unroll
                        for (int j = 0; j < 8; ++j) { a[j] *= rstd * (j < 4 ? ga0[j & 3] : ga1[j & 3]); b[j] *= rstd * (j < 4 ? gb0[j & 3] : gb1[j & 3]); }
                        if (m < MLAT) { const int t = m & 2047;
                            const f32x4 c0 = *(const f32x4*)(cosC + t * 64 + i0), c1 = *(const f32x4*)(cosC + t * 64 + i0 + 4), s0 = *(const f32x4*)(sinC + t * 64 + i0), s1 = *(const f32x4*)(sinC + t * 64 + i0 + 4);
#pragma unroll
                            for (int j = 0; j < 8; ++j) { const float c = j < 4 ? c0[j & 3] : c1[j & 3], sn = j < 4 ? s0[j & 3] : s1[j & 3]; const float x1v = a[j], x2v = b[j]; a[j] = x1v * c - x2v * sn; b[j] = x2v * c + x1v * sn; } }
                        *(u32x4*)kp = (u32x4){cvtpk(a[0], a[1]), cvtpk(a[2], a[3]), cvtpk(a[4], a[5]), cvtpk(a[6], a[7])};
                        *(u32x4*)(kp + 64) = (u32x4){cvtpk(b[0], b[1]), cvtpk(b[2], b[3]), cvtpk(b[4], b[5]), cvtpk(b[6], b[7])}; }
                }
            }
            else if (ON(7) && op == 2 && kind != 1) {
                if (kind == 0) {
                    const float* sink = args.in[11] + ja * 16;
                    const int nlat = 4096, ntot = nlat + (ctx_out ? 512 : 0);
                    for (int u = bx; u < ntot; u += G) {
                        att::UnitDesc d; d.nctx = 4; d.cosT = cosA; d.sinT = sinA; d.qg = nullptr;
                        int b, h;
                        if (u < nlat) { const int x = u & 7, j = (u >> 3) & 31, gi = (u >> 8) * 8 + x; b = gi >> 2; const int kvh = gi & 3; h = kvh * 4 + (j >> 3); const int q0 = (((j & 7) + (u >> 8)) & 7) * 256;
                            d.Q = QKV + ((size_t)b * SEQ + q0) * 1536 + h * 64; d.O = Ob + ((size_t)b * SEQ + q0) * DM + h * 64; d.qpos0 = q0;
                            const int klo = q0 - 128 < 0 ? 0 : q0 - 128, khi = q0 + 384 > SEQ ? SEQ : q0 + 384; d.band_kp0 = klo; d.NT = 4 + (khi - klo) / 64; }
                        else { const int cu = u - nlat; b = cu >> 4; h = cu & 15;
                            d.Q = QKV + ((size_t)MLAT + b * CTXL) * 1536 + h * 64; d.O = Ob + ((size_t)MLAT + b * CTXL) * DM + h * 64; d.qpos0 = -1; d.band_kp0 = 0; d.NT = 4; }
                        d.Kc = QKV + 1024 + (h >> 2) * 64; d.Vc = QKV + 1280 + (h >> 2) * 64; d.ctx_row0 = MLAT + b * CTXL; d.lat_row0 = (long)b * SEQ;
                        d.sink_l2 = sink[h] * 1.4426950408889634f;
                        att::attn_unit<64, 1536, false, true>(d, (char*)lds);
                    }
                } else {
                    const int nlat = 2048, ntot = nlat + (ctx_out ? 256 : 0);
                    for (int u = bx; u < ntot; u += G) {
                        att::UnitDesc d; d.nctx = 4; d.cosT = cosC; d.sinT = sinC; d.qg = args.in[21]; d.band_kp0 = 0;
                        int b, h;
                        if (u < nlat) { const int x = u & 7, j = (u >> 3) & 31, gi = ((u >> 8) * 8 + x) * 2 + (j >> 4); b = gi >> 2; const int kvh = gi & 3; h = kvh * 2 + ((j & 15) >> 3); const int q0 = (j & 7) * 256;
                            d.Q = QKV + ((size_t)b * SEQ + q0) * 2048 + h * 128; d.O = Ob + ((size_t)b * SEQ + q0) * DM + h * 128; d.qpos0 = q0; d.NT = 36; }
                        else { const int cu = u - nlat; b = cu >> 3; h = cu & 7;
                            d.Q = QKV + ((size_t)MLAT + b * CTXL) * 2048 + h * 128; d.O = Ob + ((size_t)MLAT + b * CTXL) * DM + h * 128; d.qpos0 = -1; d.NT = 4; }
                        d.Kc = QKV + 1024 + (h >> 1) * 128; d.Vc = QKV + 1536 + (h >> 1) * 128; d.ctx_row0 = MLAT + b * CTXL; d.lat_row0 = (long)b * SEQ;
                        d.sink_l2 = -INFINITY;
                        att::attn_unit<128, 2048, true, false>(d, (char*)lds);
                    }
                }

            }
            else if (ON(8) && op == 2) {
                constexpr int TB = 16384;
                char* V_lds = (char*)lds; f32x2* stat = (f32x2*)((char*)lds + 2 * TB);
                const float* lng = args.in[14]; const float* lnb = args.in[15]; const float* bsb = args.in[17];
                const int r32 = lane & 31, hh = lane >> 5, rb = wave & 3, chh = wave >> 2;
                const int sr = tid >> 4, sc = (tid & 15) * 8;
                const int vb0 = (int)(uintptr_t)V_lds + att::v_rd_base(lane);
                for (int u = bx; u < (MTOT / 128) * 2; u += G) {
                    const int ux = u & 7, uj = (u >> 3) & 31, ur = u >> 8; const int chunk = ur * 128 + ux * (ur < 4 ? 16 : 8) + (uj >> 1), gh = uj & 1;     const size_t row0 = (size_t)chunk * 128;
                    if (chunk >= MTOT / 128) continue;
#pragma nounroll
                    for (int rb8 = 0; rb8 < 16; rb8 += 8) {
                        bf16x8 v0[8], v1[8];
#pragma unroll
                        for (int rr = 0; rr < 8; ++rr) { const bf16* vp = QKV + (row0 + wave * 16 + rb8 + rr) * 2048 + 1024 + lane * 16; v0[rr] = *(const bf16x8*)vp; v1[rr] = *(const bf16x8*)(vp + 8); }
#pragma unroll
                        for (int rr = 0; rr < 8; ++rr) { float f[16];
#pragma unroll
                            for (int j = 0; j < 8; ++j) { f[j] = bf2f(v0[rr][j]); f[8 + j] = bf2f(v1[rr][j]); }
                            float sm = 0.f;
#pragma unroll
                            for (int j = 0; j < 16; ++j) sm += f[j];
                            const float mean = wave_sum(sm) * (1.0f / 1024.0f); float q = 0.f;
#pragma unroll
                            for (int j = 0; j < 16; ++j) { const float dd = f[j] - mean; q += dd * dd; }
                            const float rstd = rsqrtf(wave_sum(q) * (1.0f / 1024.0f) + 1e-5f);
                            if (lane == 0) stat[wave * 16 + rb8 + rr] = (f32x2){mean, rstd}; }
                    }
                    __syncthreads();
                    for (int gi = 0; gi < 4; ++gi) {
                        const int g = gh * 4 + gi;
                        bf16x8 raw[4], pa[2][4], uv[4];
#pragma unroll
                        for (int l = 0; l < 4; ++l) raw[l] = *(const bf16x8*)(QKV + (row0 + sr + 32 * l) * 2048 + 1024 + g * 128 + sc);
#pragma unroll
                        for (int T = 0; T < 2; ++T)
#pragma unroll
                            for (int ks = 0; ks < 4; ++ks) pa[T][ks] = *(const bf16x8*)(Wsb + (size_t)g * 16384 + (32 * rb + r32) * 128 + 64 * T + 16 * ks + 8 * hh);
#pragma unroll
                        for (int i = 0; i < 4; ++i) uv[i] = *(const bf16x8*)(QKV + (row0 + 32 * rb + i * 8 + (lane >> 3)) * 2048 + g * 128 + 64 * chh + (lane & 7) * 8);
                        const f32x4 lg0 = *(const f32x4*)(lng + g * 128 + sc), lg1 = *(const f32x4*)(lng + g * 128 + sc + 4), lb0 = *(const f32x4*)(lnb + g * 128 + sc), lb1 = *(const f32x4*)(lnb + g * 128 + sc + 4);
#pragma unroll
                        for (int l = 0; l < 4; ++l) { const int rl = sr + 32 * l;
                            const f32x2 st = stat[rl]; float f[8];
#pragma unroll
                            for (int j = 0; j < 8; ++j) f[j] = (bf2f(raw[l][j]) - st.x) * st.y * (j < 4 ? lg0[j & 3] : lg1[j & 3]) + (j < 4 ? lb0[j & 3] : lb1[j & 3]);
                            u32x4 w = {cvtpk(f[0], f[1]), cvtpk(f[2], f[3]), cvtpk(f[4], f[5]), cvtpk(f[6], f[7])};
                            *(u32x4*)(V_lds + (l >> 1) * TB + att::v_st<128>(sr + 32 * (l & 1), sc)) = w; }
                        __syncthreads();
                        f32x16 o[2]; o[0] = f32x16{}; o[1] = f32x16{};
                        if (chh == 0) {
                            att::pv_one<128, 0>(o[0], vb0, pa[0][0], pa[0][1], pa[0][2], pa[0][3]); att::pv_one<128, 1>(o[1], vb0, pa[0][0], pa[0][1], pa[0][2], pa[0][3]);
                            att::pv_one<128, 0>(o[0], vb0 + TB, pa[1][0], pa[1][1], pa[1][2], pa[1][3]); att::pv_one<128, 1>(o[1], vb0 + TB, pa[1][0], pa[1][1], pa[1][2], pa[1][3]);
                        } else {
                            att::pv_one<128, 2>(o[0], vb0, pa[0][0], pa[0][1], pa[0][2], pa[0][3]); att::pv_one<128, 3>(o[1], vb0, pa[0][0], pa[0][1], pa[0][2], pa[0][3]);
                            att::pv_one<128, 2>(o[0], vb0 + TB, pa[1][0], pa[1][1], pa[1][2], pa[1][3]); att::pv_one<128, 3>(o[1], vb0 + TB, pa[1][0], pa[1][1], pa[1][2], pa[1][3]);
                        }
                        { bf16* stg = (bf16*)((char*)lds + 2 * TB + 1024) + wave * 2048;
#pragma unroll
                          for (int r = 0; r < 16; ++r) { const int pr = att::crow(r, hh); const float bias = bsb[g * 128 + 32 * rb + pr];
#pragma unroll
                            for (int d = 0; d < 2; ++d) { const float v = o[d][r] + bias; stg[pr * 64 + d * 32 + r32] = (bf16)(cvtpk(v, v) & 0xffffu); } }
                          asm volatile("s_waitcnt lgkmcnt(0)" ::: "memory");
#pragma unroll
                          for (int i = 0; i < 4; ++i) { const int row = i * 8 + (lane >> 3), ch = lane & 7; const bf16x8 mv = *(const bf16x8*)(stg + row * 64 + ch * 8);
                            const size_t gr = row0 + 32 * rb + row; const int col = g * 128 + 64 * chh + ch * 8;
                            float f[8];
#pragma unroll
                            for (int e = 0; e < 8; ++e) f[e] = bf2f(uv[i][e]) * bf2f(mv[e]);
                            u32x4 w = {cvtpk(f[0], f[1]), cvtpk(f[2], f[3]), cvtpk(f[4], f[5]), cvtpk(f[6], f[7])};
                            *(u32x4*)(Ob + gr * DM + col) = w; } }
                        __syncthreads();
                    }
                }

            }
            if (ON(9) && (op == 4 || op == 5 || op == 8 || op == 9)) {
                const bool c2 = op >= 8, last = li == DEPTH - 1, first = li == 0 && !c2 && !rep;
                const int rbase = (op == 5 || op == 9) ? MLAT : 0, nrows = rbase ? MCTX : MLAT;
                const float* ml = mods + (size_t)li * NMODROW * MODW; const float* mn = ml + (size_t)NMODROW * MODW;
                int mb, me;
                if (ctx_out && !rbase && G == 256) {
                    const int F = c2 ? CMB_F2 : CMB_F1; int r0, nr;
                    if (bx >= 128) { nr = F * 64; r0 = (bx - 128) * nr; } else { nr = (8 - F) * 64; r0 = 128 * F * 64 + bx * nr; }
                    mb = r0 + wave * (nr >> 3); me = mb + (nr >> 3);
                } else { const int rpw = (nrows + NGW - 1) / NGW; mb = gw * rpw; me = mb + rpw < nrows ? mb + rpw : nrows; mb += rbase; me += rbase; }
                {
                    if (!c2) {
                        if (first) combine_span<true, true, true, !XBF16>(mb, me, x_in, ctx_in, XL, XC, Yb, Hb, ml + 2 * DM, ng + DM, ml + 3 * DM, ml + 4 * DM, ng + 2 * DM, lane, 1.0f);
                        else combine_span<true, true, !XBF16, !XBF16>(mb, me, XL, XC, XL, XC, Yb, Hb, ml + 2 * DM, ng + DM, ml + 3 * DM, ml + 4 * DM, ng + 2 * DM, lane, rep ? 0.0f : 1.0f);
                    } else {
                        if (last) combine_span<true, false, !XBF16, true>(mb, me, XL, XC, args.out, XC, Yb, Hb, ml + 5 * DM, ng + 3 * DM, nullptr, nullptr, nullptr, lane, rep ? 0.0f : 1.0f);
                        else combine_span<true, true, !XBF16, !XBF16>(mb, me, XL, XC, XL, XC, Yb, Hb, ml + 5 * DM, ng + 3 * DM, mn, mn + DM, ng + 4 * DM, lane, rep ? 0.0f : 1.0f);
                    }
                }
            }
        }
        if (!noop && step + 1 < 3 + NOPS * DEPTH) { if (RUN(ph) && RUN(ph + 1)) GSYNC(); }
#ifdef REP_MASK
        if ((((unsigned long long)(REP_MASK) >> (step - 3)) & 1ull) && rep == 0) { rep = 1; continue; }
        rep = 0;
#endif
        ++step; ++ph;
    }
#undef RUN
#undef SEAM
}

#ifndef MK_MULTI
#define MK_MULTI 0
#endif
extern "C" void kernel_launch(void* const* d_in, const int* in_sizes, int n_in, void* d_out, int out_size, void* d_ws, size_t ws_size, hipStream_t stream) {
    static int grid = 0;
    if (grid == 0) {
        if (n_in != 23 || ws_size < WS_END) { fprintf(stderr, "kernel_launch: unexpected n_in %d / ws_size %zu (need %zu)\n", n_in, ws_size, (size_t)WS_END); grid = -1; return; }
        int dev = 0, cus = 0, per_cu = 0;
        hipGetDevice(&dev); hipDeviceGetAttribute(&cus, hipDeviceAttributeMultiprocessorCount, dev);
        if (hipFuncSetAttribute((const void*)mega, hipFuncAttributeMaxDynamicSharedMemorySize, LDS_BYTES) != hipSuccess) { fprintf(stderr, "kernel_launch: hipFuncSetAttribute failed\n"); grid = -1; return; }
        if (hipOccupancyMaxActiveBlocksPerMultiprocessor(&per_cu, (const void*)mega, 512, LDS_BYTES) != hipSuccess || per_cu < 1) { fprintf(stderr, "kernel_launch: occupancy query says %d\n", per_cu); per_cu = 1; }
        (void)hipGetLastError();
        grid = cus * per_cu;
        fprintf(stderr, "kernel_launch: grid %d (cus %d x %d)\n", grid, cus, per_cu);
    }
    if (grid < 0) return;
    if (hipMemsetAsync((char*)d_ws + OFF_CTL, 0, CTL_BYTES, stream) != hipSuccess) { fprintf(stderr, "kernel_launch: memset failed\n"); return; }
    Args a{};
    for (int i = 0; i < 23; ++i) a.in[i] = (const float*)d_in[i];
    a.out = (float*)d_out; a.ws = (unsigned char*)d_ws;
#if MK_MULTI
    const int nph = 3 + 10 * DEPTH;
    for (int p = 0; p < nph; ++p) { a.ph_lo = p; a.ph_hi = p + 1; hipLaunchKernelGGL(mega, dim3(grid), dim3(512), LDS_BYTES, stream, a); }
#else
    a.ph_lo = 0; a.ph_hi = 1000;
    void* params[] = {&a};
    hipError_t e = hipLaunchCooperativeKernel((const void*)mega, dim3(grid), dim3(512), params, LDS_BYTES, stream);
    if (e != hipSuccess) fprintf(stderr, "kernel_launch: cooperative launch failed: %s (grid %d)\n", hipGetErrorString(e), grid);
#endif
}
```

```cpp
#ifndef XBF16
#define XBF16 1
#endif
#include <hip/hip_runtime.h>
#include <hip/hip_cooperative_groups.h>
#include <cstdio>
#include <cstdint>
namespace cg = cooperative_groups;
namespace pg8 {
#define PG8_LAS __attribute__((address_space(3)))
typedef unsigned short bf16_t;
typedef short bf16x8 __attribute__((ext_vector_type(8)));
typedef float f32x4 __attribute__((ext_vector_type(4)));
typedef unsigned u32x4 __attribute__((ext_vector_type(4)));
constexpr int BM = 256, BK = 64, HALF = 128, HTB = HALF * BK * 2  , STAGE_BYTES = 8 * HTB, NXCD = 8, WGM = 8;

__host__ __device__ __forceinline__ int lds_byte(int r, int c) { const int st = (r >> 4) * 2 + (c >> 5), rr = r & 15, cc = c & 31, ob = rr * 64 + cc * 2; return st * 1024 + (ob ^ (((ob >> 9) & 1) << 5)); }
__host__ __device__ __forceinline__ void stage_rc(int b, int& R, int& C) { const int st = b / 1024, sb = b % 1024, swz = sb ^ (((sb >> 9) & 1) << 5); R = (st >> 1) * 16 + swz / 64; C = (st & 1) * 32 + (swz % 64) / 2; }
__host__ __device__ __forceinline__ int perm32(int rho) { const int n = rho >> 4, i = rho & 15; return 8 * (i >> 2) + 4 * n + (i & 3); }

struct Unit { int pm, pn; };
struct Gemm { const bf16_t* A; const bf16_t* Bt; int M, N, K; };

struct StaticOrder {
    int nM, nN, nwg, G, c;
    __host__ __device__ void init(int M, int N, int G_, int c_) { nM = M / BM; nN = N / BM; nwg = nM * nN; G = G_; c = c_; }
    __host__ __device__ bool next(int i, Unit& u) const {
        const long L = (long)i * G + c; if (L >= nwg) return false;
        int wgid = (int)L; { const int q = nwg / NXCD, r = nwg % NXCD, xcd = wgid % NXCD, off = wgid / NXCD; wgid = (xcd < r ? xcd * (q + 1) : r * (q + 1) + (xcd - r) * q) + off; }
        const int nig = WGM * nN, gid = wgid / nig, fm = gid * WGM, gsz = (nM - fm) < WGM ? (nM - fm) : WGM;
        u.pm = fm + ((wgid % nig) % gsz); u.pn = (wgid % nig) / gsz; return true;
    }
    __device__ __forceinline__ void a_ready(const Unit&) const {}
    __device__ __forceinline__ void done(const Unit&) const {}
};

__device__ __forceinline__ unsigned cvt_pk_bf16(float lo, float hi) { unsigned r; asm volatile("v_cvt_pk_bf16_f32 %0, %1, %2" : "=v"(r) : "v"(lo), "v"(hi)); return r; }
typedef float f32x2 __attribute__((ext_vector_type(2)));
__device__ __forceinline__ f32x2 gelu_pk(f32x2 v) {
    const f32x2 av = __builtin_elementwise_abs(v), d = av * 0.2316418882f + 1.0f;
    f32x2 t; t.x = __builtin_amdgcn_rcpf(d.x); t.y = __builtin_amdgcn_rcpf(d.y);
    f32x2 q = t * 0.5307027145f + (-0.7265760135f); q = q * t + 0.7107068705f; q = q * t + (-0.142248368f); q = q * t + 0.127414796f; q = q * t;
    const f32x2 s = (v * v) * (-0.72134752044f);
    f32x2 e; e.x = __builtin_amdgcn_exp2f(s.x); e.y = __builtin_amdgcn_exp2f(s.y);
    const f32x2 m = v * (q * e), r = v - m;
    f32x2 o; o.x = v.x < 0.f ? m.x : r.x; o.y = v.y < 0.f ? m.y : r.y; return o;
}

#ifndef PG8_STMODE
#define PG8_STMODE 0
#endif
#if PG8_STMODE == 1
#define PG8_ST16(p, v) asm volatile("global_store_dwordx4 %0, %1, off sc1\n\ts_nop 1" :: "v"(p), "v"(v) : "memory")
#elif PG8_STMODE == 2
#define PG8_ST16(p, v) asm volatile("global_store_dwordx4 %0, %1, off nt\n\ts_nop 1" :: "v"(p), "v"(v) : "memory")
#elif PG8_STMODE == 4
#define PG8_ST16(p, v) asm volatile("global_store_dwordx4 %0, %1, off\n\ts_nop 1" :: "v"(p), "v"(v) : "memory")
#elif PG8_STMODE == 3
#define PG8_ST16(p, v) asm volatile("global_store_dwordx4 %0, %1, off sc0 sc1\n\ts_nop 1" :: "v"(p), "v"(v) : "memory")
#else
#define PG8_ST16(p, v) (*(u32x4*)(p) = (v))
#endif
template <int ACT  > struct EpiBf16 {
    static constexpr bool PERM = true, AFTER_DRAIN = false; static_assert(ACT == 0 || ACT == 1, "EpiBf16: ACT is 0 (none) or 1 (gelu_pk)");
    bf16_t* O; int ldc; const float* bias; int split_cols; size_t split_stride; float scale0; int skip; bf16_t* scratch;
    __device__ __forceinline__ void operator()(const f32x4 (&acc)[2][2][4][2], const Unit& u, int wr, int wc, int fr, int fq) const {
        if (skip == 1) return;
        const int row0 = u.pm * BM + wr * 64 + fr; int colt = u.pn * BM; bf16_t* base = O;
        float sc = 1.f; if (split_cols) { const int t = colt / split_cols; base += (size_t)t * split_stride; colt -= t * split_cols; if (t == 0) sc = scale0; }
        const int col0 = colt + wc * 32 + 8 * fq, bcol0 = u.pn * BM + wc * 32 + 8 * fq;
        f32x4 bv[2][2];
#pragma unroll
        for (int bj = 0; bj < 2; ++bj)
#pragma unroll
            for (int n = 0; n < 2; ++n) bv[bj][n] = bias ? *(const f32x4*)(bias + bcol0 + bj * HALF + 4 * n) : (f32x4){0.f, 0.f, 0.f, 0.f};
#pragma unroll
        for (int ai = 0; ai < 2; ++ai)
#pragma unroll
            for (int m = 0; m < 4; ++m) { bf16_t* rowp = base + (size_t)(row0 + ai * HALF + m * 16) * ldc + col0; int bjs = HALF;
                if (skip == 2) { rowp = scratch + ((size_t)((((u.pm * 8 + u.pn) & 1023) * 8 + wr * 4 + wc) * 16 + (ai * 4 + m) * 2)) * 512 + (fq * 16 + fr) * 8; bjs = 512; }
#pragma unroll
                for (int bj = 0; bj < 2; ++bj) { f32x4 v0 = acc[ai][bj][m][0] + bv[bj][0], v1 = acc[ai][bj][m][1] + bv[bj][1];
                    if (ACT == 1) { f32x2 a = gelu_pk((f32x2){v0[0], v0[1]}), b = gelu_pk((f32x2){v0[2], v0[3]}), c = gelu_pk((f32x2){v1[0], v1[1]}), d = gelu_pk((f32x2){v1[2], v1[3]});
                        v0 = (f32x4){a.x, a.y, b.x, b.y}; v1 = (f32x4){c.x, c.y, d.x, d.y}; }
                    v0 = v0 * sc; v1 = v1 * sc; u32x4 w; w.x = cvt_pk_bf16(v0[0], v0[1]); w.y = cvt_pk_bf16(v0[2], v0[3]); w.z = cvt_pk_bf16(v1[0], v1[1]); w.w = cvt_pk_bf16(v1[2], v1[3]);
                    PG8_ST16(rowp + bj * bjs, w); } }
    }
};
template <class Epi, class Sched, bool ALIGN_EPI = false, bool SP2 = false>
__device__ __forceinline__ void gemm_phase(PG8_LAS unsigned char* lds, const Gemm g, const Sched& S, const Epi& E) {
    int tid = threadIdx.x; asm volatile("" : "+v"(tid));
    const int wid = __builtin_amdgcn_readfirstlane(tid >> 6), lane = tid & 63, wr = wid >> 2, wc = wid & 3, fr = lane & 15, fq = lane >> 4;
    const int K = g.K, nt = K / BK;
    unsigned voffA[2], voffB[2];
#pragma unroll
    for (int i = 0; i < 2; ++i) { int R, C; stage_rc(tid * 16 + i * 8192, R, C); const int Rb = Epi::PERM ? ((R & ~31) + perm32(R & 31)) : R;
        voffA[i] = (unsigned)(R * K + C) * 2u; voffB[i] = (unsigned)(Rb * K + C) * 2u; }
    const size_t kstep = (size_t)(BK * 2);
    const size_t hstep = (size_t)HALF * K * 2;
    const size_t tstep = 2 * hstep;
    const unsigned ldsw = (unsigned)wid * 1024u;
    const int aoff = lds_byte(wr * 64 + fr, fq * 8), boff = lds_byte(wc * 32 + fr, fq * 8);
#define PG8_SA(b, h) (((b) * 2 + (h)) * HTB)
#define PG8_SB(b, h) ((4 + (b) * 2 + (h)) * HTB)
#define PG8_STAGE(bufoff, gbase, voff) do { _Pragma("unroll") for (int _i = 0; _i < 2; ++_i) \
        __builtin_amdgcn_global_load_lds((const unsigned*)((const char*)(gbase) + (voff)[_i]), (PG8_LAS unsigned*)(lds + (bufoff) + ldsw + _i * 8192), 16, 0, 0); } while (0)
#define PG8_LDA(dst, b, h) do { _Pragma("unroll") for (int m = 0; m < 4; ++m) _Pragma("unroll") for (int k = 0; k < 2; ++k) dst[m][k] = *(const PG8_LAS bf16x8*)(lds + PG8_SA(b, h) + aoff + m * 2048 + k * 1024); } while (0)
#define PG8_LDB(dst, b, h) do { _Pragma("unroll") for (int n = 0; n < 2; ++n) _Pragma("unroll") for (int k = 0; k < 2; ++k) dst[n][k] = *(const PG8_LAS bf16x8*)(lds + PG8_SB(b, h) + boff + n * 2048 + k * 1024); } while (0)
#define PG8_MMA(ai, bj, At, Bt) do { __builtin_amdgcn_s_setprio(1); _Pragma("unroll") for (int m = 0; m < 4; ++m) _Pragma("unroll") for (int n = 0; n < 2; ++n) _Pragma("unroll") for (int k = 0; k < 2; ++k) \
        acc[ai][bj][m][n] = __builtin_amdgcn_mfma_f32_16x16x32_bf16(Bt[n][k], At[m][k], acc[ai][bj][m][n], 0, 0, 0); __builtin_amdgcn_s_setprio(0); } while (0)
#define PG8_WAIT_V(n) asm volatile("s_waitcnt vmcnt(" #n ")" ::: "memory")
#define PG8_WAIT_L(n) asm volatile("s_waitcnt lgkmcnt(" #n ")" ::: "memory")
#define PG8_BAR __builtin_amdgcn_s_barrier()
#define PG8_SCHED __builtin_amdgcn_sched_barrier(0)
    Unit cur, nxt; int ui = 0;
    if (!S.next(0, cur)) return;
    f32x4 acc[2][2][4][2];
#pragma unroll
    for (int a = 0; a < 2; ++a)
#pragma unroll
        for (int b = 0; b < 2; ++b)
#pragma unroll
            for (int m = 0; m < 4; ++m)
#pragma unroll
                for (int n = 0; n < 2; ++n) acc[a][b][m][n] = (f32x4){0.f, 0.f, 0.f, 0.f};
    bf16x8 At[4][2], B0[2][2], B1[2][2];
    const char* cA = (const char*)g.A + (size_t)cur.pm * tstep; const char* cB = (const char*)g.Bt + (size_t)cur.pn * tstep;
    S.a_ready(cur);
    if constexpr (SP2) {
        PG8_STAGE(PG8_SB(0, 0), cB, voffB); PG8_STAGE(PG8_SB(0, 1), cB + hstep, voffB); PG8_STAGE(PG8_SA(0, 0), cA, voffA); PG8_STAGE(PG8_SA(0, 1), cA + hstep, voffA);
        if (wr == 1) PG8_BAR;
        PG8_WAIT_V(2); PG8_BAR;
        PG8_STAGE(PG8_SB(1, 0), cB + kstep, voffB); PG8_STAGE(PG8_SA(1, 0), cA + kstep, voffA); PG8_STAGE(PG8_SB(1, 1), cB + hstep + kstep, voffB);
        PG8_WAIT_V(6); PG8_BAR;
    } else {
        PG8_STAGE(PG8_SB(0, 0), cB, voffB); PG8_STAGE(PG8_SA(0, 0), cA, voffA); PG8_STAGE(PG8_SB(0, 1), cB + hstep, voffB); PG8_STAGE(PG8_SA(0, 1), cA + hstep, voffA);
        if (wr == 1) PG8_BAR;
        PG8_WAIT_V(4); PG8_BAR;
        PG8_STAGE(PG8_SB(1, 0), cB + kstep, voffB); PG8_STAGE(PG8_SA(1, 0), cA + kstep, voffA); PG8_STAGE(PG8_SB(1, 1), cB + hstep + kstep, voffB);
        PG8_WAIT_V(6); PG8_BAR;
    }
    for (;;) {
        const bool has_next = S.next(ui + 1, nxt);
        const char* nA = has_next ? (const char*)g.A + (size_t)nxt.pm * tstep : cA; const char* nB = has_next ? (const char*)g.Bt + (size_t)nxt.pn * tstep : cB;
        for (int t = 0; t < nt; t += 2) {
            const bool last = (t == nt - 2);
            const char* a1 = cA + (size_t)(t + 1) * kstep;
            const char* a2 = last ? nA : cA + (size_t)(t + 2) * kstep; const char* b2 = last ? nB : cB + (size_t)(t + 2) * kstep;
            const char* a3 = a2 + kstep; const char* b3 = b2 + kstep;
            if (last && has_next) S.a_ready(nxt);
            if constexpr (SP2) {
            PG8_LDB(B0, 0, 0); PG8_LDB(B1, 0, 1); PG8_SCHED; PG8_LDA(At, 0, 0); PG8_STAGE(PG8_SA(1, 1), a1 + hstep, voffA);
            PG8_WAIT_V(8); PG8_WAIT_L(0); PG8_BAR; PG8_MMA(0, 0, At, B0); PG8_MMA(0, 1, At, B1); PG8_BAR; PG8_SCHED;
            PG8_LDA(At, 0, 1); PG8_STAGE(PG8_SB(0, 0), b2, voffB); PG8_STAGE(PG8_SB(0, 1), b2 + hstep, voffB); PG8_STAGE(PG8_SA(0, 0), a2, voffA);
            PG8_WAIT_V(8); PG8_WAIT_L(0); PG8_BAR; PG8_MMA(1, 0, At, B0); PG8_MMA(1, 1, At, B1); PG8_BAR; PG8_SCHED;
            PG8_LDB(B0, 1, 0); PG8_LDB(B1, 1, 1); PG8_SCHED; PG8_LDA(At, 1, 0); PG8_STAGE(PG8_SA(0, 1), a2 + hstep, voffA);
            PG8_WAIT_V(8); PG8_WAIT_L(0); PG8_BAR; PG8_MMA(0, 0, At, B0); PG8_MMA(0, 1, At, B1); PG8_BAR; PG8_SCHED;
            PG8_LDA(At, 1, 1); PG8_STAGE(PG8_SB(1, 0), b3, voffB); PG8_STAGE(PG8_SB(1, 1), b3 + hstep, voffB); PG8_STAGE(PG8_SA(1, 0), a3, voffA);
            PG8_WAIT_V(8); PG8_WAIT_L(0); PG8_BAR; PG8_MMA(1, 0, At, B0); PG8_MMA(1, 1, At, B1); PG8_BAR; PG8_SCHED;
            } else {
            PG8_LDB(B0, 0, 0); PG8_SCHED; PG8_LDA(At, 0, 0); PG8_STAGE(PG8_SA(1, 1), a1 + hstep, voffA);
            PG8_WAIT_L(8); PG8_BAR; PG8_WAIT_L(0); PG8_MMA(0, 0, At, B0); PG8_BAR; PG8_SCHED;
            PG8_LDB(B1, 0, 1); PG8_STAGE(PG8_SB(0, 0), b2, voffB);
            PG8_BAR; PG8_WAIT_L(0); PG8_MMA(0, 1, At, B1); PG8_BAR;
            PG8_LDA(At, 0, 1); PG8_STAGE(PG8_SA(0, 0), a2, voffA);
            PG8_BAR; PG8_WAIT_L(0); PG8_MMA(1, 0, At, B0); PG8_BAR; PG8_SCHED;
            PG8_STAGE(PG8_SB(0, 1), b2 + hstep, voffB);
            PG8_WAIT_V(6); PG8_BAR; PG8_MMA(1, 1, At, B1); PG8_BAR;
            PG8_LDB(B0, 1, 0); PG8_SCHED; PG8_LDA(At, 1, 0); PG8_STAGE(PG8_SA(0, 1), a2 + hstep, voffA);
            PG8_WAIT_L(8); PG8_BAR; PG8_WAIT_L(0); PG8_MMA(0, 0, At, B0); PG8_BAR; PG8_SCHED;
            PG8_LDB(B1, 1, 1); PG8_STAGE(PG8_SB(1, 0), b3, voffB);
            PG8_BAR; PG8_WAIT_L(0); PG8_MMA(0, 1, At, B1); PG8_BAR;
            PG8_LDA(At, 1, 1); PG8_STAGE(PG8_SA(1, 0), a3, voffA);
            PG8_BAR; PG8_WAIT_L(0); PG8_MMA(1, 0, At, B0); PG8_BAR; PG8_SCHED;
            PG8_STAGE(PG8_SB(1, 1), b3 + hstep, voffB);
            PG8_WAIT_V(6); PG8_BAR; PG8_MMA(1, 1, At, B1); PG8_BAR;
            }
        }
        if constexpr (ALIGN_EPI) { if (wr == 0) PG8_BAR; }
        if constexpr (!Epi::AFTER_DRAIN) { E(acc, cur, wr, wc, fr, fq); S.done(cur); }
        if (!has_next) break;
#pragma unroll
        for (int a = 0; a < 2; ++a)
#pragma unroll
            for (int b = 0; b < 2; ++b)
#pragma unroll
                for (int m = 0; m < 4; ++m)
#pragma unroll
                    for (int n = 0; n < 2; ++n) acc[a][b][m][n] = (f32x4){0.f, 0.f, 0.f, 0.f};
        cur = nxt; cA = nA; cB = nB; ++ui;
        if constexpr (ALIGN_EPI) { if (wr == 1) PG8_BAR; }
    }
    PG8_WAIT_V(0);
    if constexpr (!ALIGN_EPI) { if (wr == 0) PG8_BAR; }
    PG8_BAR;
    if constexpr (Epi::AFTER_DRAIN) { E.fused(acc, cur, wr, wc, fr, fq, lds, wid, lane); S.done(cur); }
#undef PG8_SA
#undef PG8_SB
#undef PG8_STAGE
#undef PG8_LDA
#undef PG8_LDB
#undef PG8_MMA
#undef PG8_WAIT_V
#undef PG8_WAIT_L
#undef PG8_BAR
#undef PG8_SCHED
}
}
namespace pg8 {
struct EpiSwiglu {
    static constexpr bool PERM = true, AFTER_DRAIN = false;
    bf16_t* O; int ldc;
    __device__ __forceinline__ void operator()(const f32x4 (&acc)[2][2][4][2], const Unit& u, int wr, int wc, int fr, int fq) const {
        const int row0 = u.pm * BM + wr * 64 + fr; const int col0 = u.pn * HALF + wc * 32 + 8 * fq;
#pragma unroll
        for (int ai = 0; ai < 2; ++ai)
#pragma unroll
            for (int m = 0; m < 4; ++m) { bf16_t* rowp = O + (size_t)(row0 + ai * HALF + m * 16) * ldc + col0;
                float o[8];
#pragma unroll
                for (int n = 0; n < 2; ++n)
#pragma unroll
                    for (int e = 0; e < 4; ++e) { const float g = acc[ai][0][m][n][e], up = acc[ai][1][m][n][e];
                        o[n * 4 + e] = g * __builtin_amdgcn_rcpf(1.0f + __expf(-g)) * up; }
                u32x4 w; w.x = cvt_pk_bf16(o[0], o[1]); w.y = cvt_pk_bf16(o[2], o[3]); w.z = cvt_pk_bf16(o[4], o[5]); w.w = cvt_pk_bf16(o[6], o[7]);
                PG8_ST16(rowp, w); }
    }
};
}

constexpr int DM = 1024, NBATCH = 32, SEQ = 2048, CTXL = 256, MLAT = NBATCH * SEQ, MCTX = NBATCH * CTXL, MTOT = MLAT + MCTX, FFH = 2816, DEPTH = 4;
constexpr int NMODROW = 33, MODW = 6 * DM;
constexpr int LDS_BYTES = 147456;
constexpr size_t MiB = 1u << 20;
constexpr size_t OFF_MODP = 0;
constexpr size_t OFF_MODS = 26 * MiB;
constexpr size_t OFF_ROPE = 30 * MiB;
constexpr size_t OFF_WS = 32 * MiB;
constexpr size_t OFF_W = 33 * MiB;
constexpr size_t W_FI = 0, W_FO = 44 * MiB, W_AQ = 66 * MiB, W_AO = 72 * MiB, W_BI = 76 * MiB, W_BO = 80 * MiB, W_CQ = 82 * MiB, W_CO = 86 * MiB;
constexpr size_t OFF_XC = 121 * MiB;
constexpr size_t OFF_H = 153 * MiB;
constexpr size_t OFF_Y = 297 * MiB;
constexpr size_t OFF_BIG = 441 * MiB;
constexpr size_t OFF_O = OFF_BIG + 288 * MiB;
constexpr size_t OFF_CTL = OFF_BIG + 432 * MiB;
constexpr size_t CTL_BYTES = 65536;
constexpr size_t OFF_XLB = OFF_CTL + 1 * MiB;
constexpr size_t WS_END = OFF_XLB + 128 * MiB;
constexpr int LDS_XB = LDS_BYTES - 64;

typedef unsigned short bf16;
typedef short bf16x8 __attribute__((ext_vector_type(8)));
typedef short s16x4 __attribute__((ext_vector_type(4)));
typedef float f32x16 __attribute__((ext_vector_type(16)));
typedef float f32x4 __attribute__((ext_vector_type(4)));
typedef float f32x2 __attribute__((ext_vector_type(2)));
typedef unsigned u32x4 __attribute__((ext_vector_type(4)));
typedef unsigned u32x2 __attribute__((ext_vector_type(2)));
#define LAS __attribute__((address_space(3)))

__device__ __forceinline__ unsigned cvtpk(float lo, float hi) { unsigned r; asm volatile("v_cvt_pk_bf16_f32 %0, %1, %2" : "=v"(r) : "v"(lo), "v"(hi)); return r; }
__device__ __forceinline__ float bf2f(short s) { return __uint_as_float(((unsigned)(unsigned short)s) << 16); }
__device__ __forceinline__ float bflo(unsigned w) { return __uint_as_float(w << 16); }
__device__ __forceinline__ float bfhi(unsigned w) { return __uint_as_float(w & 0xffff0000u); }
__device__ __forceinline__ float wave_sum(float v) {
#pragma unroll
    for (int o = 1; o < 64; o <<= 1) v += __shfl_xor(v, o);
    return v;
}

namespace att {
#define SBAR() __builtin_amdgcn_sched_barrier(0)
__device__ __forceinline__ int crow(int r, int hi) { return (r & 3) + 8 * (r >> 2) + 4 * hi; }
template <int DH> __device__ __forceinline__ int kswz(int row, int colB) { return row * (DH * 2) + (colB ^ ((row & 7) << 4)); }
template <int DH> __device__ __forceinline__ int v_st(int k, int c) { const int kk = (k & ~0xC) | ((k & 4) << 1) | ((k & 8) >> 1); return ((kk >> 3) * (DH / 32) + (c >> 5)) * 512 + ((kk & 7) * 32 + (c & 31)) * 2; }
__device__ __forceinline__ int v_rd_base(int lane) { return ((lane & 3) << 3) | (((lane >> 2) & 3) << 6) | (((lane >> 4) & 1) << 5) | (((lane >> 5) & 1) << 8); }
template <int DH> constexpr int v_rd_off(int d0, int ks, int half) { return d0 * 512 + ks * (DH / 32) * 1024 + half * (DH / 32) * 512; }
template <int OFF> __device__ __forceinline__ s16x4 tr_read(int vb) { s16x4 r; asm volatile("ds_read_b64_tr_b16 %0, %1 offset:%2" : "=&v"(r) : "v"(vb), "i"(OFF) : "memory"); return r; }
template <int DH, int D0> __device__ __forceinline__ void pv_one(f32x16& od, int vb, bf16x8 pa0, bf16x8 pa1, bf16x8 pa2, bf16x8 pa3) {
  const s16x4 l0 = tr_read<v_rd_off<DH>(D0, 0, 0)>(vb), h0 = tr_read<v_rd_off<DH>(D0, 0, 1)>(vb), l1 = tr_read<v_rd_off<DH>(D0, 1, 0)>(vb), h1 = tr_read<v_rd_off<DH>(D0, 1, 1)>(vb);
  const s16x4 l2 = tr_read<v_rd_off<DH>(D0, 2, 0)>(vb), h2 = tr_read<v_rd_off<DH>(D0, 2, 1)>(vb), l3 = tr_read<v_rd_off<DH>(D0, 3, 0)>(vb), h3 = tr_read<v_rd_off<DH>(D0, 3, 1)>(vb);
  asm volatile("s_waitcnt lgkmcnt(0)" ::: "memory"); SBAR();
#define PK(L, H) (bf16x8){L[0], L[1], L[2], L[3], H[0], H[1], H[2], H[3]}
  od = __builtin_amdgcn_mfma_f32_32x32x16_bf16(pa0, PK(l0, h0), od, 0, 0, 0);
  od = __builtin_amdgcn_mfma_f32_32x32x16_bf16(pa1, PK(l1, h1), od, 0, 0, 0);
  od = __builtin_amdgcn_mfma_f32_32x32x16_bf16(pa2, PK(l2, h2), od, 0, 0, 0);
  od = __builtin_amdgcn_mfma_f32_32x32x16_bf16(pa3, PK(l3, h3), od, 0, 0, 0);
#undef PK
}
template <int DH> __device__ __forceinline__ void pv_all(f32x16* o, int vb, bf16x8 pa0, bf16x8 pa1, bf16x8 pa2, bf16x8 pa3) {
  pv_one<DH, 0>(o[0], vb, pa0, pa1, pa2, pa3); pv_one<DH, 1>(o[1], vb, pa0, pa1, pa2, pa3);
  if constexpr (DH == 128) { pv_one<DH, 2>(o[2], vb, pa0, pa1, pa2, pa3); pv_one<DH, 3>(o[3], vb, pa0, pa1, pa2, pa3); }
}
template <int DH> struct SC { static constexpr float SCALE = DH == 128 ? 0.088388347648318440f : 0.125f; static constexpr float C = SCALE * 1.4426950408889634f; static constexpr float THRS = 8.f / SCALE; };
template <int DH> __device__ __forceinline__ void partialSM(f32x16& p0, f32x16& p1, float& m_reg, float& mn, float& alpha) {
  constexpr float C = SC<DH>::C;
  float pmax = p0[0];
#pragma unroll
  for (int r = 1; r < 16; ++r) pmax = fmaxf(pmax, p0[r]);
#pragma unroll
  for (int r = 0; r < 16; ++r) pmax = fmaxf(pmax, p1[r]);
  { auto rr = __builtin_amdgcn_permlane32_swap(__float_as_uint(pmax), __float_as_uint(pmax), false, false);
    pmax = fmaxf(__uint_as_float(rr[0]), __uint_as_float(rr[1])); }
  if (__builtin_expect(__all(pmax - m_reg <= SC<DH>::THRS), 1)) { mn = m_reg; alpha = 1.f; }
  else { mn = fmaxf(m_reg, pmax); alpha = __builtin_amdgcn_exp2f((m_reg - mn) * C); m_reg = mn; }
  const float mnC = -mn * C;
#pragma unroll
  for (int r = 0; r < 16; ++r) p0[r] = fmaf(p0[r], C, mnC);
#pragma unroll
  for (int r = 0; r < 16; ++r) p1[r] = fmaf(p1[r], C, mnC);
#pragma unroll
  for (int r = 0; r < 16; ++r) p0[r] = __builtin_amdgcn_exp2f(p0[r]);
}
__device__ __forceinline__ void finishSM(f32x16& p0, f32x16& p1, float alpha, float& l_reg, bf16x8& pa0, bf16x8& pa1, bf16x8& pa2, bf16x8& pa3) {
#pragma unroll
  for (int r = 0; r < 16; ++r) p1[r] = __builtin_amdgcn_exp2f(p1[r]);
  float ps = 0;
#pragma unroll
  for (int r = 0; r < 16; ++r) ps += p0[r];
#pragma unroll
  for (int r = 0; r < 16; ++r) ps += p1[r];
  { auto rr = __builtin_amdgcn_permlane32_swap(__float_as_uint(ps), __float_as_uint(ps), false, false);
    ps = __uint_as_float(rr[0]) + __uint_as_float(rr[1]); }
  l_reg = l_reg * alpha + ps;
#define PK4(P, BASE, OUT) do { unsigned a0 = cvtpk(P[BASE + 0], P[BASE + 1]), a1 = cvtpk(P[BASE + 2], P[BASE + 3]);   \
    unsigned b0 = cvtpk(P[BASE + 4], P[BASE + 5]), b1 = cvtpk(P[BASE + 6], P[BASE + 7]);                              \
    auto r0 = __builtin_amdgcn_permlane32_swap(a0, b0, false, false); auto r1 = __builtin_amdgcn_permlane32_swap(a1, b1, false, false); \
    u32x4 w = {r0[0], r1[0], r0[1], r1[1]}; OUT = *reinterpret_cast<bf16x8*>(&w); } while (0)
  PK4(p0, 0, pa0); PK4(p0, 8, pa1); PK4(p1, 0, pa2); PK4(p1, 8, pa3);
#undef PK4
}
template <int DH> __device__ __forceinline__ void qkt(f32x16& p0, f32x16& p1, const char* Ks, const bf16x8* qr, int r32, int hi) {
  p0 = f32x16{}; p1 = f32x16{};
#pragma unroll
  for (int d0 = 0; d0 < DH / 16; ++d0) { const int cb = (d0 * 16 + hi * 8) * 2;
    const bf16x8 b0 = *reinterpret_cast<const bf16x8*>(Ks + kswz<DH>(r32, cb));
    const bf16x8 b1 = *reinterpret_cast<const bf16x8*>(Ks + kswz<DH>(32 + r32, cb));
    p0 = __builtin_amdgcn_mfma_f32_32x32x16_bf16(b0, qr[d0], p0, 0, 0, 0);
    p1 = __builtin_amdgcn_mfma_f32_32x32x16_bf16(b1, qr[d0], p1, 0, 0, 0); }
}
__device__ __forceinline__ void wmask(f32x16& p0, f32x16& p1, int kp0, int qp, int hi) {
  const int d0 = kp0 + 4 * hi - qp;
#pragma unroll
  for (int r = 0; r < 16; ++r) { const int d = d0 + (r & 3) + 8 * (r >> 2); if (d > 128 || d < -128) p0[r] = -1e30f; if (d + 32 > 128 || d + 32 < -128) p1[r] = -1e30f; }
}
struct UnitDesc {
  const bf16* Q; const bf16* Kc; const bf16* Vc; bf16* O;
  long ctx_row0, lat_row0; int nctx, band_kp0, NT, qpos0;
  const float* cosT; const float* sinT; const float* qg; float sink_l2;
};
template <int DH, int PITCH, bool QKNORM, bool MASK>
__device__ __forceinline__ void attn_unit(const UnitDesc& u, char* lds) {
  constexpr int NB = DH / 16, NO = DH / 32, TB = 64 * DH * 2, NLD = DH / 64, SDEPTH = DH == 128 ? 1 : 2;
  int tid = threadIdx.x; asm volatile("" : "+v"(tid));
  const int wid = tid >> 6, lane = tid & 63, r32 = lane & 31, hi = lane >> 5;
  char* V_lds = lds; char* K_lds = lds + 2 * TB;
  float* ws = (float*)(lds + 4 * TB) + wid * 64; float* li_l = ws; float* al_l = ws + 32;
  float m_reg = -1e30f, l_reg = 0; f32x16 o[NO];
#pragma unroll
  for (int d = 0; d < NO; ++d) o[d] = f32x16{};
  bf16x8 qr[NB];
  {
    const bf16* Qw = u.Q + (long)(wid * 32 + r32) * PITCH + hi * 8;
    float qf[NB][8];
#pragma unroll
    for (int d0 = 0; d0 < NB; ++d0) { const bf16x8 raw = *reinterpret_cast<const bf16x8*>(Qw + d0 * 16);
#pragma unroll
      for (int j = 0; j < 8; ++j) qf[d0][j] = bf2f(raw[j]); }
    if constexpr (QKNORM) {
      float ss = 0.f;
#pragma unroll
      for (int d0 = 0; d0 < NB; ++d0)
#pragma unroll
        for (int j = 0; j < 8; ++j) ss += qf[d0][j] * qf[d0][j];
      ss += __shfl_xor(ss, 32);
      const float rstd = rsqrtf(ss * (1.0f / DH) + 1e-6f);
#pragma unroll
      for (int d0 = 0; d0 < NB; ++d0) { const f32x4 g0 = *(const f32x4*)(u.qg + d0 * 16 + hi * 8), g1 = *(const f32x4*)(u.qg + d0 * 16 + hi * 8 + 4);
#pragma unroll
        for (int j = 0; j < 4; ++j) { qf[d0][j] *= rstd * g0[j]; qf[d0][4 + j] *= rstd * g1[j]; } }
    }
    if (u.qpos0 >= 0) {
      const int pos = u.qpos0 + wid * 32 + r32;
      const float* cp = u.cosT + (long)pos * (DH / 2) + hi * 8; const float* sp = u.sinT + (long)pos * (DH / 2) + hi * 8;
#pragma unroll
      for (int d0 = 0; d0 < NB / 2; ++d0) {
        const f32x4 c0 = *(const f32x4*)(cp + d0 * 16), c1 = *(const f32x4*)(cp + d0 * 16 + 4), s0 = *(const f32x4*)(sp + d0 * 16), s1 = *(const f32x4*)(sp + d0 * 16 + 4);
#pragma unroll
        for (int j = 0; j < 8; ++j) { const float c = j < 4 ? c0[j & 3] : c1[j & 3], s = j < 4 ? s0[j & 3] : s1[j & 3];
          const float x1 = qf[d0][j], x2 = qf[d0 + NB / 2][j]; qf[d0][j] = x1 * c - x2 * s; qf[d0 + NB / 2][j] = x2 * c + x1 * s; }
      }
    }
#pragma unroll
    for (int d0 = 0; d0 < NB; ++d0) { u32x4 w = {cvtpk(qf[d0][0], qf[d0][1]), cvtpk(qf[d0][2], qf[d0][3]), cvtpk(qf[d0][4], qf[d0][5]), cvtpk(qf[d0][6], qf[d0][7])}; qr[d0] = *reinterpret_cast<bf16x8*>(&w); }
  }
  const int sr = DH == 128 ? (tid >> 4) : (tid >> 3), sc = DH == 128 ? (tid & 15) * 8 : (tid & 7) * 8;
  const int vb0 = (int)(uintptr_t)V_lds + v_rd_base(lane);
  struct { bf16x8 v[NLD], k[NLD]; } st_[SDEPTH];
  const int qp = u.qpos0 + wid * 32 + r32;
#define TROW(t) ((t) < u.nctx ? u.ctx_row0 + 64 * (t) : u.lat_row0 + u.band_kp0 + 64 * ((t) - u.nctx))
#define TKP(t) (u.band_kp0 + 64 * ((t) - u.nctx))
#define SLOAD(i, t) do { const long row_ = TROW(t); _Pragma("unroll") for (int l_ = 0; l_ < NLD; ++l_) { \
    st_[i].v[l_] = *reinterpret_cast<const bf16x8*>(u.Vc + (row_ + sr + 32 * l_) * PITCH + sc); st_[i].k[l_] = *reinterpret_cast<const bf16x8*>(u.Kc + (row_ + sr + 32 * l_) * PITCH + sc); } } while (0)
#define SWRITE(b, i) do { _Pragma("unroll") for (int l_ = 0; l_ < NLD; ++l_) { *(bf16x8*)(V_lds + (b) * TB + v_st<DH>(sr + 32 * l_, sc)) = st_[i].v[l_]; \
    *(bf16x8*)(K_lds + (b) * TB + kswz<DH>(sr + 32 * l_, sc * 2)) = st_[i].k[l_]; } } while (0)
#define SWAIT() do { if constexpr (SDEPTH == 1) asm volatile("s_waitcnt vmcnt(0)" ::: "memory"); else if constexpr (NLD == 2) asm volatile("s_waitcnt vmcnt(4)" ::: "memory"); else asm volatile("s_waitcnt vmcnt(2)" ::: "memory"); } while (0)
#define RESC(a) do { if (__any((a) < 1.f)) { if (hi == 0) al_l[r32] = (a); asm volatile("s_waitcnt lgkmcnt(0)" ::: "memory"); \
    _Pragma("unroll") for (int d = 0; d < NO; ++d) _Pragma("unroll") for (int r = 0; r < 16; ++r) o[d][r] *= al_l[crow(r, hi)]; } } while (0)
#define AMASK(P0, P1, t) do { if constexpr (MASK) { if ((t) >= u.nctx && (TKP(t) < qw - 97 || TKP(t) + 63 > qw + 128)) wmask(P0, P1, TKP(t), qp, hi); } } while (0)
  f32x16 pA0, pA1, pB0, pB1; float mnA, mnB, alA, alB; bf16x8 pa0, pa1, pa2, pa3; const int NT = u.NT;
  constexpr int SE = 0, SO = SDEPTH - 1;
  const int qw = __builtin_amdgcn_readfirstlane(u.qpos0 + wid * 32);
#define ACT(t) (!MASK || (t) < u.nctx || (TKP(t) <= qw + 159 && TKP(t) + 63 >= qw - 128))
  bool actA = true, actB = true;
  SLOAD(SE, 0); asm volatile("s_waitcnt vmcnt(0)" ::: "memory"); SWRITE(0, SE); __syncthreads();
  qkt<DH>(pA0, pA1, K_lds, qr, r32, hi); AMASK(pA0, pA1, 0); partialSM<DH>(pA0, pA1, m_reg, mnA, alA);
  SLOAD(SO, 1); if constexpr (SDEPTH == 2) { if (2 < NT) SLOAD(SE, 2); }
  SWAIT(); SWRITE(1, SO); __syncthreads();
  for (int j = 1; j + 1 < NT; j += 2) {
    actB = ACT(j);
    SBAR(); if (actB) { qkt<DH>(pB0, pB1, K_lds + TB, qr, r32, hi); AMASK(pB0, pB1, j); }
    if (actA) finishSM(pA0, pA1, alA, l_reg, pa0, pa1, pa2, pa3); SBAR();
    SLOAD(SO, j + SDEPTH); SBAR();
    if (actA) pv_all<DH>(o, vb0, pa0, pa1, pa2, pa3);
    if (actB) partialSM<DH>(pB0, pB1, m_reg, mnB, alB); else alB = 1.f;
    __syncthreads(); SWAIT(); SWRITE(0, SE);
    RESC(alB); __syncthreads();
    actA = ACT(j + 1);
    SBAR(); if (actA) { qkt<DH>(pA0, pA1, K_lds, qr, r32, hi); AMASK(pA0, pA1, j + 1); }
    if (actB) finishSM(pB0, pB1, alB, l_reg, pa0, pa1, pa2, pa3); SBAR();
    if (SDEPTH == 1 || j + 3 < NT) SLOAD(SE, j + 1 + SDEPTH); SBAR();
    if (actB) pv_all<DH>(o, vb0 + TB, pa0, pa1, pa2, pa3);
    if (actA) partialSM<DH>(pA0, pA1, m_reg, mnA, alA); else alA = 1.f;
    __syncthreads(); SWAIT(); SWRITE(1, SO);
    RESC(alA); __syncthreads();
  }
  actB = ACT(NT - 1);
  SBAR(); if (actB) { qkt<DH>(pB0, pB1, K_lds + TB, qr, r32, hi); AMASK(pB0, pB1, NT - 1); }
  if (actA) finishSM(pA0, pA1, alA, l_reg, pa0, pa1, pa2, pa3); SBAR();
  if (actA) pv_all<DH>(o, vb0, pa0, pa1, pa2, pa3);
  if (actB) partialSM<DH>(pB0, pB1, m_reg, mnB, alB); else alB = 1.f;
  __syncthreads(); RESC(alB);
  if (actB) { finishSM(pB0, pB1, alB, l_reg, pa0, pa1, pa2, pa3); SBAR();
    pv_all<DH>(o, vb0 + TB, pa0, pa1, pa2, pa3); }
#undef ACT
  l_reg += __builtin_amdgcn_exp2f(u.sink_l2 - m_reg * SC<DH>::C);
  if (hi == 0) li_l[r32] = l_reg; asm volatile("s_waitcnt lgkmcnt(0)" ::: "memory");
  float rli[16];
#pragma unroll
  for (int r = 0; r < 16; ++r) rli[r] = __builtin_amdgcn_rcpf(li_l[crow(r, hi)]);
  { bf16* stg = (bf16*)(lds + 4 * TB + 2048) + wid * (32 * DH);
#pragma unroll
    for (int r = 0; r < 16; ++r) { const int orow = crow(r, hi);
#pragma unroll
      for (int d0 = 0; d0 < NO; ++d0) { const float v = o[d0][r] * rli[r]; const unsigned w = cvtpk(v, v); stg[orow * DH + d0 * 32 + r32] = (bf16)(w & 0xffffu); } }
    asm volatile("s_waitcnt lgkmcnt(0)" ::: "memory");
    constexpr int CPR = DH / 8, RPI = 64 / CPR;
    bf16* Ow = u.O + (long)(wid * 32) * DM;
#pragma unroll
    for (int i = 0; i < 32 / RPI; ++i) { const int row = i * RPI + lane / CPR, ch = lane % CPR; const u32x4 v = *(const u32x4*)(stg + row * DH + ch * 8); *(u32x4*)(Ow + (long)row * DM + ch * 8) = v; } }
  __syncthreads();
#undef TROW
#undef TKP
#undef SLOAD
#undef SWRITE
#undef SWAIT
#undef RESC
#undef AMASK
}
}

__device__ __forceinline__ void transpose_item(const float* W, int K, int N, bf16* WT, int k0, int n0, int drow0, LAS float* scr, int lane) {
    float tv[32];
#pragma unroll
    for (int i = 0; i < 32; ++i) tv[i] = W[(size_t)(k0 + 2 * i + (lane >> 5)) * N + n0 + (lane & 31)];
#pragma unroll
    for (int i = 0; i < 32; ++i) scr[(2 * i + (lane >> 5)) * 33 + (lane & 31)] = tv[i];
    asm volatile("s_waitcnt lgkmcnt(0)" ::: "memory");
    const int c = lane & 7;
#pragma unroll
    for (int j = 0; j < 4; ++j) { const int n = (lane >> 3) + 8 * j; const LAS float* s = scr + (8 * c) * 33 + n;
        u32x4 o; o.x = cvtpk(s[0 * 33], s[1 * 33]); o.y = cvtpk(s[2 * 33], s[3 * 33]); o.z = cvtpk(s[4 * 33], s[5 * 33]); o.w = cvtpk(s[6 * 33], s[7 * 33]);
        *(u32x4*)(WT + (size_t)(drow0 + n) * K + k0 + 8 * c) = o; }
    asm volatile("s_waitcnt lgkmcnt(0)" ::: "memory");
}
__device__ __forceinline__ int ffn_in_row(int n0) { return n0 < FFH ? 256 * (n0 >> 7) + (n0 & 127) : 256 * ((n0 - FFH) >> 7) + 128 + ((n0 - FFH) & 127); }

struct RowJob { const float* xin; const bf16* y; float* xout; bf16* h; const float* gate; const float* sh; const float* sc; };
template <int NR, bool HASY, bool HASH>
__device__ __forceinline__ void combine_rows(const RowJob (&J)[NR], const float* npost, const float* npre, int lane, float gmul) {
    f32x4 xv[NR][4]; u32x2 yv[NR][4];
#pragma unroll
    for (int q = 0; q < NR; ++q)
#pragma unroll
        for (int j = 0; j < 4; ++j) { xv[q][j] = ((const f32x4*)J[q].xin)[lane + 64 * j]; if constexpr (HASY) yv[q][j] = ((const u32x2*)J[q].y)[lane + 64 * j]; }
    if constexpr (HASY) {
        float rstd[NR];
#pragma unroll
        for (int q = 0; q < NR; ++q) { float ss = 0.f;
#pragma unroll
            for (int j = 0; j < 4; ++j) { const float a = bflo(yv[q][j].x), b = bfhi(yv[q][j].x), c = bflo(yv[q][j].y), d = bfhi(yv[q][j].y); ss += (a * a + b * b) + (c * c + d * d); }
            rstd[q] = rsqrtf(wave_sum(ss) * (1.0f / DM) + 1e-6f) * gmul; }
#pragma unroll
        for (int j = 0; j < 4; ++j) { const f32x4 n4 = ((const f32x4*)npost)[lane + 64 * j];
#pragma unroll
            for (int q = 0; q < NR; ++q) { const f32x4 g4 = ((const f32x4*)J[q].gate)[lane + 64 * j];
                const f32x4 yf = {bflo(yv[q][j].x), bfhi(yv[q][j].x), bflo(yv[q][j].y), bfhi(yv[q][j].y)};
                xv[q][j] = xv[q][j] + g4 * (yf * rstd[q] * n4);
                ((f32x4*)J[q].xout)[lane + 64 * j] = xv[q][j]; } }
    }
    if constexpr (HASH) {
        float rstd[NR];
#pragma unroll
        for (int q = 0; q < NR; ++q) { float ss = 0.f;
#pragma unroll
            for (int j = 0; j < 4; ++j) ss += (xv[q][j].x * xv[q][j].x + xv[q][j].y * xv[q][j].y) + (xv[q][j].z * xv[q][j].z + xv[q][j].w * xv[q][j].w);
            rstd[q] = rsqrtf(wave_sum(ss) * (1.0f / DM) + 1e-6f); }
#pragma unroll
        for (int j = 0; j < 4; ++j) { const f32x4 n4 = ((const f32x4*)npre)[lane + 64 * j];
#pragma unroll
            for (int q = 0; q < NR; ++q) { const f32x4 s4 = ((const f32x4*)J[q].sc)[lane + 64 * j], b4 = ((const f32x4*)J[q].sh)[lane + 64 * j];
                const f32x4 hv = (xv[q][j] * rstd[q] * n4) * (s4 + 1.0f) + b4;
                u32x2 w; w.x = cvtpk(hv.x, hv.y); w.y = cvtpk(hv.z, hv.w); ((u32x2*)J[q].h)[lane + 64 * j] = w; } }
    }
}

template <bool HASY, bool HASH, bool XIN32 = true, bool XOUT32 = true>
__device__ __forceinline__ void combine_span(int mb, int me, const void* xin_lat, const void* xin_ctx, void* xout_lat, void* xout_ctx, const bf16* Y, bf16* H,
                                             const float* gate0, const float* npost, const float* sh0, const float* sc0, const float* npre, int lane, float gmul) {
    int cur_r = -1; f32x4 A1[4], A2[4], B2[4];
    for (int m = mb; m < me;) {
        const int r = m < MLAT ? (m >> 11) : 32;
        if (r != cur_r) { cur_r = r;
#pragma unroll
            for (int j = 0; j < 4; ++j) {
                if constexpr (HASY) A1[j] = ((const f32x4*)(gate0 + (size_t)r * MODW))[lane + 64 * j] * ((const f32x4*)npost)[lane + 64 * j] * gmul;
                if constexpr (HASH) { A2[j] = ((const f32x4*)npre)[lane + 64 * j] * (((const f32x4*)(sc0 + (size_t)r * MODW))[lane + 64 * j] + 1.0f); B2[j] = ((const f32x4*)(sh0 + (size_t)r * MODW))[lane + 64 * j]; } } }
        const int mn = m + 1; const bool two = mn < me && (mn < MLAT ? (mn >> 11) : 32) == r;
        const int mq[2] = {m, two ? mn : m};
        f32x4 xv[2][4]; u32x2 yv[2][4];
#pragma unroll
        for (int q = 0; q < 2; ++q) { const int mm = mq[q]; const size_t eo = mm < MLAT ? (size_t)mm * DM : (size_t)(mm - MLAT) * DM; const void* xb = mm < MLAT ? xin_lat : xin_ctx;
#pragma unroll
            for (int j = 0; j < 4; ++j) {
                if constexpr (XIN32) xv[q][j] = ((const f32x4*)((const float*)xb + eo))[lane + 64 * j];
                else { const u32x2 w = ((const u32x2*)((const bf16*)xb + eo))[lane + 64 * j]; xv[q][j] = (f32x4){bflo(w.x), bfhi(w.x), bflo(w.y), bfhi(w.y)}; }
                if constexpr (HASY) yv[q][j] = ((const u32x2*)(Y + (size_t)mm * DM))[lane + 64 * j]; } }
        if constexpr (HASY) {
            float rstd[2];
#pragma unroll
            for (int q = 0; q < 2; ++q) { float ss = 0.f;
#pragma unroll
                for (int j = 0; j < 4; ++j) { const float a = bflo(yv[q][j].x), b = bfhi(yv[q][j].x), c = bflo(yv[q][j].y), d = bfhi(yv[q][j].y); ss += (a * a + b * b) + (c * c + d * d); }
                rstd[q] = rsqrtf(wave_sum(ss) * (1.0f / DM) + 1e-6f); }
#pragma unroll
            for (int q = 0; q < 2; ++q) { const int mm = mq[q]; const size_t eo = mm < MLAT ? (size_t)mm * DM : (size_t)(mm - MLAT) * DM; void* xb = mm < MLAT ? xout_lat : xout_ctx;
#pragma unroll
                for (int j = 0; j < 4; ++j) { const f32x4 yf = {bflo(yv[q][j].x), bfhi(yv[q][j].x), bflo(yv[q][j].y), bfhi(yv[q][j].y)};
                    xv[q][j] = xv[q][j] + A1[j] * (yf * rstd[q]);
                    if constexpr (XOUT32) ((f32x4*)((float*)xb + eo))[lane + 64 * j] = xv[q][j];
                    else { u32x2 w; w.x = cvtpk(xv[q][j].x, xv[q][j].y); w.y = cvtpk(xv[q][j].z, xv[q][j].w); ((u32x2*)((bf16*)xb + eo))[lane + 64 * j] = w;
                        xv[q][j] = (f32x4){bflo(w.x), bfhi(w.x), bflo(w.y), bfhi(w.y)}; } } }
        }
        if constexpr (HASH) {
            float rstd[2];
#pragma unroll
            for (int q = 0; q < 2; ++q) { float ss = 0.f;
#pragma unroll
                for (int j = 0; j < 4; ++j) ss += (xv[q][j].x * xv[q][j].x + xv[q][j].y * xv[q][j].y) + (xv[q][j].z * xv[q][j].z + xv[q][j].w * xv[q][j].w);
                rstd[q] = rsqrtf(wave_sum(ss) * (1.0f / DM) + 1e-6f); }
#pragma unroll
            for (int q = 0; q < 2; ++q) { const int mm = mq[q];
#pragma unroll
                for (int j = 0; j < 4; ++j) { const f32x4 hv = (xv[q][j] * rstd[q]) * A2[j] + B2[j];
                    u32x2 w; w.x = cvtpk(hv.x, hv.y); w.y = cvtpk(hv.z, hv.w); ((u32x2*)(H + (size_t)mm * DM))[lane + 64 * j] = w; } }
        }
        m += two ? 2 : 1;
    }
}

#define XB_TMO      128
#define XB_XCNT(j)  (256  + 64 * (j))
#define XB_XSUB(j)  (1280 + 64 * (j))
#define XB_XGEN(j)  (2304 + 64 * (j))
#define XB_TOP      3328
#define XB_TOPGEN   3392
#define XCD_BAR_WORDS 3456
#define XB_SPIN_CAP (1u << 18)

__device__ __forceinline__ unsigned xb_ld(unsigned* p)              { return __hip_atomic_load(p, __ATOMIC_RELAXED, __HIP_MEMORY_SCOPE_AGENT); }
__device__ __forceinline__ unsigned xb_add(unsigned* p, unsigned v) { return __hip_atomic_fetch_add(p, v, __ATOMIC_RELAXED, __HIP_MEMORY_SCOPE_AGENT); }
__device__ __forceinline__ unsigned xb_xcc_id() { return (unsigned)__builtin_amdgcn_s_getreg((3 << 11) | 20) & 0xFu; }
#define XB_SPIN(cond, bar) do { unsigned _sp = 0; while (cond) { __builtin_amdgcn_s_sleep(1); \
    if ((++_sp & 255u) == 0u) { if (xb_ld(&(bar)[XB_TMO])) break; if (_sp > XB_SPIN_CAP) { atomicAdd(&(bar)[XB_TMO], 1u); break; } } } } while (0)

struct XcdBarrier {
    unsigned* bar; unsigned x;
    volatile LAS unsigned* st;
};

__device__ __forceinline__ XcdBarrier xcd_barrier_post(unsigned* bar, volatile LAS unsigned* st) {
    XcdBarrier b; b.bar = bar; b.x = xb_xcc_id(); b.st = st;
    if (threadIdx.x == 0) (void)xb_add(&bar[XB_XCNT(b.x)], 1u);
    return b;
}
__device__ __forceinline__ void xcd_barrier_complete(unsigned* bar, unsigned x, unsigned& nloc, unsigned& nx) {
    const unsigned G = gridDim.x * gridDim.y * gridDim.z;
    unsigned sum, cnt, mine, sp = 0u;
    for (;;) {
        sum = 0u; cnt = 0u; mine = 0u;
#pragma unroll
        for (unsigned j = 0; j < 16; ++j) { const unsigned c = xb_ld(&bar[XB_XCNT(j)]); sum += c; cnt += (c > 0u) ? 1u : 0u; mine = (j == x) ? c : mine; }
        if (sum == G) break;
        __builtin_amdgcn_s_sleep(1);
        if ((++sp & 255u) == 0u) { if (xb_ld(&bar[XB_TMO])) break; if (sp > XB_SPIN_CAP) { atomicAdd(&bar[XB_TMO], 1u); break; } }
    }
    nloc = mine > 0u ? mine : 1u; nx = cnt > 0u ? cnt : 1u;
}

__device__ __forceinline__ void xcd_barrier(const XcdBarrier& b) {
    asm volatile("s_waitcnt vmcnt(0)" ::: "memory");
    __syncthreads();
    if (threadIdx.x == 0) {
        unsigned* bar = b.bar;
        __builtin_amdgcn_s_waitcnt(0);
        unsigned nloc = b.st[0], nx = b.st[1];
        if (nloc == 0u) { xcd_barrier_complete(bar, b.x, nloc, nx); b.st[0] = nloc; b.st[1] = nx; }
        const unsigned old = xb_add(&bar[XB_XSUB(b.x)], 1u);
        const unsigned gen = old / nloc;
        if (old + 1u == (gen + 1u) * nloc) {
            __builtin_amdgcn_fence(__ATOMIC_RELEASE, "agent");
            asm volatile("s_waitcnt vmcnt(0)" ::: "memory");
            const unsigned og = xb_add(&bar[XB_TOP], 1u);
            const unsigned tg = og / nx;
            if (og + 1u == (tg + 1u) * nx) xb_add(&bar[XB_TOPGEN], 1u);
            else XB_SPIN(xb_ld(&bar[XB_TOPGEN]) == tg, bar);
            __builtin_amdgcn_fence(__ATOMIC_ACQUIRE, "agent");
            xb_add(&bar[XB_XGEN(b.x)], 1u);
            asm volatile("s_waitcnt vmcnt(0)" ::: "memory");
        } else {
            XB_SPIN(xb_ld(&bar[XB_XGEN(b.x)]) == gen, bar);
            __builtin_amdgcn_fence(__ATOMIC_ACQUIRE, "agent");
            asm volatile("s_waitcnt vmcnt(0)" ::: "memory");
        }
    }
    __syncthreads();
}

struct Args { const float* in[23]; float* out; unsigned char* ws; int ph_lo, ph_hi; };

__global__ void __launch_bounds__(512, 2) mega(Args args) {
    extern __shared__ __attribute__((aligned(16))) unsigned char lds[];
    cg::grid_group grid = cg::this_grid();
    const int G = gridDim.x, bx = blockIdx.x;
    const int vcu = (G % 8 == 0) ? (bx % 8) * (G / 8) + bx / 8 : bx;
    const int NGW = G * 8;
    const int lo = args.ph_lo, hi = args.ph_hi;
    unsigned char* ws = args.ws;
    const float* x_in = args.in[0]; const float* c_in = args.in[1]; const float* ctx_in = args.in[2]; const float* cctx_in = args.in[3];
    const float* ada_w = args.in[4]; const float* ada_b = args.in[5]; const float* norm_g = args.in[6];
    float* modp = (float*)(ws + OFF_MODP); float* mods = (float*)(ws + OFF_MODS);
    float* cosA = (float*)(ws + OFF_ROPE); float* sinA = cosA + 2048 * 32; float* cosC = sinA + 2048 * 32; float* sinC = cosC + 2048 * 64;
    bf16* Wsb = (bf16*)(ws + OFF_WS);
    unsigned char* Wb = ws + OFF_W;
#ifndef XBF16
#define XBF16 0
#endif
    void* XC = (void*)(ws + OFF_XC); void* XL = XBF16 ? (void*)(ws + OFF_XLB) : (void*)args.out;
    bf16* Hb = (bf16*)(ws + OFF_H); bf16* Yb = (bf16*)(ws + OFF_Y); bf16* QKV = (bf16*)(ws + OFF_BIG); bf16* Ob = (bf16*)(ws + OFF_O); bf16* HID = (bf16*)(ws + OFF_BIG);
    if (threadIdx.x < 16) ((LAS unsigned*)((LAS unsigned char*)lds + LDS_XB))[threadIdx.x] = 0u;
    __syncthreads();
    const XcdBarrier xbar = xcd_barrier_post((unsigned*)(ws + OFF_CTL), (volatile LAS unsigned*)((LAS unsigned char*)lds + LDS_XB));
    bool first_seam = false;
    int ph = 0;
#define GSYNC() do { if (first_seam) { grid.sync(); first_seam = false; } else xcd_barrier(xbar); } while (0)
    first_seam = args.ph_hi < 0;
#ifndef PH_MASK
#define PH_MASK 0xffff
#endif
#define RUN(p) (lo <= (p) && (p) < hi)
#define ON(b) ((PH_MASK >> (b)) & 1)
#ifndef G1MASK
#define G1MASK 7
#endif
#ifndef ATMASK
#define ATMASK 3
#endif
#define ATK(k) ((ATMASK >> (k)) & 1)
#define G1K(k) ((G1MASK >> (k)) & 1)
#define SEAM(p) do { if (RUN(p) && RUN((p) + 1)) GSYNC(); } while (0)

#ifndef NPRO
#define NPRO 1
#endif
#ifndef CMB_F1
#define CMB_F1 5
#endif
#ifndef CMB_F2
#define CMB_F2 6
#endif
#ifndef EPI_SKIP_ON_REP
#define EPI_SKIP_ON_REP 0
#endif
#ifdef EXTRA_SYNCS
    for (int es = 0; es < EXTRA_SYNCS; ++es) GSYNC();
#endif
    for (int prep = 0; prep < NPRO; ++prep) {
    if (prep) { GSYNC(); ph -= 3; }
    int tid = threadIdx.x; asm volatile("" : "+v"(tid));
    const int lane = tid & 63, wave = __builtin_amdgcn_readfirstlane(tid >> 6), gw = vcu * 8 + wave;
    if (ON(0) && RUN(ph)) {
        LAS float* scr = (LAS float*)((LAS unsigned char*)lds + wave * 16896);
        for (int it = gw; it < 96 * 8; it += NGW) {
            const int cb = it % 96, ks = it / 96, k0 = ks * 128;
            { float cv[NMODROW][2];
#pragma unroll
              for (int r = 0; r < NMODROW; ++r) { const float* cp = r < 32 ? c_in + r * DM + k0 : cctx_in + k0; cv[r][0] = cp[lane]; cv[r][1] = cp[lane + 64]; }
#pragma unroll
              for (int r = 0; r < NMODROW; ++r) { scr[r * 128 + lane] = cv[r][0] / (1.0f + __expf(-cv[r][0])); scr[r * 128 + lane + 64] = cv[r][1] / (1.0f + __expf(-cv[r][1])); } }
            asm volatile("s_waitcnt lgkmcnt(0)" ::: "memory");
            f32x4 acc[NMODROW];
#pragma unroll
            for (int r = 0; r < NMODROW; ++r) acc[r] = (f32x4){0.f, 0.f, 0.f, 0.f};
            const int li = cb / 24, col0 = (cb % 24) * 256 + lane * 4;
            const float* wp = ada_w + ((size_t)li * DM + k0) * MODW + col0;
#pragma nounroll
            for (int kk = 0; kk < 128; kk += 8) {
                f32x4 w4[8];
#pragma unroll
                for (int u = 0; u < 8; ++u) w4[u] = *(const f32x4*)(wp + (size_t)(kk + u) * MODW);
#pragma unroll
                for (int r = 0; r < NMODROW; ++r) { const f32x4 s0 = *(const LAS f32x4*)(scr + r * 128 + kk), s1 = *(const LAS f32x4*)(scr + r * 128 + kk + 4);
                    acc[r] = acc[r] + w4[0] * s0.x + w4[1] * s0.y + w4[2] * s0.z + w4[3] * s0.w + w4[4] * s1.x + w4[5] * s1.y + w4[6] * s1.z + w4[7] * s1.w; } }
#pragma unroll
            for (int r = 0; r < NMODROW; ++r) *(f32x4*)(modp + ((size_t)ks * NMODROW + r) * (4 * MODW) + li * MODW + col0) = acc[r];
            asm volatile("s_waitcnt lgkmcnt(0)" ::: "memory");
        }
        {
            constexpr int I_FI = 16 * 176, I_FO = 44 * 32, I_AQ = 16 * 48, I_AO = 16 * 32, I_BI = 16 * 64, I_BO = 16 * 32, I_CQ = 16 * 64, I_CO = 16 * 32;
            constexpr int NIT = 4 * I_FI + 4 * I_FO + 2 * I_AQ + 2 * I_AO + I_BI + I_BO + I_CQ + I_CO;
            const int ntw = NGW > 1024 ? NGW - 768 : NGW, tw = NGW > 1024 ? gw - 768 : gw;
            if (tw >= 0) for (int it = tw; it < NIT; it += ntw) {
                int r = it;
                if (r < 4 * I_FI) { const int l = r / I_FI; r %= I_FI; const int kb = r / 176, nb = r % 176;
                    transpose_item(args.in[7] + (size_t)l * DM * 2 * FFH, DM, 2 * FFH, (bf16*)(Wb + W_FI) + (size_t)l * 2 * FFH * DM, kb * 64, nb * 32, ffn_in_row(nb * 32), scr, lane); continue; } r -= 4 * I_FI;
                if (r < 4 * I_FO) { const int l = r / I_FO; r %= I_FO; const int kb = r / 32, nb = r % 32;
                    transpose_item(args.in[8] + (size_t)l * FFH * DM, FFH, DM, (bf16*)(Wb + W_FO) + (size_t)l * DM * FFH, kb * 64, nb * 32, nb * 32, scr, lane); continue; } r -= 4 * I_FO;
                if (r < 2 * I_AQ) { const int l = r / I_AQ; r %= I_AQ; const int kb = r / 48, nb = r % 48;
                    transpose_item(args.in[9] + (size_t)l * DM * 1536, DM, 1536, (bf16*)(Wb + W_AQ) + (size_t)l * 1536 * DM, kb * 64, nb * 32, nb * 32, scr, lane); continue; } r -= 2 * I_AQ;
                if (r < 2 * I_AO) { const int l = r / I_AO; r %= I_AO; const int kb = r / 32, nb = r % 32;
                    transpose_item(args.in[10] + (size_t)l * DM * DM, DM, DM, (bf16*)(Wb + W_AO) + (size_t)l * DM * DM, kb * 64, nb * 32, nb * 32, scr, lane); continue; } r -= 2 * I_AO;
                if (r < I_BI) { const int kb = r / 64, nb = r % 64; transpose_item(args.in[12], DM, 2048, (bf16*)(Wb + W_BI), kb * 64, nb * 32, nb * 32, scr, lane); continue; } r -= I_BI;
                if (r < I_BO) { const int kb = r / 32, nb = r % 32; transpose_item(args.in[18], DM, DM, (bf16*)(Wb + W_BO), kb * 64, nb * 32, nb * 32, scr, lane); continue; } r -= I_BO;
                if (r < I_CQ) { const int kb = r / 64, nb = r % 64; transpose_item(args.in[19], DM, 2048, (bf16*)(Wb + W_CQ), kb * 64, nb * 32, nb * 32, scr, lane); continue; } r -= I_CQ;
                { const int kb = r / 32, nb = r % 32; transpose_item(args.in[20], DM, DM, (bf16*)(Wb + W_CO), kb * 64, nb * 32, nb * 32, scr, lane); }
            }
        }
        {
            const int gt = gw * 64 + lane, NGT = NGW * 64;
            const float* wsf = args.in[16];
            for (int e = gt; e < 8 * 128 * 128 / 2; e += NGT) ((unsigned*)Wsb)[e] = cvtpk(wsf[2 * e], wsf[2 * e + 1]);
            for (int e = gt; e < 2048 * 32; e += NGT) { const int t = e >> 5, p = e & 31, j = p & 15; const float pos = (float)(p < 16 ? (t >> 6) : (t & 63));
                const float inv = exp2f(-(float)j * (13.287712379549449f / 16.0f)); const float a = pos * inv; cosA[e] = cosf(a); sinA[e] = sinf(a); }
            for (int e = gt; e < 2048 * 64; e += NGT) { const int t = e >> 6, p = e & 63, j = p & 31; const float pos = (float)(p < 32 ? (t >> 6) : (t & 63));
                const float inv = exp2f(-(float)j * (13.287712379549449f / 32.0f)); const float a = pos * inv; cosC[e] = cosf(a); sinC[e] = sinf(a); }
        }
    }
    SEAM(ph); ++ph;
    if (ON(1) && RUN(ph)) {
        const int gt = gw * 64 + lane, NGT = NGW * 64;
        for (int e = gt; e < DEPTH * NMODROW * MODW / 4; e += NGT) {
            const int c4 = e % (MODW / 4), rr = (e / (MODW / 4)) % NMODROW, li = e / (MODW / 4 * NMODROW);
            f32x4 s = *(const f32x4*)(ada_b + li * MODW + c4 * 4);
#pragma unroll
            for (int k = 0; k < 8; ++k) s = s + *(const f32x4*)(modp + ((size_t)k * NMODROW + rr) * (4 * MODW) + li * MODW + c4 * 4);
            *(f32x4*)(mods + ((size_t)li * NMODROW + rr) * MODW + c4 * 4) = s;
        }
    }
    SEAM(ph); ++ph;
    if (ON(2) && RUN(ph)) {
        { const int rpw = (MTOT + NGW - 1) / NGW, mb = gw * rpw, me = mb + rpw < MTOT ? mb + rpw : MTOT;
          combine_span<false, true>(mb, me, x_in, ctx_in, nullptr, nullptr, nullptr, Hb, nullptr, nullptr, mods, mods + DM, norm_g, lane, 1.0f); }
    }
    SEAM(ph); ++ph;
    }

    constexpr int NOPS = 10;
    for (int step = 3, rep = 0; step < 3 + NOPS * DEPTH; ) {
        const int li = (step - 3) / NOPS, op = (step - 3) % NOPS;
        int tid = threadIdx.x; asm volatile("" : "+v"(tid));
        const int lane = tid & 63, wave = __builtin_amdgcn_readfirstlane(tid >> 6), gw = vcu * 8 + wave;
        const int kind = li % 3; const int ja = li / 3; const bool ctx_out = li < DEPTH - 1; const int Mact = ctx_out ? MTOT : MLAT;
        const float* ng = norm_g + (size_t)li * 4 * DM;
        const bool noop = (op == 1 && kind == 1) || ((op == 5 || op == 9) && !ctx_out);
        if (RUN(ph) && !noop) {
#ifdef STAGGER_US
            if (op == 0 || op == 3 || op == 5 || op == 6) {
                const unsigned long long t0 = __builtin_amdgcn_s_memrealtime(); const unsigned long long dl = (unsigned long long)(((bx >> 3) & 3) * STAGGER_US * 100);
                while (__builtin_amdgcn_s_memrealtime() - t0 < dl) __builtin_amdgcn_s_sleep(32);
            }
#endif
            if (ON(3) && ((op == 0 && kind != 1) || op == 3 || op == 7 || ((op == 4 || op == 8) && ctx_out))) {
                pg8::Gemm g; pg8::EpiBf16<0> E; E.bias = nullptr; E.split_cols = 0; E.split_stride = 0; E.scale0 = 1.f; E.skip = EPI_SKIP_ON_REP ? rep * EPI_SKIP_ON_REP : 0; E.scratch = Ob;
                if (op == 0) { const int N1 = kind == 0 ? 1536 : 2048; g.A = Hb; g.Bt = kind == 0 ? (const bf16*)(Wb + W_AQ) + (size_t)ja * 1536 * DM : (const bf16*)(Wb + W_CQ); g.M = MTOT; g.N = N1; g.K = DM; E.O = QKV; E.ldc = N1; }
                else if (op == 3 || op == 4) { const size_t ro = op == 4 ? (size_t)MLAT * DM : 0;
                    g.A = Ob + ro; g.Bt = kind == 0 ? (const bf16*)(Wb + W_AO) + (size_t)ja * DM * DM : kind == 1 ? (const bf16*)(Wb + W_BO) : (const bf16*)(Wb + W_CO); g.M = op == 4 ? MCTX : MLAT; g.N = DM; g.K = DM; E.O = Yb + ro; E.ldc = DM; }
                else { const bool cx = op == 8;
                    g.A = HID + (cx ? (size_t)MLAT * FFH : 0); g.Bt = (const bf16*)(Wb + W_FO) + (size_t)li * DM * FFH; g.M = cx ? MCTX : MLAT; g.N = DM; g.K = FFH; E.O = Yb + (cx ? (size_t)MLAT * DM : 0); E.ldc = DM; }
                pg8::StaticOrder S; S.init(g.M, g.N, G, bx);
                pg8::gemm_phase<pg8::EpiBf16<0>, pg8::StaticOrder, true, true>((PG8_LAS unsigned char*)lds, g, S, E);
            }
            else if (ON(4) && op == 0) {
                pg8::Gemm g{Hb, (const bf16*)(Wb + W_BI), MTOT, 2048, DM}; pg8::StaticOrder S; S.init(MTOT, 2048, G, bx);
                pg8::EpiBf16<1> E{QKV, 2048, args.in[13], 0, 0, 1.f, EPI_SKIP_ON_REP ? rep * EPI_SKIP_ON_REP : 0, Ob}; pg8::gemm_phase<pg8::EpiBf16<1>, pg8::StaticOrder, true, true>((PG8_LAS unsigned char*)lds, g, S, E);
            }
            else if (ON(5) && op == 6) {
                pg8::Gemm g{Hb, (const bf16*)(Wb + W_FI) + (size_t)li * 2 * FFH * DM, Mact, 2 * FFH, DM}; pg8::StaticOrder S; S.init(Mact, 2 * FFH, G, bx);
                pg8::EpiSwiglu E{HID, FFH}; pg8::gemm_phase<pg8::EpiSwiglu, pg8::StaticOrder, true, true>((PG8_LAS unsigned char*)lds, g, S, E);
            }
            else if (ON(6) && op == 1) {
                if (kind == 0) {
                    const int rs = lane >> 4, l16 = lane & 15, hd = l16 >> 2, i0 = (l16 & 3) * 8;
#pragma nounroll
                    for (int m = gw * 4 + rs; m < MLAT; m += NGW * 4) { const int t = m & 2047; bf16* kp = QKV + (size_t)m * 1536 + 1024 + hd * 64 + i0;
                        const bf16x8 x1 = *(const bf16x8*)kp, x2 = *(const bf16x8*)(kp + 32);
                        const f32x4 c0 = *(const f32x4*)(cosA + t * 32 + i0), c1 = *(const f32x4*)(cosA + t * 32 + i0 + 4), s0 = *(const f32x4*)(sinA + t * 32 + i0), s1 = *(const f32x4*)(sinA + t * 32 + i0 + 4);
                        float o1[8], o2[8];
#pragma unroll
                        for (int j = 0; j < 8; ++j) { const float c = j < 4 ? c0[j & 3] : c1[j & 3], sn = j < 4 ? s0[j & 3] : s1[j & 3]; const float a = bf2f(x1[j]), b = bf2f(x2[j]); o1[j] = a * c - b * sn; o2[j] = b * c + a * sn; }
                        *(u32x4*)kp = (u32x4){cvtpk(o1[0], o1[1]), cvtpk(o1[2], o1[3]), cvtpk(o1[4], o1[5]), cvtpk(o1[6], o1[7])};
                        *(u32x4*)(kp + 32) = (u32x4){cvtpk(o2[0], o2[1]), cvtpk(o2[2], o2[3]), cvtpk(o2[4], o2[5]), cvtpk(o2[6], o2[7])}; }
                } else {
                    const float* kg = args.in[22]; const int rs = lane >> 5, l32 = lane & 31, hd = l32 >> 3, i0 = (l32 & 7) * 8;
                    const f32x4 ga0 = *(const f32x4*)(kg + i0), ga1 = *(const f32x4*)(kg + i0 + 4), gb0 = *(const f32x4*)(kg + 64 + i0), gb1 = *(const f32x4*)(kg + 64 + i0 + 4);
#pragma nounroll
                    for (int m = gw * 2 + rs; m < MTOT; m += NGW * 2) { bf16* kp = QKV + (size_t)m * 2048 + 1024 + hd * 128 + i0;
                        const bf16x8 x1 = *(const bf16x8*)kp, x2 = *(const bf16x8*)(kp + 64);
                        float a[8], b[8]; float ss = 0.f;
#pragma unroll
                        for (int j = 0; j < 8; ++j) { a[j] = bf2f(x1[j]); b[j] = bf2f(x2[j]); ss += a[j] * a[j] + b[j] * b[j]; }
                        ss += __shfl_xor(ss, 1); ss += __shfl_xor(ss, 2); ss += __shfl_xor(ss, 4);
                        const float rstd = rsqrtf(ss * (1.0f / 128.0f) + 1e-6f);
#pragma unroll
                        for (int j = 0; j < 8; ++j) { a[j] *= rstd * (j < 4 ? ga0[j & 3] : ga1[j & 3]); b[j] *= rstd * (j < 4 ? gb0[j & 3] : gb1[j & 3]); }
                        if (m < MLAT) { const int t = m & 2047;
                            const f32x4 c0 = *(const f32x4*)(cosC + t * 64 + i0), c1 = *(const f32x4*)(cosC + t * 64 + i0 + 4), s0 = *(const f32x4*)(sinC + t * 64 + i0), s1 = *(const f32x4*)(sinC + t * 64 + i0 + 4);
#pragma unroll
                            for (int j = 0; j < 8; ++j) { const float c = j < 4 ? c0[j & 3] : c1[j & 3], sn = j < 4 ? s0[j & 3] : s1[j & 3]; const float x1v = a[j], x2v = b[j]; a[j] = x1v * c - x2v * sn; b[j] = x2v * c + x1v * sn; } }
                        *(u32x4*)kp = (u32x4){cvtpk(a[0], a[1]), cvtpk(a[2], a[3]), cvtpk(a[4], a[5]), cvtpk(a[6], a[7])};
                        *(u32x4*)(kp + 64) = (u32x4){cvtpk(b[0], b[1]), cvtpk(b[2], b[3]), cvtpk(b[4], b[5]), cvtpk(b[6], b[7])}; }
                }
            }
            else if (ON(7) && op == 2 && kind != 1) {
                if (kind == 0) {
                    const float* sink = args.in[11] + ja * 16;
                    const int nlat = 4096, ntot = nlat + (ctx_out ? 512 : 0);
                    for (int u = bx; u < ntot; u += G) {
                        att::UnitDesc d; d.nctx = 4; d.cosT = cosA; d.sinT = sinA; d.qg = nullptr;
                        int b, h;
                        if (u < nlat) { const int x = u & 7, j = (u >> 3) & 31, gi = (u >> 8) * 8 + x; b = gi >> 2; const int kvh = gi & 3; h = kvh * 4 + (j >> 3); const int q0 = (((j & 7) + (u >> 8)) & 7) * 256;
                            d.Q = QKV + ((size_t)b * SEQ + q0) * 1536 + h * 64; d.O = Ob + ((size_t)b * SEQ + q0) * DM + h * 64; d.qpos0 = q0;
                            const int klo = q0 - 128 < 0 ? 0 : q0 - 128, khi = q0 + 384 > SEQ ? SEQ : q0 + 384; d.band_kp0 = klo; d.NT = 4 + (khi - klo) / 64; }
                        else { const int cu = u - nlat; b = cu >> 4; h = cu & 15;
                            d.Q = QKV + ((size_t)MLAT + b * CTXL) * 1536 + h * 64; d.O = Ob + ((size_t)MLAT + b * CTXL) * DM + h * 64; d.qpos0 = -1; d.band_kp0 = 0; d.NT = 4; }
                        d.Kc = QKV + 1024 + (h >> 2) * 64; d.Vc = QKV + 1280 + (h >> 2) * 64; d.ctx_row0 = MLAT + b * CTXL; d.lat_row0 = (long)b * SEQ;
                        d.sink_l2 = sink[h] * 1.4426950408889634f;
                        att::attn_unit<64, 1536, false, true>(d, (char*)lds);
                    }
                } else {
                    const int nlat = 2048, ntot = nlat + (ctx_out ? 256 : 0);
                    for (int u = bx; u < ntot; u += G) {
                        att::UnitDesc d; d.nctx = 4; d.cosT = cosC; d.sinT = sinC; d.qg = args.in[21]; d.band_kp0 = 0;
                        int b, h;
                        if (u < nlat) { const int x = u & 7, j = (u >> 3) & 31, gi = ((u >> 8) * 8 + x) * 2 + (j >> 4); b = gi >> 2; const int kvh = gi & 3; h = kvh * 2 + ((j & 15) >> 3); const int q0 = (j & 7) * 256;
                            d.Q = QKV + ((size_t)b * SEQ + q0) * 2048 + h * 128; d.O = Ob + ((size_t)b * SEQ + q0) * DM + h * 128; d.qpos0 = q0; d.NT = 36; }
                        else { const int cu = u - nlat; b = cu >> 3; h = cu & 7;
                            d.Q = QKV + ((size_t)MLAT + b * CTXL) * 2048 + h * 128; d.O = Ob + ((size_t)MLAT + b * CTXL) * DM + h * 128; d.qpos0 = -1; d.NT = 4; }
                        d.Kc = QKV + 1024 + (h >> 1) * 128; d.Vc = QKV + 1536 + (h >> 1) * 128; d.ctx_row0 = MLAT + b * CTXL; d.lat_row0 = (long)b * SEQ;
                        d.sink_l2 = -INFINITY;
                        att::attn_unit<128, 2048, true, false>(d, (char*)lds);
                    }
                }

            }
            else if (ON(8) && op == 2) {
                constexpr int TB = 16384;
                char* V_lds = (char*)lds; f32x2* stat = (f32x2*)((char*)lds + 4 * TB);
                const float* lng = args.in[14]; const float* lnb = args.in[15]; const float* bsb = args.in[17];
                const int r32 = lane & 31, hh = lane >> 5, rb = wave & 3, half = wave >> 2;
                const int ht = tid & 255, sr = ht >> 4, sc = (ht & 15) * 8;
                const int vb0 = (int)(uintptr_t)V_lds + half * 2 * TB + att::v_rd_base(lane);
                bf16* stg = (bf16*)((char*)lds + 4 * TB + 1024) + wave * 4096;
                for (int u = bx; u < (MTOT / 128) * 2; u += G) {
                    const int ux = u & 7, uj = (u >> 3) & 31, ur = u >> 8; const int chunk = ur * 128 + ux * (ur < 4 ? 16 : 8) + (uj >> 1), gh = uj & 1;
                    if (chunk >= MTOT / 128) continue;
                    const size_t row0 = (size_t)chunk * 128;
#pragma nounroll
                    for (int rb8 = 0; rb8 < 16; rb8 += 8) {
                        bf16x8 v0[8], v1[8];
#pragma unroll
                        for (int rr = 0; rr < 8; ++rr) { const bf16* vp = QKV + (row0 + wave * 16 + rb8 + rr) * 2048 + 1024 + lane * 16; v0[rr] = *(const bf16x8*)vp; v1[rr] = *(const bf16x8*)(vp + 8); }
#pragma unroll
                        for (int rr = 0; rr < 8; ++rr) { float f[16];
#pragma unroll
                            for (int j = 0; j < 8; ++j) { f[j] = bf2f(v0[rr][j]); f[8 + j] = bf2f(v1[rr][j]); }
                            float sm = 0.f;
#pragma unroll
                            for (int j = 0; j < 16; ++j) sm += f[j];
                            const float mean = wave_sum(sm) * (1.0f / 1024.0f); float q = 0.f;
#pragma unroll
                            for (int j = 0; j < 16; ++j) { const float dd = f[j] - mean; q += dd * dd; }
                            const float rstd = rsqrtf(wave_sum(q) * (1.0f / 1024.0f) + 1e-5f);
                            if (lane == 0) stat[wave * 16 + rb8 + rr] = (f32x2){mean, rstd}; }
                    }
                    __syncthreads();
#pragma nounroll
                    for (int st2 = 0; st2 < 2; ++st2) {
                        const int g = gh * 4 + st2 * 2 + half;
                        bf16x8 raw[8], pa[2][4], uv[8];
#pragma unroll
                        for (int l = 0; l < 8; ++l) raw[l] = *(const bf16x8*)(QKV + (row0 + sr + 16 * l) * 2048 + 1024 + g * 128 + sc);
#pragma unroll
                        for (int T = 0; T < 2; ++T)
#pragma unroll
                            for (int ks = 0; ks < 4; ++ks) pa[T][ks] = *(const bf16x8*)(Wsb + (size_t)g * 16384 + (32 * rb + r32) * 128 + 64 * T + 16 * ks + 8 * hh);
#pragma unroll
                        for (int i = 0; i < 8; ++i) uv[i] = *(const bf16x8*)(QKV + (row0 + 32 * rb + i * 4 + (lane >> 4)) * 2048 + g * 128 + (lane & 15) * 8);
                        const f32x4 lg0 = *(const f32x4*)(lng + g * 128 + sc), lg1 = *(const f32x4*)(lng + g * 128 + sc + 4), lb0 = *(const f32x4*)(lnb + g * 128 + sc), lb1 = *(const f32x4*)(lnb + g * 128 + sc + 4);
#pragma unroll
                        for (int l = 0; l < 8; ++l) { const int rl = sr + 16 * l;
                            const f32x2 st = stat[rl]; float f[8];
#pragma unroll
                            for (int j = 0; j < 8; ++j) f[j] = (bf2f(raw[l][j]) - st.x) * st.y * (j < 4 ? lg0[j & 3] : lg1[j & 3]) + (j < 4 ? lb0[j & 3] : lb1[j & 3]);
                            u32x4 w = {cvtpk(f[0], f[1]), cvtpk(f[2], f[3]), cvtpk(f[4], f[5]), cvtpk(f[6], f[7])};
                            *(u32x4*)(V_lds + half * 2 * TB + (rl >> 6) * TB + att::v_st<128>(rl & 63, sc)) = w; }
                        __syncthreads();
                        f32x16 o[4]; o[0] = f32x16{}; o[1] = f32x16{}; o[2] = f32x16{}; o[3] = f32x16{};
                        att::pv_all<128>(o, vb0, pa[0][0], pa[0][1], pa[0][2], pa[0][3]);
                        att::pv_all<128>(o, vb0 + TB, pa[1][0], pa[1][1], pa[1][2], pa[1][3]);
#pragma unroll
                        for (int r = 0; r < 16; ++r) { const int pr = att::crow(r, hh); const float bias = bsb[g * 128 + 32 * rb + pr];
#pragma unroll
                            for (int d = 0; d < 4; ++d) { const float v = o[d][r] + bias; stg[pr * 128 + d * 32 + r32] = (bf16)(cvtpk(v, v) & 0xffffu); } }
                        asm volatile("s_waitcnt lgkmcnt(0)" ::: "memory");
#pragma unroll
                        for (int i = 0; i < 8; ++i) { const int row = i * 4 + (lane >> 4), ch = lane & 15; const bf16x8 mv = *(const bf16x8*)(stg + row * 128 + ch * 8);
                            float f[8];
#pragma unroll
                            for (int e = 0; e < 8; ++e) f[e] = bf2f(uv[i][e]) * bf2f(mv[e]);
                            u32x4 w = {cvtpk(f[0], f[1]), cvtpk(f[2], f[3]), cvtpk(f[4], f[5]), cvtpk(f[6], f[7])};
                            *(u32x4*)(Ob + (row0 + 32 * rb + row) * DM + g * 128 + ch * 8) = w; }
                        __syncthreads();
                    }
                }
            }
            if (ON(9) && (op == 4 || op == 5 || op == 8 || op == 9)) {
                const bool c2 = op >= 8, last = li == DEPTH - 1, first = li == 0 && !c2 && !rep;
                const int rbase = (op == 5 || op == 9) ? MLAT : 0, nrows = rbase ? MCTX : MLAT;
                const float* ml = mods + (size_t)li * NMODROW * MODW; const float* mn = ml + (size_t)NMODROW * MODW;
                int mb, me;
                if (ctx_out && !rbase && G == 256) {
                    const int F = c2 ? CMB_F2 : CMB_F1; int r0, nr;
                    if (bx >= 128) { nr = F * 64; r0 = (bx - 128) * nr; } else { nr = (8 - F) * 64; r0 = 128 * F * 64 + bx * nr; }
                    mb = r0 + wave * (nr >> 3); me = mb + (nr >> 3);
                } else { const int rpw = (nrows + NGW - 1) / NGW; mb = gw * rpw; me = mb + rpw < nrows ? mb + rpw : nrows; mb += rbase; me += rbase; }
                {
                    if (!c2) {
                        if (first) combine_span<true, true, true, !XBF16>(mb, me, x_in, ctx_in, XL, XC, Yb, Hb, ml + 2 * DM, ng + DM, ml + 3 * DM, ml + 4 * DM, ng + 2 * DM, lane, 1.0f);
                        else combine_span<true, true, !XBF16, !XBF16>(mb, me, XL, XC, XL, XC, Yb, Hb, ml + 2 * DM, ng + DM, ml + 3 * DM, ml + 4 * DM, ng + 2 * DM, lane, rep ? 0.0f : 1.0f);
                    } else {
                        if (last) combine_span<true, false, !XBF16, true>(mb, me, XL, XC, args.out, XC, Yb, Hb, ml + 5 * DM, ng + 3 * DM, nullptr, nullptr, nullptr, lane, rep ? 0.0f : 1.0f);
                        else combine_span<true, true, !XBF16, !XBF16>(mb, me, XL, XC, XL, XC, Yb, Hb, ml + 5 * DM, ng + 3 * DM, mn, mn + DM, ng + 4 * DM, lane, rep ? 0.0f : 1.0f);
                    }
                }
            }
        }
        if (!noop && step + 1 < 3 + NOPS * DEPTH) { if (RUN(ph) && RUN(ph + 1)) GSYNC(); }
#ifdef REP_MASK
        if ((((unsigned long long)(REP_MASK) >> (step - 3)) & 1ull) && rep == 0) { rep = 1; continue; }
        rep = 0;
#endif
        ++step; ++ph;
    }
#undef RUN
#undef SEAM
}

#ifndef MK_MULTI
#define MK_MULTI 0
#endif
extern "C" void kernel_launch(void* const* d_in, const int* in_sizes, int n_in, void* d_out, int out_size, void* d_ws, size_t ws_size, hipStream_t stream) {
    static int grid = 0;
    if (grid == 0) {
        if (n_in != 23 || ws_size < WS_END) { fprintf(stderr, "kernel_launch: unexpected n_in %d / ws_size %zu (need %zu)\n", n_in, ws_size, (size_t)WS_END); grid = -1; return; }
        int dev = 0, cus = 0, per_cu = 0;
        hipGetDevice(&dev); hipDeviceGetAttribute(&cus, hipDeviceAttributeMultiprocessorCount, dev);
        if (hipFuncSetAttribute((const void*)mega, hipFuncAttributeMaxDynamicSharedMemorySize, LDS_BYTES) != hipSuccess) { fprintf(stderr, "kernel_launch: hipFuncSetAttribute failed\n"); grid = -1; return; }
        if (hipOccupancyMaxActiveBlocksPerMultiprocessor(&per_cu, (const void*)mega, 512, LDS_BYTES) != hipSuccess || per_cu < 1) { fprintf(stderr, "kernel_launch: occupancy query says %d\n", per_cu); per_cu = 1; }
        (void)hipGetLastError();
        grid = cus * per_cu;
        fprintf(stderr, "kernel_launch: grid %d (cus %d x %d)\n", grid, cus, per_cu);
    }
    if (grid < 0) return;
    if (hipMemsetAsync((char*)d_ws + OFF_CTL, 0, CTL_BYTES, stream) != hipSuccess) { fprintf(stderr, "kernel_launch: memset failed\n"); return; }
    Args a{};
    for (int i = 0; i < 23; ++i) a.in[i] = (const float*)d_in[i];
    a.out = (float*)d_out; a.ws = (unsigned char*)d_ws;
#if MK_MULTI
    const int nph = 3 + 10 * DEPTH;
    for (int p = 0; p < nph; ++p) { a.ph_lo = p; a.ph_hi = p + 1; hipLaunchKernelGGL(mega, dim3(grid), dim3(512), LDS_BYTES, stream, a); }
#else
    a.ph_lo = 0; a.ph_hi = 1000;
    void* params[] = {&a};
    hipError_t e = hipLaunchCooperativeKernel((const void*)mega, dim3(grid), dim3(512), params, LDS_BYTES, stream);
    if (e != hipSuccess) fprintf(stderr, "kernel_launch: cooperative launch failed: %s (grid %d)\n", hipGetErrorString(e), grid);
#endif
}
```

```cpp
#ifndef XBF16
#define XBF16 1
#endif
#include <hip/hip_runtime.h>
#include <hip/hip_cooperative_groups.h>
#include <cstdio>
#include <cstdint>
namespace cg = cooperative_groups;
namespace pg8 {
#define PG8_LAS __attribute__((address_space(3)))
typedef unsigned short bf16_t;
typedef short bf16x8 __attribute__((ext_vector_type(8)));
typedef float f32x4 __attribute__((ext_vector_type(4)));
typedef unsigned u32x4 __attribute__((ext_vector_type(4)));
constexpr int BM = 256, BK = 64, HALF = 128, HTB = HALF * BK * 2  , STAGE_BYTES = 8 * HTB, NXCD = 8, WGM = 8;

__host__ __device__ __forceinline__ int lds_byte(int r, int c) { const int st = (r >> 4) * 2 + (c >> 5), rr = r & 15, cc = c & 31, ob = rr * 64 + cc * 2; return st * 1024 + (ob ^ (((ob >> 9) & 1) << 5)); }
__host__ __device__ __forceinline__ void stage_rc(int b, int& R, int& C) { const int st = b / 1024, sb = b % 1024, swz = sb ^ (((sb >> 9) & 1) << 5); R = (st >> 1) * 16 + swz / 64; C = (st & 1) * 32 + (swz % 64) / 2; }
__host__ __device__ __forceinline__ int perm32(int rho) { const int n = rho >> 4, i = rho & 15; return 8 * (i >> 2) + 4 * n + (i & 3); }

struct Unit { int pm, pn; };
struct Gemm { const bf16_t* A; const bf16_t* Bt; int M, N, K; };

struct StaticOrder {
    int nM, nN, nwg, G, c;
    __host__ __device__ void init(int M, int N, int G_, int c_) { nM = M / BM; nN = N / BM; nwg = nM * nN; G = G_; c = c_; }
    __host__ __device__ bool next(int i, Unit& u) const {
        const long L = (long)i * G + c; if (L >= nwg) return false;
        int wgid = (int)L; { const int q = nwg / NXCD, r = nwg % NXCD, xcd = wgid % NXCD, off = wgid / NXCD; wgid = (xcd < r ? xcd * (q + 1) : r * (q + 1) + (xcd - r) * q) + off; }
        const int nig = WGM * nN, gid = wgid / nig, fm = gid * WGM, gsz = (nM - fm) < WGM ? (nM - fm) : WGM;
        u.pm = fm + ((wgid % nig) % gsz); u.pn = (wgid % nig) / gsz; return true;
    }
    __device__ __forceinline__ void a_ready(const Unit&) const {}
    __device__ __forceinline__ void done(const Unit&) const {}
};

__device__ __forceinline__ unsigned cvt_pk_bf16(float lo, float hi) { unsigned r; asm volatile("v_cvt_pk_bf16_f32 %0, %1, %2" : "=v"(r) : "v"(lo), "v"(hi)); return r; }
typedef float f32x2 __attribute__((ext_vector_type(2)));
__device__ __forceinline__ f32x2 gelu_pk(f32x2 v) {
    const f32x2 av = __builtin_elementwise_abs(v), d = av * 0.2316418882f + 1.0f;
    f32x2 t; t.x = __builtin_amdgcn_rcpf(d.x); t.y = __builtin_amdgcn_rcpf(d.y);
    f32x2 q = t * 0.5307027145f + (-0.7265760135f); q = q * t + 0.7107068705f; q = q * t + (-0.142248368f); q = q * t + 0.127414796f; q = q * t;
    const f32x2 s = (v * v) * (-0.72134752044f);
    f32x2 e; e.x = __builtin_amdgcn_exp2f(s.x); e.y = __builtin_amdgcn_exp2f(s.y);
    const f32x2 m = v * (q * e), r = v - m;
    f32x2 o; o.x = v.x < 0.f ? m.x : r.x; o.y = v.y < 0.f ? m.y : r.y; return o;
}

#ifndef PG8_STMODE
#define PG8_STMODE 0
#endif
#if PG8_STMODE == 1
#define PG8_ST16(p, v) asm volatile("global_store_dwordx4 %0, %1, off sc1\n\ts_nop 1" :: "v"(p), "v"(v) : "memory")
#elif PG8_STMODE == 2
#define PG8_ST16(p, v) asm volatile("global_store_dwordx4 %0, %1, off nt\n\ts_nop 1" :: "v"(p), "v"(v) : "memory")
#elif PG8_STMODE == 4
#define PG8_ST16(p, v) asm volatile("global_store_dwordx4 %0, %1, off\n\ts_nop 1" :: "v"(p), "v"(v) : "memory")
#elif PG8_STMODE == 3
#define PG8_ST16(p, v) asm volatile("global_store_dwordx4 %0, %1, off sc0 sc1\n\ts_nop 1" :: "v"(p), "v"(v) : "memory")
#else
#define PG8_ST16(p, v) (*(u32x4*)(p) = (v))
#endif
template <int ACT  > struct EpiBf16 {
    static constexpr int NST = 16;
    static constexpr bool PERM = true, AFTER_DRAIN = false; static_assert(ACT == 0 || ACT == 1, "EpiBf16: ACT is 0 (none) or 1 (gelu_pk)");
    bf16_t* O; int ldc; const float* bias; int split_cols; size_t split_stride; float scale0; int skip; bf16_t* scratch;
    __device__ __forceinline__ void operator()(const f32x4 (&acc)[2][2][4][2], const Unit& u, int wr, int wc, int fr, int fq) const {
        if (skip == 1) return;
        const int row0 = u.pm * BM + wr * 64 + fr; int colt = u.pn * BM; bf16_t* base = O;
        float sc = 1.f; if (split_cols) { const int t = colt / split_cols; base += (size_t)t * split_stride; colt -= t * split_cols; if (t == 0) sc = scale0; }
        const int col0 = colt + wc * 32 + 8 * fq, bcol0 = u.pn * BM + wc * 32 + 8 * fq;
        f32x4 bv[2][2];
#pragma unroll
        for (int bj = 0; bj < 2; ++bj)
#pragma unroll
            for (int n = 0; n < 2; ++n) bv[bj][n] = bias ? *(const f32x4*)(bias + bcol0 + bj * HALF + 4 * n) : (f32x4){0.f, 0.f, 0.f, 0.f};
#pragma unroll
        for (int ai = 0; ai < 2; ++ai)
#pragma unroll
            for (int m = 0; m < 4; ++m) { bf16_t* rowp = base + (size_t)(row0 + ai * HALF + m * 16) * ldc + col0; int bjs = HALF;
                if (skip == 2) { rowp = scratch + ((size_t)((((u.pm * 8 + u.pn) & 1023) * 8 + wr * 4 + wc) * 16 + (ai * 4 + m) * 2)) * 512 + (fq * 16 + fr) * 8; bjs = 512; }
#pragma unroll
                for (int bj = 0; bj < 2; ++bj) { f32x4 v0 = acc[ai][bj][m][0] + bv[bj][0], v1 = acc[ai][bj][m][1] + bv[bj][1];
                    if (ACT == 1) { f32x2 a = gelu_pk((f32x2){v0[0], v0[1]}), b = gelu_pk((f32x2){v0[2], v0[3]}), c = gelu_pk((f32x2){v1[0], v1[1]}), d = gelu_pk((f32x2){v1[2], v1[3]});
                        v0 = (f32x4){a.x, a.y, b.x, b.y}; v1 = (f32x4){c.x, c.y, d.x, d.y}; }
                    v0 = v0 * sc; v1 = v1 * sc; u32x4 w; w.x = cvt_pk_bf16(v0[0], v0[1]); w.y = cvt_pk_bf16(v0[2], v0[3]); w.z = cvt_pk_bf16(v1[0], v1[1]); w.w = cvt_pk_bf16(v1[2], v1[3]);
                    PG8_ST16(rowp + bj * bjs, w); } }
    }
};
template <class Epi, class Sched, bool ALIGN_EPI = false, bool SP2 = false>
__device__ __forceinline__ void gemm_phase(PG8_LAS unsigned char* lds, const Gemm g, const Sched& S, const Epi& E) {
    int tid = threadIdx.x; asm volatile("" : "+v"(tid));
    const int wid = __builtin_amdgcn_readfirstlane(tid >> 6), lane = tid & 63, wr = wid >> 2, wc = wid & 3, fr = lane & 15, fq = lane >> 4;
    const int K = g.K, nt = K / BK;
    unsigned voffA[2], voffB[2];
#pragma unroll
    for (int i = 0; i < 2; ++i) { int R, C; stage_rc(tid * 16 + i * 8192, R, C); const int Rb = Epi::PERM ? ((R & ~31) + perm32(R & 31)) : R;
        voffA[i] = (unsigned)(R * K + C) * 2u; voffB[i] = (unsigned)(Rb * K + C) * 2u; }
    const size_t kstep = (size_t)(BK * 2);
    const size_t hstep = (size_t)HALF * K * 2;
    const size_t tstep = 2 * hstep;
    const unsigned ldsw = (unsigned)wid * 1024u;
    const int aoff = lds_byte(wr * 64 + fr, fq * 8), boff = lds_byte(wc * 32 + fr, fq * 8);
#define PG8_SA(b, h) (((b) * 2 + (h)) * HTB)
#define PG8_SB(b, h) ((4 + (b) * 2 + (h)) * HTB)
#define PG8_STAGE(bufoff, gbase, voff) do { _Pragma("unroll") for (int _i = 0; _i < 2; ++_i) \
        __builtin_amdgcn_global_load_lds((const unsigned*)((const char*)(gbase) + (voff)[_i]), (PG8_LAS unsigned*)(lds + (bufoff) + ldsw + _i * 8192), 16, 0, 0); } while (0)
#define PG8_LDA(dst, b, h) do { _Pragma("unroll") for (int m = 0; m < 4; ++m) _Pragma("unroll") for (int k = 0; k < 2; ++k) dst[m][k] = *(const PG8_LAS bf16x8*)(lds + PG8_SA(b, h) + aoff + m * 2048 + k * 1024); } while (0)
#define PG8_LDB(dst, b, h) do { _Pragma("unroll") for (int n = 0; n < 2; ++n) _Pragma("unroll") for (int k = 0; k < 2; ++k) dst[n][k] = *(const PG8_LAS bf16x8*)(lds + PG8_SB(b, h) + boff + n * 2048 + k * 1024); } while (0)
#define PG8_MMA(ai, bj, At, Bt) do { __builtin_amdgcn_s_setprio(1); _Pragma("unroll") for (int m = 0; m < 4; ++m) _Pragma("unroll") for (int n = 0; n < 2; ++n) _Pragma("unroll") for (int k = 0; k < 2; ++k) \
        acc[ai][bj][m][n] = __builtin_amdgcn_mfma_f32_16x16x32_bf16(Bt[n][k], At[m][k], acc[ai][bj][m][n], 0, 0, 0); __builtin_amdgcn_s_setprio(0); } while (0)
#define PG8_WAIT_V(n) asm volatile("s_waitcnt vmcnt(" #n ")" ::: "memory")
#define PG8_WAIT_L(n) asm volatile("s_waitcnt lgkmcnt(" #n ")" ::: "memory")
#define PG8_BAR __builtin_amdgcn_s_barrier()
#define PG8_SCHED __builtin_amdgcn_sched_barrier(0)
    Unit cur, nxt; int ui = 0;
    if (!S.next(0, cur)) return;
    f32x4 acc[2][2][4][2];
#pragma unroll
    for (int a = 0; a < 2; ++a)
#pragma unroll
        for (int b = 0; b < 2; ++b)
#pragma unroll
            for (int m = 0; m < 4; ++m)
#pragma unroll
                for (int n = 0; n < 2; ++n) acc[a][b][m][n] = (f32x4){0.f, 0.f, 0.f, 0.f};
    bf16x8 At[4][2], B0[2][2], B1[2][2];
    const char* cA = (const char*)g.A + (size_t)cur.pm * tstep; const char* cB = (const char*)g.Bt + (size_t)cur.pn * tstep;
    S.a_ready(cur);
    if constexpr (SP2) {
        PG8_STAGE(PG8_SB(0, 0), cB, voffB); PG8_STAGE(PG8_SB(0, 1), cB + hstep, voffB); PG8_STAGE(PG8_SA(0, 0), cA, voffA); PG8_STAGE(PG8_SA(0, 1), cA + hstep, voffA);
        if (wr == 1) PG8_BAR;
        PG8_WAIT_V(2); PG8_BAR;
        PG8_STAGE(PG8_SB(1, 0), cB + kstep, voffB); PG8_STAGE(PG8_SA(1, 0), cA + kstep, voffA); PG8_STAGE(PG8_SB(1, 1), cB + hstep + kstep, voffB);
        PG8_WAIT_V(6); PG8_BAR;
    } else {
        PG8_STAGE(PG8_SB(0, 0), cB, voffB); PG8_STAGE(PG8_SA(0, 0), cA, voffA); PG8_STAGE(PG8_SB(0, 1), cB + hstep, voffB); PG8_STAGE(PG8_SA(0, 1), cA + hstep, voffA);
        if (wr == 1) PG8_BAR;
        PG8_WAIT_V(4); PG8_BAR;
        PG8_STAGE(PG8_SB(1, 0), cB + kstep, voffB); PG8_STAGE(PG8_SA(1, 0), cA + kstep, voffA); PG8_STAGE(PG8_SB(1, 1), cB + hstep + kstep, voffB);
        PG8_WAIT_V(6); PG8_BAR;
    }
    for (;;) {
        const bool has_next = S.next(ui + 1, nxt);
        const char* nA = has_next ? (const char*)g.A + (size_t)nxt.pm * tstep : cA; const char* nB = has_next ? (const char*)g.Bt + (size_t)nxt.pn * tstep : cB;
        for (int t = 0; t < nt; t += 2) {
            const bool last = (t == nt - 2);
            const char* a1 = cA + (size_t)(t + 1) * kstep;
            const char* a2 = last ? nA : cA + (size_t)(t + 2) * kstep; const char* b2 = last ? nB : cB + (size_t)(t + 2) * kstep;
            const char* a3 = a2 + kstep; const char* b3 = b2 + kstep;
            if (last && has_next) S.a_ready(nxt);
            if constexpr (SP2) {
            PG8_LDB(B0, 0, 0); PG8_LDB(B1, 0, 1); PG8_SCHED; PG8_LDA(At, 0, 0); PG8_STAGE(PG8_SA(1, 1), a1 + hstep, voffA);
            PG8_WAIT_V(8); PG8_WAIT_L(0); PG8_BAR; PG8_MMA(0, 0, At, B0); PG8_MMA(0, 1, At, B1); PG8_BAR; PG8_SCHED;
            PG8_LDA(At, 0, 1); PG8_STAGE(PG8_SB(0, 0), b2, voffB); PG8_STAGE(PG8_SB(0, 1), b2 + hstep, voffB); PG8_STAGE(PG8_SA(0, 0), a2, voffA);
            PG8_WAIT_V(8); PG8_WAIT_L(0); PG8_BAR; PG8_MMA(1, 0, At, B0); PG8_MMA(1, 1, At, B1); PG8_BAR; PG8_SCHED;
            PG8_LDB(B0, 1, 0); PG8_LDB(B1, 1, 1); PG8_SCHED; PG8_LDA(At, 1, 0); PG8_STAGE(PG8_SA(0, 1), a2 + hstep, voffA);
            PG8_WAIT_V(8); PG8_WAIT_L(0); PG8_BAR; PG8_MMA(0, 0, At, B0); PG8_MMA(0, 1, At, B1); PG8_BAR; PG8_SCHED;
            PG8_LDA(At, 1, 1); PG8_STAGE(PG8_SB(1, 0), b3, voffB); PG8_STAGE(PG8_SB(1, 1), b3 + hstep, voffB); PG8_STAGE(PG8_SA(1, 0), a3, voffA);
            PG8_WAIT_V(8); PG8_WAIT_L(0); PG8_BAR; PG8_MMA(1, 0, At, B0); PG8_MMA(1, 1, At, B1); PG8_BAR; PG8_SCHED;
            } else {
            PG8_LDB(B0, 0, 0); PG8_SCHED; PG8_LDA(At, 0, 0); PG8_STAGE(PG8_SA(1, 1), a1 + hstep, voffA);
            PG8_WAIT_L(8); PG8_BAR; PG8_WAIT_L(0); PG8_MMA(0, 0, At, B0); PG8_BAR; PG8_SCHED;
            PG8_LDB(B1, 0, 1); PG8_STAGE(PG8_SB(0, 0), b2, voffB);
            PG8_BAR; PG8_WAIT_L(0); PG8_MMA(0, 1, At, B1); PG8_BAR;
            PG8_LDA(At, 0, 1); PG8_STAGE(PG8_SA(0, 0), a2, voffA);
            PG8_BAR; PG8_WAIT_L(0); PG8_MMA(1, 0, At, B0); PG8_BAR; PG8_SCHED;
            PG8_STAGE(PG8_SB(0, 1), b2 + hstep, voffB);
            PG8_WAIT_V(6); PG8_BAR; PG8_MMA(1, 1, At, B1); PG8_BAR;
            PG8_LDB(B0, 1, 0); PG8_SCHED; PG8_LDA(At, 1, 0); PG8_STAGE(PG8_SA(0, 1), a2 + hstep, voffA);
            PG8_WAIT_L(8); PG8_BAR; PG8_WAIT_L(0); PG8_MMA(0, 0, At, B0); PG8_BAR; PG8_SCHED;
            PG8_LDB(B1, 1, 1); PG8_STAGE(PG8_SB(1, 0), b3, voffB);
            PG8_BAR; PG8_WAIT_L(0); PG8_MMA(0, 1, At, B1); PG8_BAR;
            PG8_LDA(At, 1, 1); PG8_STAGE(PG8_SA(1, 0), a3, voffA);
            PG8_BAR; PG8_WAIT_L(0); PG8_MMA(1, 0, At, B0); PG8_BAR; PG8_SCHED;
            PG8_STAGE(PG8_SB(1, 1), b3 + hstep, voffB);
            PG8_WAIT_V(6); PG8_BAR; PG8_MMA(1, 1, At, B1); PG8_BAR;
            }
        }
        if constexpr (ALIGN_EPI) { if (wr == 0) PG8_BAR; }
        if constexpr (!Epi::AFTER_DRAIN) { E(acc, cur, wr, wc, fr, fq); S.done(cur); }
        if (!has_next) break;
#pragma unroll
        for (int a = 0; a < 2; ++a)
#pragma unroll
            for (int b = 0; b < 2; ++b)
#pragma unroll
                for (int m = 0; m < 4; ++m)
#pragma unroll
                    for (int n = 0; n < 2; ++n) acc[a][b][m][n] = (f32x4){0.f, 0.f, 0.f, 0.f};
        cur = nxt; cA = nA; cB = nB; ++ui;
        if constexpr (ALIGN_EPI) { if (wr == 1) PG8_BAR; }
    }
    PG8_WAIT_V(0);
    if constexpr (!ALIGN_EPI) { if (wr == 0) PG8_BAR; }
    PG8_BAR;
    if constexpr (Epi::AFTER_DRAIN) { E.fused(acc, cur, wr, wc, fr, fq, lds, wid, lane); S.done(cur); }
#undef PG8_SA
#undef PG8_SB
#undef PG8_STAGE
#undef PG8_LDA
#undef PG8_LDB
#undef PG8_MMA
#undef PG8_WAIT_V
#undef PG8_WAIT_L
#undef PG8_BAR
#undef PG8_SCHED
}
}
namespace pg8 {
struct EpiSwiglu {
    static constexpr int NST = 8;
    static constexpr bool PERM = true, AFTER_DRAIN = false;
    bf16_t* O; int ldc;
    __device__ __forceinline__ void operator()(const f32x4 (&acc)[2][2][4][2], const Unit& u, int wr, int wc, int fr, int fq) const {
        const int row0 = u.pm * BM + wr * 64 + fr; const int col0 = u.pn * HALF + wc * 32 + 8 * fq;
#pragma unroll
        for (int ai = 0; ai < 2; ++ai)
#pragma unroll
            for (int m = 0; m < 4; ++m) { bf16_t* rowp = O + (size_t)(row0 + ai * HALF + m * 16) * ldc + col0;
                float o[8];
#pragma unroll
                for (int n = 0; n < 2; ++n)
#pragma unroll
                    for (int e = 0; e < 4; ++e) { const float g = acc[ai][0][m][n][e], up = acc[ai][1][m][n][e];
                        o[n * 4 + e] = g * __builtin_amdgcn_rcpf(1.0f + __expf(-g)) * up; }
                u32x4 w; w.x = cvt_pk_bf16(o[0], o[1]); w.y = cvt_pk_bf16(o[2], o[3]); w.z = cvt_pk_bf16(o[4], o[5]); w.w = cvt_pk_bf16(o[6], o[7]);
                PG8_ST16(rowp, w); }
    }
};
}

constexpr int DM = 1024, NBATCH = 32, SEQ = 2048, CTXL = 256, MLAT = NBATCH * SEQ, MCTX = NBATCH * CTXL, MTOT = MLAT + MCTX, FFH = 2816, DEPTH = 4;
constexpr int NMODROW = 33, MODW = 6 * DM;
constexpr int LDS_BYTES = 147456;
constexpr size_t MiB = 1u << 20;
constexpr size_t OFF_MODP = 0;
constexpr size_t OFF_MODS = 26 * MiB;
constexpr size_t OFF_ROPE = 30 * MiB;
constexpr size_t OFF_WS = 32 * MiB;
constexpr size_t OFF_W = 33 * MiB;
constexpr size_t W_FI = 0, W_FO = 44 * MiB, W_AQ = 66 * MiB, W_AO = 72 * MiB, W_BI = 76 * MiB, W_BO = 80 * MiB, W_CQ = 82 * MiB, W_CO = 86 * MiB;
constexpr size_t OFF_XC = 121 * MiB;
constexpr size_t OFF_H = 153 * MiB;
constexpr size_t OFF_Y = 297 * MiB;
constexpr size_t OFF_BIG = 441 * MiB;
constexpr size_t OFF_O = OFF_BIG + 288 * MiB;
constexpr size_t OFF_CTL = OFF_BIG + 432 * MiB;
constexpr size_t CTL_BYTES = 65536;
constexpr size_t OFF_XLB = OFF_CTL + 1 * MiB;
constexpr size_t WS_END = OFF_XLB + 128 * MiB;
constexpr int LDS_XB = LDS_BYTES - 64;

typedef unsigned short bf16;
typedef short bf16x8 __attribute__((ext_vector_type(8)));
typedef short s16x4 __attribute__((ext_vector_type(4)));
typedef float f32x16 __attribute__((ext_vector_type(16)));
typedef float f32x4 __attribute__((ext_vector_type(4)));
typedef float f32x2 __attribute__((ext_vector_type(2)));
typedef unsigned u32x4 __attribute__((ext_vector_type(4)));
typedef unsigned u32x2 __attribute__((ext_vector_type(2)));
#define LAS __attribute__((address_space(3)))

__device__ __forceinline__ unsigned cvtpk(float lo, float hi) { unsigned r; asm volatile("v_cvt_pk_bf16_f32 %0, %1, %2" : "=v"(r) : "v"(lo), "v"(hi)); return r; }
__device__ __forceinline__ float bf2f(short s) { return __uint_as_float(((unsigned)(unsigned short)s) << 16); }
__device__ __forceinline__ float bflo(unsigned w) { return __uint_as_float(w << 16); }
__device__ __forceinline__ float bfhi(unsigned w) { return __uint_as_float(w & 0xffff0000u); }
__device__ __forceinline__ float wave_sum(float v) {
#pragma unroll
    for (int o = 1; o < 64; o <<= 1) v += __shfl_xor(v, o);
    return v;
}

namespace att {
#define SBAR() __builtin_amdgcn_sched_barrier(0)
__device__ __forceinline__ int crow(int r, int hi) { return (r & 3) + 8 * (r >> 2) + 4 * hi; }
template <int DH> __device__ __forceinline__ int kswz(int row, int colB) { return row * (DH * 2) + (colB ^ ((row & 7) << 4)); }
template <int DH> __device__ __forceinline__ int v_st(int k, int c) { const int kk = (k & ~0xC) | ((k & 4) << 1) | ((k & 8) >> 1); return ((kk >> 3) * (DH / 32) + (c >> 5)) * 512 + ((kk & 7) * 32 + (c & 31)) * 2; }
__device__ __forceinline__ int v_rd_base(int lane) { return ((lane & 3) << 3) | (((lane >> 2) & 3) << 6) | (((lane >> 4) & 1) << 5) | (((lane >> 5) & 1) << 8); }
template <int DH> constexpr int v_rd_off(int d0, int ks, int half) { return d0 * 512 + ks * (DH / 32) * 1024 + half * (DH / 32) * 512; }
template <int OFF> __device__ __forceinline__ s16x4 tr_read(int vb) { s16x4 r; asm volatile("ds_read_b64_tr_b16 %0, %1 offset:%2" : "=&v"(r) : "v"(vb), "i"(OFF) : "memory"); return r; }
template <int DH, int D0> __device__ __forceinline__ void pv_one(f32x16& od, int vb, bf16x8 pa0, bf16x8 pa1, bf16x8 pa2, bf16x8 pa3) {
  const s16x4 l0 = tr_read<v_rd_off<DH>(D0, 0, 0)>(vb), h0 = tr_read<v_rd_off<DH>(D0, 0, 1)>(vb), l1 = tr_read<v_rd_off<DH>(D0, 1, 0)>(vb), h1 = tr_read<v_rd_off<DH>(D0, 1, 1)>(vb);
  const s16x4 l2 = tr_read<v_rd_off<DH>(D0, 2, 0)>(vb), h2 = tr_read<v_rd_off<DH>(D0, 2, 1)>(vb), l3 = tr_read<v_rd_off<DH>(D0, 3, 0)>(vb), h3 = tr_read<v_rd_off<DH>(D0, 3, 1)>(vb);
  asm volatile("s_waitcnt lgkmcnt(0)" ::: "memory"); SBAR();
#define PK(L, H) (bf16x8){L[0], L[1], L[2], L[3], H[0], H[1], H[2], H[3]}
  od = __builtin_amdgcn_mfma_f32_32x32x16_bf16(pa0, PK(l0, h0), od, 0, 0, 0);
  od = __builtin_amdgcn_mfma_f32_32x32x16_bf16(pa1, PK(l1, h1), od, 0, 0, 0);
  od = __builtin_amdgcn_mfma_f32_32x32x16_bf16(pa2, PK(l2, h2), od, 0, 0, 0);
  od = __builtin_amdgcn_mfma_f32_32x32x16_bf16(pa3, PK(l3, h3), od, 0, 0, 0);
#undef PK
}
template <int DH> __device__ __forceinline__ void pv_all(f32x16* o, int vb, bf16x8 pa0, bf16x8 pa1, bf16x8 pa2, bf16x8 pa3) {
  pv_one<DH, 0>(o[0], vb, pa0, pa1, pa2, pa3); pv_one<DH, 1>(o[1], vb, pa0, pa1, pa2, pa3);
  if constexpr (DH == 128) { pv_one<DH, 2>(o[2], vb, pa0, pa1, pa2, pa3); pv_one<DH, 3>(o[3], vb, pa0, pa1, pa2, pa3); }
}
template <int DH> struct SC { static constexpr float SCALE = DH == 128 ? 0.088388347648318440f : 0.125f; static constexpr float C = SCALE * 1.4426950408889634f; static constexpr float THRS = 8.f / SCALE; };
template <int DH> __device__ __forceinline__ void partialSM(f32x16& p0, f32x16& p1, float& m_reg, float& mn, float& alpha) {
  constexpr float C = SC<DH>::C;
  float pmax = p0[0];
#pragma unroll
  for (int r = 1; r < 16; ++r) pmax = fmaxf(pmax, p0[r]);
#pragma unroll
  for (int r = 0; r < 16; ++r) pmax = fmaxf(pmax, p1[r]);
  { auto rr = __builtin_amdgcn_permlane32_swap(__float_as_uint(pmax), __float_as_uint(pmax), false, false);
    pmax = fmaxf(__uint_as_float(rr[0]), __uint_as_float(rr[1])); }
  if (__builtin_expect(__all(pmax - m_reg <= SC<DH>::THRS), 1)) { mn = m_reg; alpha = 1.f; }
  else { mn = fmaxf(m_reg, pmax); alpha = __builtin_amdgcn_exp2f((m_reg - mn) * C); m_reg = mn; }
  const float mnC = -mn * C;
#pragma unroll
  for (int r = 0; r < 16; ++r) p0[r] = fmaf(p0[r], C, mnC);
#pragma unroll
  for (int r = 0; r < 16; ++r) p1[r] = fmaf(p1[r], C, mnC);
#pragma unroll
  for (int r = 0; r < 16; ++r) p0[r] = __builtin_amdgcn_exp2f(p0[r]);
}
__device__ __forceinline__ void finishSM(f32x16& p0, f32x16& p1, float alpha, float& l_reg, bf16x8& pa0, bf16x8& pa1, bf16x8& pa2, bf16x8& pa3) {
#pragma unroll
  for (int r = 0; r < 16; ++r) p1[r] = __builtin_amdgcn_exp2f(p1[r]);
  float ps = 0;
#pragma unroll
  for (int r = 0; r < 16; ++r) ps += p0[r];
#pragma unroll
  for (int r = 0; r < 16; ++r) ps += p1[r];
  { auto rr = __builtin_amdgcn_permlane32_swap(__float_as_uint(ps), __float_as_uint(ps), false, false);
    ps = __uint_as_float(rr[0]) + __uint_as_float(rr[1]); }
  l_reg = l_reg * alpha + ps;
#define PK4(P, BASE, OUT) do { unsigned a0 = cvtpk(P[BASE + 0], P[BASE + 1]), a1 = cvtpk(P[BASE + 2], P[BASE + 3]);   \
    unsigned b0 = cvtpk(P[BASE + 4], P[BASE + 5]), b1 = cvtpk(P[BASE + 6], P[BASE + 7]);                              \
    auto r0 = __builtin_amdgcn_permlane32_swap(a0, b0, false, false); auto r1 = __builtin_amdgcn_permlane32_swap(a1, b1, false, false); \
    u32x4 w = {r0[0], r1[0], r0[1], r1[1]}; OUT = *reinterpret_cast<bf16x8*>(&w); } while (0)
  PK4(p0, 0, pa0); PK4(p0, 8, pa1); PK4(p1, 0, pa2); PK4(p1, 8, pa3);
#undef PK4
}
template <int DH> __device__ __forceinline__ void qkt(f32x16& p0, f32x16& p1, const char* Ks, const bf16x8* qr, int r32, int hi) {
  p0 = f32x16{}; p1 = f32x16{};
#pragma unroll
  for (int d0 = 0; d0 < DH / 16; ++d0) { const int cb = (d0 * 16 + hi * 8) * 2;
    const bf16x8 b0 = *reinterpret_cast<const bf16x8*>(Ks + kswz<DH>(r32, cb));
    const bf16x8 b1 = *reinterpret_cast<const bf16x8*>(Ks + kswz<DH>(32 + r32, cb));
    p0 = __builtin_amdgcn_mfma_f32_32x32x16_bf16(b0, qr[d0], p0, 0, 0, 0);
    p1 = __builtin_amdgcn_mfma_f32_32x32x16_bf16(b1, qr[d0], p1, 0, 0, 0); }
}
__device__ __forceinline__ void wmask(f32x16& p0, f32x16& p1, int kp0, int qp, int hi) {
  const int d0 = kp0 + 4 * hi - qp;
#pragma unroll
  for (int r = 0; r < 16; ++r) { const int d = d0 + (r & 3) + 8 * (r >> 2); if (d > 128 || d < -128) p0[r] = -1e30f; if (d + 32 > 128 || d + 32 < -128) p1[r] = -1e30f; }
}
struct UnitDesc {
  const bf16* Q; const bf16* Kc; const bf16* Vc; bf16* O;
  long ctx_row0, lat_row0; int nctx, band_kp0, NT, qpos0;
  const float* cosT; const float* sinT; const float* qg; float sink_l2;
};
template <int DH, int PITCH, bool QKNORM, bool MASK>
__device__ __forceinline__ void attn_unit(const UnitDesc& u, char* lds) {
  constexpr int NB = DH / 16, NO = DH / 32, TB = 64 * DH * 2, NLD = DH / 64, SDEPTH = DH == 128 ? 1 : 2;
  int tid = threadIdx.x; asm volatile("" : "+v"(tid));
  const int wid = tid >> 6, lane = tid & 63, r32 = lane & 31, hi = lane >> 5;
  char* V_lds = lds; char* K_lds = lds + 2 * TB;
  float* ws = (float*)(lds + 4 * TB) + wid * 64; float* li_l = ws; float* al_l = ws + 32;
  float m_reg = -1e30f, l_reg = 0; f32x16 o[NO];
#pragma unroll
  for (int d = 0; d < NO; ++d) o[d] = f32x16{};
  bf16x8 qr[NB];
  {
    const bf16* Qw = u.Q + (long)(wid * 32 + r32) * PITCH + hi * 8;
    float qf[NB][8];
#pragma unroll
    for (int d0 = 0; d0 < NB; ++d0) { const bf16x8 raw = *reinterpret_cast<const bf16x8*>(Qw + d0 * 16);
#pragma unroll
      for (int j = 0; j < 8; ++j) qf[d0][j] = bf2f(raw[j]); }
    if constexpr (QKNORM) {
      float ss = 0.f;
#pragma unroll
      for (int d0 = 0; d0 < NB; ++d0)
#pragma unroll
        for (int j = 0; j < 8; ++j) ss += qf[d0][j] * qf[d0][j];
      ss += __shfl_xor(ss, 32);
      const float rstd = rsqrtf(ss * (1.0f / DH) + 1e-6f);
#pragma unroll
      for (int d0 = 0; d0 < NB; ++d0) { const f32x4 g0 = *(const f32x4*)(u.qg + d0 * 16 + hi * 8), g1 = *(const f32x4*)(u.qg + d0 * 16 + hi * 8 + 4);
#pragma unroll
        for (int j = 0; j < 4; ++j) { qf[d0][j] *= rstd * g0[j]; qf[d0][4 + j] *= rstd * g1[j]; } }
    }
    if (u.qpos0 >= 0) {
      const int pos = u.qpos0 + wid * 32 + r32;
      const float* cp = u.cosT + (long)pos * (DH / 2) + hi * 8; const float* sp = u.sinT + (long)pos * (DH / 2) + hi * 8;
#pragma unroll
      for (int d0 = 0; d0 < NB / 2; ++d0) {
        const f32x4 c0 = *(const f32x4*)(cp + d0 * 16), c1 = *(const f32x4*)(cp + d0 * 16 + 4), s0 = *(const f32x4*)(sp + d0 * 16), s1 = *(const f32x4*)(sp + d0 * 16 + 4);
#pragma unroll
        for (int j = 0; j < 8; ++j) { const float c = j < 4 ? c0[j & 3] : c1[j & 3], s = j < 4 ? s0[j & 3] : s1[j & 3];
          const float x1 = qf[d0][j], x2 = qf[d0 + NB / 2][j]; qf[d0][j] = x1 * c - x2 * s; qf[d0 + NB / 2][j] = x2 * c + x1 * s; }
      }
    }
#pragma unroll
    for (int d0 = 0; d0 < NB; ++d0) { u32x4 w = {cvtpk(qf[d0][0], qf[d0][1]), cvtpk(qf[d0][2], qf[d0][3]), cvtpk(qf[d0][4], qf[d0][5]), cvtpk(qf[d0][6], qf[d0][7])}; qr[d0] = *reinterpret_cast<bf16x8*>(&w); }
  }
  const int sr = DH == 128 ? (tid >> 4) : (tid >> 3), sc = DH == 128 ? (tid & 15) * 8 : (tid & 7) * 8;
  const int vb0 = (int)(uintptr_t)V_lds + v_rd_base(lane);
  struct { bf16x8 v[NLD], k[NLD]; } st_[SDEPTH];
  const int qp = u.qpos0 + wid * 32 + r32;
#define TROW(t) ((t) < u.nctx ? u.ctx_row0 + 64 * (t) : u.lat_row0 + u.band_kp0 + 64 * ((t) - u.nctx))
#define TKP(t) (u.band_kp0 + 64 * ((t) - u.nctx))
#define SLOAD(i, t) do { const long row_ = TROW(t); _Pragma("unroll") for (int l_ = 0; l_ < NLD; ++l_) { \
    st_[i].v[l_] = *reinterpret_cast<const bf16x8*>(u.Vc + (row_ + sr + 32 * l_) * PITCH + sc); st_[i].k[l_] = *reinterpret_cast<const bf16x8*>(u.Kc + (row_ + sr + 32 * l_) * PITCH + sc); } } while (0)
#define SWRITE(b, i) do { _Pragma("unroll") for (int l_ = 0; l_ < NLD; ++l_) { *(bf16x8*)(V_lds + (b) * TB + v_st<DH>(sr + 32 * l_, sc)) = st_[i].v[l_]; \
    *(bf16x8*)(K_lds + (b) * TB + kswz<DH>(sr + 32 * l_, sc * 2)) = st_[i].k[l_]; } } while (0)
#define SWAIT() do { if constexpr (SDEPTH == 1) asm volatile("s_waitcnt vmcnt(0)" ::: "memory"); else if constexpr (NLD == 2) asm volatile("s_waitcnt vmcnt(4)" ::: "memory"); else asm volatile("s_waitcnt vmcnt(2)" ::: "memory"); } while (0)
#define RESC(a) do { if (__any((a) < 1.f)) { if (hi == 0) al_l[r32] = (a); asm volatile("s_waitcnt lgkmcnt(0)" ::: "memory"); \
    _Pragma("unroll") for (int d = 0; d < NO; ++d) _Pragma("unroll") for (int r = 0; r < 16; ++r) o[d][r] *= al_l[crow(r, hi)]; } } while (0)
#define AMASK(P0, P1, t) do { if constexpr (MASK) { if ((t) >= u.nctx && (TKP(t) < qw - 97 || TKP(t) + 63 > qw + 128)) wmask(P0, P1, TKP(t), qp, hi); } } while (0)
  f32x16 pA0, pA1, pB0, pB1; float mnA, mnB, alA, alB; bf16x8 pa0, pa1, pa2, pa3; const int NT = u.NT;
  constexpr int SE = 0, SO = SDEPTH - 1;
  const int qw = __builtin_amdgcn_readfirstlane(u.qpos0 + wid * 32);
#define ACT(t) (!MASK || (t) < u.nctx || (TKP(t) <= qw + 159 && TKP(t) + 63 >= qw - 128))
  bool actA = true, actB = true;
  SLOAD(SE, 0); asm volatile("s_waitcnt vmcnt(0)" ::: "memory"); SWRITE(0, SE); __syncthreads();
  qkt<DH>(pA0, pA1, K_lds, qr, r32, hi); AMASK(pA0, pA1, 0); partialSM<DH>(pA0, pA1, m_reg, mnA, alA);
  SLOAD(SO, 1); if constexpr (SDEPTH == 2) { if (2 < NT) SLOAD(SE, 2); }
  SWAIT(); SWRITE(1, SO); __syncthreads();
  for (int j = 1; j + 1 < NT; j += 2) {
    actB = ACT(j);
    SBAR(); if (actB) { qkt<DH>(pB0, pB1, K_lds + TB, qr, r32, hi); AMASK(pB0, pB1, j); }
    if (actA) finishSM(pA0, pA1, alA, l_reg, pa0, pa1, pa2, pa3); SBAR();
    SLOAD(SO, j + SDEPTH); SBAR();
    if (actA) pv_all<DH>(o, vb0, pa0, pa1, pa2, pa3);
    if (actB) partialSM<DH>(pB0, pB1, m_reg, mnB, alB); else alB = 1.f;
    __syncthreads(); SWAIT(); SWRITE(0, SE);
    RESC(alB); __syncthreads();
    actA = ACT(j + 1);
    SBAR(); if (actA) { qkt<DH>(pA0, pA1, K_lds, qr, r32, hi); AMASK(pA0, pA1, j + 1); }
    if (actB) finishSM(pB0, pB1, alB, l_reg, pa0, pa1, pa2, pa3); SBAR();
    if (SDEPTH == 1 || j + 3 < NT) SLOAD(SE, j + 1 + SDEPTH); SBAR();
    if (actB) pv_all<DH>(o, vb0 + TB, pa0, pa1, pa2, pa3);
    if (actA) partialSM<DH>(pA0, pA1, m_reg, mnA, alA); else alA = 1.f;
    __syncthreads(); SWAIT(); SWRITE(1, SO);
    RESC(alA); __syncthreads();
  }
  actB = ACT(NT - 1);
  SBAR(); if (actB) { qkt<DH>(pB0, pB1, K_lds + TB, qr, r32, hi); AMASK(pB0, pB1, NT - 1); }
  if (actA) finishSM(pA0, pA1, alA, l_reg, pa0, pa1, pa2, pa3); SBAR();
  if (actA) pv_all<DH>(o, vb0, pa0, pa1, pa2, pa3);
  if (actB) partialSM<DH>(pB0, pB1, m_reg, mnB, alB); else alB = 1.f;
  __syncthreads(); RESC(alB);
  if (actB) { finishSM(pB0, pB1, alB, l_reg, pa0, pa1, pa2, pa3); SBAR();
    pv_all<DH>(o, vb0 + TB, pa0, pa1, pa2, pa3); }
#undef ACT
  l_reg += __builtin_amdgcn_exp2f(u.sink_l2 - m_reg * SC<DH>::C);
  if (hi == 0) li_l[r32] = l_reg; asm volatile("s_waitcnt lgkmcnt(0)" ::: "memory");
  float rli[16];
#pragma unroll
  for (int r = 0; r < 16; ++r) rli[r] = __builtin_amdgcn_rcpf(li_l[crow(r, hi)]);
  { bf16* stg = (bf16*)(lds + 4 * TB + 2048) + wid * (32 * DH);
#pragma unroll
    for (int r = 0; r < 16; ++r) { const int orow = crow(r, hi);
#pragma unroll
      for (int d0 = 0; d0 < NO; ++d0) { const float v = o[d0][r] * rli[r]; const unsigned w = cvtpk(v, v); stg[orow * DH + d0 * 32 + r32] = (bf16)(w & 0xffffu); } }
    asm volatile("s_waitcnt lgkmcnt(0)" ::: "memory");
    constexpr int CPR = DH / 8, RPI = 64 / CPR;
    bf16* Ow = u.O + (long)(wid * 32) * DM;
#pragma unroll
    for (int i = 0; i < 32 / RPI; ++i) { const int row = i * RPI + lane / CPR, ch = lane % CPR; const u32x4 v = *(const u32x4*)(stg + row * DH + ch * 8); *(u32x4*)(Ow + (long)row * DM + ch * 8) = v; } }
  __syncthreads();
#undef TROW
#undef TKP
#undef SLOAD
#undef SWRITE
#undef SWAIT
#undef RESC
#undef AMASK
}
}

__device__ __forceinline__ void transpose_item(const float* W, int K, int N, bf16* WT, int k0, int n0, int drow0, LAS float* scr, int lane) {
    float tv[32];
#pragma unroll
    for (int i = 0; i < 32; ++i) tv[i] = W[(size_t)(k0 + 2 * i + (lane >> 5)) * N + n0 + (lane & 31)];
#pragma unroll
    for (int i = 0; i < 32; ++i) scr[(2 * i + (lane >> 5)) * 33 + (lane & 31)] = tv[i];
    asm volatile("s_waitcnt lgkmcnt(0)" ::: "memory");
    const int c = lane & 7;
#pragma unroll
    for (int j = 0; j < 4; ++j) { const int n = (lane >> 3) + 8 * j; const LAS float* s = scr + (8 * c) * 33 + n;
        u32x4 o; o.x = cvtpk(s[0 * 33], s[1 * 33]); o.y = cvtpk(s[2 * 33], s[3 * 33]); o.z = cvtpk(s[4 * 33], s[5 * 33]); o.w = cvtpk(s[6 * 33], s[7 * 33]);
        *(u32x4*)(WT + (size_t)(drow0 + n) * K + k0 + 8 * c) = o; }
    asm volatile("s_waitcnt lgkmcnt(0)" ::: "memory");
}
__device__ __forceinline__ int ffn_in_row(int n0) { return n0 < FFH ? 256 * (n0 >> 7) + (n0 & 127) : 256 * ((n0 - FFH) >> 7) + 128 + ((n0 - FFH) & 127); }

struct RowJob { const float* xin; const bf16* y; float* xout; bf16* h; const float* gate; const float* sh; const float* sc; };
template <int NR, bool HASY, bool HASH>
__device__ __forceinline__ void combine_rows(const RowJob (&J)[NR], const float* npost, const float* npre, int lane, float gmul) {
    f32x4 xv[NR][4]; u32x2 yv[NR][4];
#pragma unroll
    for (int q = 0; q < NR; ++q)
#pragma unroll
        for (int j = 0; j < 4; ++j) { xv[q][j] = ((const f32x4*)J[q].xin)[lane + 64 * j]; if constexpr (HASY) yv[q][j] = ((const u32x2*)J[q].y)[lane + 64 * j]; }
    if constexpr (HASY) {
        float rstd[NR];
#pragma unroll
        for (int q = 0; q < NR; ++q) { float ss = 0.f;
#pragma unroll
            for (int j = 0; j < 4; ++j) { const float a = bflo(yv[q][j].x), b = bfhi(yv[q][j].x), c = bflo(yv[q][j].y), d = bfhi(yv[q][j].y); ss += (a * a + b * b) + (c * c + d * d); }
            rstd[q] = rsqrtf(wave_sum(ss) * (1.0f / DM) + 1e-6f) * gmul; }
#pragma unroll
        for (int j = 0; j < 4; ++j) { const f32x4 n4 = ((const f32x4*)npost)[lane + 64 * j];
#pragma unroll
            for (int q = 0; q < NR; ++q) { const f32x4 g4 = ((const f32x4*)J[q].gate)[lane + 64 * j];
                const f32x4 yf = {bflo(yv[q][j].x), bfhi(yv[q][j].x), bflo(yv[q][j].y), bfhi(yv[q][j].y)};
                xv[q][j] = xv[q][j] + g4 * (yf * rstd[q] * n4);
                ((f32x4*)J[q].xout)[lane + 64 * j] = xv[q][j]; } }
    }
    if constexpr (HASH) {
        float rstd[NR];
#pragma unroll
        for (int q = 0; q < NR; ++q) { float ss = 0.f;
#pragma unroll
            for (int j = 0; j < 4; ++j) ss += (xv[q][j].x * xv[q][j].x + xv[q][j].y * xv[q][j].y) + (xv[q][j].z * xv[q][j].z + xv[q][j].w * xv[q][j].w);
            rstd[q] = rsqrtf(wave_sum(ss) * (1.0f / DM) + 1e-6f); }
#pragma unroll
        for (int j = 0; j < 4; ++j) { const f32x4 n4 = ((const f32x4*)npre)[lane + 64 * j];
#pragma unroll
            for (int q = 0; q < NR; ++q) { const f32x4 s4 = ((const f32x4*)J[q].sc)[lane + 64 * j], b4 = ((const f32x4*)J[q].sh)[lane + 64 * j];
                const f32x4 hv = (xv[q][j] * rstd[q] * n4) * (s4 + 1.0f) + b4;
                u32x2 w; w.x = cvtpk(hv.x, hv.y); w.y = cvtpk(hv.z, hv.w); ((u32x2*)J[q].h)[lane + 64 * j] = w; } }
    }
}

#ifndef CNR
#define CNR 2
#endif
template <bool HASY, bool HASH, bool XIN32 = true, bool XOUT32 = true>
__device__ __forceinline__ void combine_span(int mb, int me, const void* xin_lat, const void* xin_ctx, void* xout_lat, void* xout_ctx, const bf16* Y, bf16* H,
                                             const float* gate0, const float* npost, const float* sh0, const float* sc0, const float* npre, int lane, float gmul) {
    int cur_r = -1; f32x4 A1[4], A2[4], B2[4];
    for (int m = mb; m < me;) {
        const int r = m < MLAT ? (m >> 11) : 32;
        if (r != cur_r) { cur_r = r;
#pragma unroll
            for (int j = 0; j < 4; ++j) {
                if constexpr (HASY) A1[j] = ((const f32x4*)(gate0 + (size_t)r * MODW))[lane + 64 * j] * ((const f32x4*)npost)[lane + 64 * j] * gmul;
                if constexpr (HASH) { A2[j] = ((const f32x4*)npre)[lane + 64 * j] * (((const f32x4*)(sc0 + (size_t)r * MODW))[lane + 64 * j] + 1.0f); B2[j] = ((const f32x4*)(sh0 + (size_t)r * MODW))[lane + 64 * j]; } } }
        int nv = 1;
#pragma unroll
        for (int q = 1; q < CNR; ++q) { const int mn = m + q; if (nv == q && mn < me && (mn < MLAT ? (mn >> 11) : 32) == r) nv = q + 1; }
        int mq[CNR];
#pragma unroll
        for (int q = 0; q < CNR; ++q) mq[q] = q < nv ? m + q : m;
        f32x4 xv[CNR][4]; u32x2 yv[CNR][4];
#pragma unroll
        for (int q = 0; q < CNR; ++q) { const int mm = mq[q]; const size_t eo = mm < MLAT ? (size_t)mm * DM : (size_t)(mm - MLAT) * DM; const void* xb = mm < MLAT ? xin_lat : xin_ctx;
#pragma unroll
            for (int j = 0; j < 4; ++j) {
                if constexpr (XIN32) xv[q][j] = __builtin_nontemporal_load((const f32x4*)((const float*)xb + eo) + lane + 64 * j);
                else { const u32x2 w = __builtin_nontemporal_load((const u32x2*)((const bf16*)xb + eo) + lane + 64 * j); xv[q][j] = (f32x4){bflo(w.x), bfhi(w.x), bflo(w.y), bfhi(w.y)}; }
                if constexpr (HASY) yv[q][j] = __builtin_nontemporal_load((const u32x2*)(Y + (size_t)mm * DM) + lane + 64 * j); } }
        if constexpr (HASY) {
            float rstd[CNR];
#pragma unroll
            for (int q = 0; q < CNR; ++q) { float ss = 0.f;
#pragma unroll
                for (int j = 0; j < 4; ++j) { const float a = bflo(yv[q][j].x), b = bfhi(yv[q][j].x), c = bflo(yv[q][j].y), d = bfhi(yv[q][j].y); ss += (a * a + b * b) + (c * c + d * d); }
                rstd[q] = rsqrtf(wave_sum(ss) * (1.0f / DM) + 1e-6f); }
#pragma unroll
            for (int q = 0; q < CNR; ++q) { const int mm = mq[q]; const size_t eo = mm < MLAT ? (size_t)mm * DM : (size_t)(mm - MLAT) * DM; void* xb = mm < MLAT ? xout_lat : xout_ctx;
#pragma unroll
                for (int j = 0; j < 4; ++j) { const f32x4 yf = {bflo(yv[q][j].x), bfhi(yv[q][j].x), bflo(yv[q][j].y), bfhi(yv[q][j].y)};
                    xv[q][j] = xv[q][j] + A1[j] * (yf * rstd[q]);
                    if constexpr (XOUT32) __builtin_nontemporal_store(xv[q][j], (f32x4*)((float*)xb + eo) + lane + 64 * j);
                    else { u32x2 w; w.x = cvtpk(xv[q][j].x, xv[q][j].y); w.y = cvtpk(xv[q][j].z, xv[q][j].w); __builtin_nontemporal_store(w, (u32x2*)((bf16*)xb + eo) + lane + 64 * j);
                        xv[q][j] = (f32x4){bflo(w.x), bfhi(w.x), bflo(w.y), bfhi(w.y)}; } } }
        }
        if constexpr (HASH) {
            float rstd[CNR];
#pragma unroll
            for (int q = 0; q < CNR; ++q) { float ss = 0.f;
#pragma unroll
                for (int j = 0; j < 4; ++j) ss += (xv[q][j].x * xv[q][j].x + xv[q][j].y * xv[q][j].y) + (xv[q][j].z * xv[q][j].z + xv[q][j].w * xv[q][j].w);
                rstd[q] = rsqrtf(wave_sum(ss) * (1.0f / DM) + 1e-6f); }
#pragma unroll
            for (int q = 0; q < CNR; ++q) { const int mm = mq[q];
#pragma unroll
                for (int j = 0; j < 4; ++j) { const f32x4 hv = (xv[q][j] * rstd[q]) * A2[j] + B2[j];
                    u32x2 w; w.x = cvtpk(hv.x, hv.y); w.y = cvtpk(hv.z, hv.w); ((u32x2*)(H + (size_t)mm * DM))[lane + 64 * j] = w; } }
        }
        m += nv;
    }
}

#define XB_TMO      128
#define XB_XCNT(j)  (256  + 64 * (j))
#define XB_XSUB(j)  (1280 + 64 * (j))
#define XB_XGEN(j)  (2304 + 64 * (j))
#define XB_TOP      3328
#define XB_TOPGEN   3392
#define XCD_BAR_WORDS 3456
#define XB_SPIN_CAP (1u << 18)

__device__ __forceinline__ unsigned xb_ld(unsigned* p)              { return __hip_atomic_load(p, __ATOMIC_RELAXED, __HIP_MEMORY_SCOPE_AGENT); }
__device__ __forceinline__ unsigned xb_add(unsigned* p, unsigned v) { return __hip_atomic_fetch_add(p, v, __ATOMIC_RELAXED, __HIP_MEMORY_SCOPE_AGENT); }
__device__ __forceinline__ unsigned xb_xcc_id() { return (unsigned)__builtin_amdgcn_s_getreg((3 << 11) | 20) & 0xFu; }
#define XB_SPIN(cond, bar) do { unsigned _sp = 0; while (cond) { __builtin_amdgcn_s_sleep(1); \
    if ((++_sp & 255u) == 0u) { if (xb_ld(&(bar)[XB_TMO])) break; if (_sp > XB_SPIN_CAP) { atomicAdd(&(bar)[XB_TMO], 1u); break; } } } } while (0)

struct XcdBarrier {
    unsigned* bar; unsigned x;
    volatile LAS unsigned* st;
};

__device__ __forceinline__ XcdBarrier xcd_barrier_post(unsigned* bar, volatile LAS unsigned* st) {
    XcdBarrier b; b.bar = bar; b.x = xb_xcc_id(); b.st = st;
    if (threadIdx.x == 0) (void)xb_add(&bar[XB_XCNT(b.x)], 1u);
    return b;
}
__device__ __forceinline__ void xcd_barrier_complete(unsigned* bar, unsigned x, unsigned& nloc, unsigned& nx) {
    const unsigned G = gridDim.x * gridDim.y * gridDim.z;
    unsigned sum, cnt, mine, sp = 0u;
    for (;;) {
        sum = 0u; cnt = 0u; mine = 0u;
#pragma unroll
        for (unsigned j = 0; j < 16; ++j) { const unsigned c = xb_ld(&bar[XB_XCNT(j)]); sum += c; cnt += (c > 0u) ? 1u : 0u; mine = (j == x) ? c : mine; }
        if (sum == G) break;
        __builtin_amdgcn_s_sleep(1);
        if ((++sp & 255u) == 0u) { if (xb_ld(&bar[XB_TMO])) break; if (sp > XB_SPIN_CAP) { atomicAdd(&bar[XB_TMO], 1u); break; } }
    }
    nloc = mine > 0u ? mine : 1u; nx = cnt > 0u ? cnt : 1u;
}

__device__ __forceinline__ void xcd_barrier(const XcdBarrier& b) {
    asm volatile("s_waitcnt vmcnt(0)" ::: "memory");
    __syncthreads();
    if (threadIdx.x == 0) {
        unsigned* bar = b.bar;
        __builtin_amdgcn_s_waitcnt(0);
        unsigned nloc = b.st[0], nx = b.st[1];
        if (nloc == 0u) { xcd_barrier_complete(bar, b.x, nloc, nx); b.st[0] = nloc; b.st[1] = nx; }
        const unsigned old = xb_add(&bar[XB_XSUB(b.x)], 1u);
        const unsigned gen = old / nloc;
        if (old + 1u == (gen + 1u) * nloc) {
            __builtin_amdgcn_fence(__ATOMIC_RELEASE, "agent");
            asm volatile("s_waitcnt vmcnt(0)" ::: "memory");
            const unsigned og = xb_add(&bar[XB_TOP], 1u);
            const unsigned tg = og / nx;
            if (og + 1u == (tg + 1u) * nx) xb_add(&bar[XB_TOPGEN], 1u);
            else XB_SPIN(xb_ld(&bar[XB_TOPGEN]) == tg, bar);
            __builtin_amdgcn_fence(__ATOMIC_ACQUIRE, "agent");
            xb_add(&bar[XB_XGEN(b.x)], 1u);
            asm volatile("s_waitcnt vmcnt(0)" ::: "memory");
        } else {
            XB_SPIN(xb_ld(&bar[XB_XGEN(b.x)]) == gen, bar);
            __builtin_amdgcn_fence(__ATOMIC_ACQUIRE, "agent");
            asm volatile("s_waitcnt vmcnt(0)" ::: "memory");
        }
    }
    __syncthreads();
}

struct Args { const float* in[23]; float* out; unsigned char* ws; int ph_lo, ph_hi; };

__global__ void __launch_bounds__(512, 2) mega(Args args) {
    extern __shared__ __attribute__((aligned(16))) unsigned char lds[];
    cg::grid_group grid = cg::this_grid();
    const int G = gridDim.x, bx = blockIdx.x;
    const int vcu = (G % 8 == 0) ? (bx % 8) * (G / 8) + bx / 8 : bx;
    const int NGW = G * 8;
    const int lo = args.ph_lo, hi = args.ph_hi;
    unsigned char* ws = args.ws;
    const float* x_in = args.in[0]; const float* c_in = args.in[1]; const float* ctx_in = args.in[2]; const float* cctx_in = args.in[3];
    const float* ada_w = args.in[4]; const float* ada_b = args.in[5]; const float* norm_g = args.in[6];
    float* modp = (float*)(ws + OFF_MODP); float* mods = (float*)(ws + OFF_MODS);
    float* cosA = (float*)(ws + OFF_ROPE); float* sinA = cosA + 2048 * 32; float* cosC = sinA + 2048 * 32; float* sinC = cosC + 2048 * 64;
    bf16* Wsb = (bf16*)(ws + OFF_WS);
    unsigned char* Wb = ws + OFF_W;
#ifndef XBF16
#define XBF16 0
#endif
    void* XC = (void*)(ws + OFF_XC); void* XL = XBF16 ? (void*)(ws + OFF_XLB) : (void*)args.out;
    bf16* Hb = (bf16*)(ws + OFF_H); bf16* Yb = (bf16*)(ws + OFF_Y); bf16* QKV = (bf16*)(ws + OFF_BIG); bf16* Ob = (bf16*)(ws + OFF_O); bf16* HID = (bf16*)(ws + OFF_BIG);
    if (threadIdx.x < 16) ((LAS unsigned*)((LAS unsigned char*)lds + LDS_XB))[threadIdx.x] = 0u;
    __syncthreads();
    const XcdBarrier xbar = xcd_barrier_post((unsigned*)(ws + OFF_CTL), (volatile LAS unsigned*)((LAS unsigned char*)lds + LDS_XB));
    bool first_seam = false;
    int ph = 0;
#define GSYNC() do { if (first_seam) { grid.sync(); first_seam = false; } else xcd_barrier(xbar); } while (0)
    first_seam = args.ph_hi < 0;
#ifndef PH_MASK
#define PH_MASK 0xffff
#endif
#define RUN(p) (lo <= (p) && (p) < hi)
#define ON(b) ((PH_MASK >> (b)) & 1)
#ifndef G1MASK
#define G1MASK 7
#endif
#ifndef ATMASK
#define ATMASK 3
#endif
#define ATK(k) ((ATMASK >> (k)) & 1)
#define G1K(k) ((G1MASK >> (k)) & 1)
#define SEAM(p) do { if (RUN(p) && RUN((p) + 1)) GSYNC(); } while (0)

#ifndef NPRO
#define NPRO 1
#endif
#ifndef NPRO_SKIP_TR
#define NPRO_SKIP_TR 0
#endif
#ifndef NPRO_SEL
#define NPRO_SEL 7
#endif
#define PSEL(k) (prep == 0 || ((NPRO_SEL >> (k)) & 1))
#ifndef CMB_F1
#define CMB_F1 5
#endif
#ifndef CMB_F2
#define CMB_F2 6
#endif
#ifndef EPI_SKIP_ON_REP
#define EPI_SKIP_ON_REP 0
#endif
#ifdef EXTRA_SYNCS
    for (int es = 0; es < EXTRA_SYNCS; ++es) GSYNC();
#endif
    for (int prep = 0; prep < NPRO; ++prep) {
    if (prep) { GSYNC(); ph -= 3; }
    int tid = threadIdx.x; asm volatile("" : "+v"(tid));
    const int lane = tid & 63, wave = __builtin_amdgcn_readfirstlane(tid >> 6), gw = vcu * 8 + wave;
    if (ON(0) && RUN(ph) && PSEL(0)) {
        LAS float* scr = (LAS float*)((LAS unsigned char*)lds + wave * 16896);
        for (int it = gw; it < 96 * 8; it += NGW) {
            const int cb = it % 96, ks = it / 96, k0 = ks * 128;
            { float cv[NMODROW][2];
#pragma unroll
              for (int r = 0; r < NMODROW; ++r) { const float* cp = r < 32 ? c_in + r * DM + k0 : cctx_in + k0; cv[r][0] = cp[lane]; cv[r][1] = cp[lane + 64]; }
#pragma unroll
              for (int r = 0; r < NMODROW; ++r) { scr[r * 128 + lane] = cv[r][0] / (1.0f + __expf(-cv[r][0])); scr[r * 128 + lane + 64] = cv[r][1] / (1.0f + __expf(-cv[r][1])); } }
            asm volatile("s_waitcnt lgkmcnt(0)" ::: "memory");
            f32x4 acc[NMODROW];
#pragma unroll
            for (int r = 0; r < NMODROW; ++r) acc[r] = (f32x4){0.f, 0.f, 0.f, 0.f};
            const int li = cb / 24, col0 = (cb % 24) * 256 + lane * 4;
            const float* wp = ada_w + ((size_t)li * DM + k0) * MODW + col0;
#pragma nounroll
            for (int kk = 0; kk < 128; kk += 8) {
                f32x4 w4[8];
#pragma unroll
                for (int u = 0; u < 8; ++u) w4[u] = *(const f32x4*)(wp + (size_t)(kk + u) * MODW);
#pragma unroll
                for (int r = 0; r < NMODROW; ++r) { const f32x4 s0 = *(const LAS f32x4*)(scr + r * 128 + kk), s1 = *(const LAS f32x4*)(scr + r * 128 + kk + 4);
                    acc[r] = acc[r] + w4[0] * s0.x + w4[1] * s0.y + w4[2] * s0.z + w4[3] * s0.w + w4[4] * s1.x + w4[5] * s1.y + w4[6] * s1.z + w4[7] * s1.w; } }
#pragma unroll
            for (int r = 0; r < NMODROW; ++r) *(f32x4*)(modp + ((size_t)ks * NMODROW + r) * (4 * MODW) + li * MODW + col0) = acc[r];
            asm volatile("s_waitcnt lgkmcnt(0)" ::: "memory");
        }
        {
            constexpr int I_FI = 16 * 176, I_FO = 44 * 32, I_AQ = 16 * 48, I_AO = 16 * 32, I_BI = 16 * 64, I_BO = 16 * 32, I_CQ = 16 * 64, I_CO = 16 * 32;
            constexpr int NIT = 4 * I_FI + 4 * I_FO + 2 * I_AQ + 2 * I_AO + I_BI + I_BO + I_CQ + I_CO;
            const int ntw = NGW > 1024 ? NGW - 768 : NGW, tw = NGW > 1024 ? gw - 768 : gw;
            if (tw >= 0 && !(NPRO_SKIP_TR && prep)) for (int it = tw; it < NIT; it += ntw) {
                int r = it;
                if (r < 4 * I_FI) { const int l = r / I_FI; r %= I_FI; const int kb = r / 176, nb = r % 176;
                    transpose_item(args.in[7] + (size_t)l * DM * 2 * FFH, DM, 2 * FFH, (bf16*)(Wb + W_FI) + (size_t)l * 2 * FFH * DM, kb * 64, nb * 32, ffn_in_row(nb * 32), scr, lane); continue; } r -= 4 * I_FI;
                if (r < 4 * I_FO) { const int l = r / I_FO; r %= I_FO; const int kb = r / 32, nb = r % 32;
                    transpose_item(args.in[8] + (size_t)l * FFH * DM, FFH, DM, (bf16*)(Wb + W_FO) + (size_t)l * DM * FFH, kb * 64, nb * 32, nb * 32, scr, lane); continue; } r -= 4 * I_FO;
                if (r < 2 * I_AQ) { const int l = r / I_AQ; r %= I_AQ; const int kb = r / 48, nb = r % 48;
                    transpose_item(args.in[9] + (size_t)l * DM * 1536, DM, 1536, (bf16*)(Wb + W_AQ) + (size_t)l * 1536 * DM, kb * 64, nb * 32, nb * 32, scr, lane); continue; } r -= 2 * I_AQ;
                if (r < 2 * I_AO) { const int l = r / I_AO; r %= I_AO; const int kb = r / 32, nb = r % 32;
                    transpose_item(args.in[10] + (size_t)l * DM * DM, DM, DM, (bf16*)(Wb + W_AO) + (size_t)l * DM * DM, kb * 64, nb * 32, nb * 32, scr, lane); continue; } r -= 2 * I_AO;
                if (r < I_BI) { const int kb = r / 64, nb = r % 64; transpose_item(args.in[12], DM, 2048, (bf16*)(Wb + W_BI), kb * 64, nb * 32, nb * 32, scr, lane); continue; } r -= I_BI;
                if (r < I_BO) { const int kb = r / 32, nb = r % 32; transpose_item(args.in[18], DM, DM, (bf16*)(Wb + W_BO), kb * 64, nb * 32, nb * 32, scr, lane); continue; } r -= I_BO;
                if (r < I_CQ) { const int kb = r / 64, nb = r % 64; transpose_item(args.in[19], DM, 2048, (bf16*)(Wb + W_CQ), kb * 64, nb * 32, nb * 32, scr, lane); continue; } r -= I_CQ;
                { const int kb = r / 32, nb = r % 32; transpose_item(args.in[20], DM, DM, (bf16*)(Wb + W_CO), kb * 64, nb * 32, nb * 32, scr, lane); }
            }
        }
        {
            const int gt = gw * 64 + lane, NGT = NGW * 64;
            const float* wsf = args.in[16];
            for (int e = gt; e < 8 * 128 * 128 / 2; e += NGT) ((unsigned*)Wsb)[e] = cvtpk(wsf[2 * e], wsf[2 * e + 1]);
            for (int e = gt; e < 2048 * 32; e += NGT) { const int t = e >> 5, p = e & 31, j = p & 15; const float pos = (float)(p < 16 ? (t >> 6) : (t & 63));
                const float inv = exp2f(-(float)j * (13.287712379549449f / 16.0f)); const float a = pos * inv; cosA[e] = cosf(a); sinA[e] = sinf(a); }
            for (int e = gt; e < 2048 * 64; e += NGT) { const int t = e >> 6, p = e & 63, j = p & 31; const float pos = (float)(p < 32 ? (t >> 6) : (t & 63));
                const float inv = exp2f(-(float)j * (13.287712379549449f / 32.0f)); const float a = pos * inv; cosC[e] = cosf(a); sinC[e] = sinf(a); }
        }
    }
    SEAM(ph); ++ph;
    if (ON(1) && RUN(ph) && PSEL(1)) {
        const int gt = gw * 64 + lane, NGT = NGW * 64;
        for (int e = gt; e < DEPTH * NMODROW * MODW / 4; e += NGT) {
            const int c4 = e % (MODW / 4), rr = (e / (MODW / 4)) % NMODROW, li = e / (MODW / 4 * NMODROW);
            f32x4 s = *(const f32x4*)(ada_b + li * MODW + c4 * 4);
#pragma unroll
            for (int k = 0; k < 8; ++k) s = s + *(const f32x4*)(modp + ((size_t)k * NMODROW + rr) * (4 * MODW) + li * MODW + c4 * 4);
            *(f32x4*)(mods + ((size_t)li * NMODROW + rr) * MODW + c4 * 4) = s;
        }
    }
    SEAM(ph); ++ph;
    if (ON(2) && RUN(ph) && PSEL(2)) {
        { const int rpw = (MTOT + NGW - 1) / NGW, mb = gw * rpw, me = mb + rpw < MTOT ? mb + rpw : MTOT;
          combine_span<false, true>(mb, me, x_in, ctx_in, nullptr, nullptr, nullptr, Hb, nullptr, nullptr, mods, mods + DM, norm_g, lane, 1.0f); }
    }
    SEAM(ph); ++ph;
    }

    constexpr int NOPS = 10;
    for (int step = 3, rep = 0; step < 3 + NOPS * DEPTH; ) {
        const int li = (step - 3) / NOPS, op = (step - 3) % NOPS;
        int tid = threadIdx.x; asm volatile("" : "+v"(tid));
        const int lane = tid & 63, wave = __builtin_amdgcn_readfirstlane(tid >> 6), gw = vcu * 8 + wave;
        const int kind = li % 3; const int ja = li / 3; const bool ctx_out = li < DEPTH - 1; const int Mact = ctx_out ? MTOT : MLAT;
        const float* ng = norm_g + (size_t)li * 4 * DM;
        const bool noop = (op == 1 && kind == 1) || ((op == 5 || op == 9) && !ctx_out);
        if (RUN(ph) && !noop) {
#ifdef STAGGER_US
            if (op == 0 || op == 3 || op == 5 || op == 6) {
                const unsigned long long t0 = __builtin_amdgcn_s_memrealtime(); const unsigned long long dl = (unsigned long long)(((bx >> 3) & 3) * STAGGER_US * 100);
                while (__builtin_amdgcn_s_memrealtime() - t0 < dl) __builtin_amdgcn_s_sleep(32);
            }
#endif
            if (ON(3) && ((op == 0 && kind != 1) || op == 3 || op == 7 || ((op == 4 || op == 8) && ctx_out))) {
                pg8::Gemm g; pg8::EpiBf16<0> E; E.bias = nullptr; E.split_cols = 0; E.split_stride = 0; E.scale0 = 1.f; E.skip = EPI_SKIP_ON_REP ? rep * EPI_SKIP_ON_REP : 0; E.scratch = Ob;
                if (op == 0) { const int N1 = kind == 0 ? 1536 : 2048; g.A = Hb; g.Bt = kind == 0 ? (const bf16*)(Wb + W_AQ) + (size_t)ja * 1536 * DM : (const bf16*)(Wb + W_CQ); g.M = MTOT; g.N = N1; g.K = DM; E.O = QKV; E.ldc = N1; }
                else if (op == 3 || op == 4) { const size_t ro = op == 4 ? (size_t)MLAT * DM : 0;
                    g.A = Ob + ro; g.Bt = kind == 0 ? (const bf16*)(Wb + W_AO) + (size_t)ja * DM * DM : kind == 1 ? (const bf16*)(Wb + W_BO) : (const bf16*)(Wb + W_CO); g.M = op == 4 ? MCTX : MLAT; g.N = DM; g.K = DM; E.O = Yb + ro; E.ldc = DM; }
                else { const bool cx = op == 8;
                    g.A = HID + (cx ? (size_t)MLAT * FFH : 0); g.Bt = (const bf16*)(Wb + W_FO) + (size_t)li * DM * FFH; g.M = cx ? MCTX : MLAT; g.N = DM; g.K = FFH; E.O = Yb + (cx ? (size_t)MLAT * DM : 0); E.ldc = DM; }
                pg8::StaticOrder S; S.init(g.M, g.N, G, bx);
                pg8::gemm_phase<pg8::EpiBf16<0>, pg8::StaticOrder, true, true>((PG8_LAS unsigned char*)lds, g, S, E);
            }
            else if (ON(4) && op == 0) {
                pg8::Gemm g{Hb, (const bf16*)(Wb + W_BI), MTOT, 2048, DM}; pg8::StaticOrder S; S.init(MTOT, 2048, G, bx);
                pg8::EpiBf16<1> E{QKV, 2048, args.in[13], 0, 0, 1.f, EPI_SKIP_ON_REP ? rep * EPI_SKIP_ON_REP : 0, Ob}; pg8::gemm_phase<pg8::EpiBf16<1>, pg8::StaticOrder, true, true>((PG8_LAS unsigned char*)lds, g, S, E);
            }
            else if (ON(5) && op == 6) {
                pg8::Gemm g{Hb, (const bf16*)(Wb + W_FI) + (size_t)li * 2 * FFH * DM, Mact, 2 * FFH, DM}; pg8::StaticOrder S; S.init(Mact, 2 * FFH, G, bx);
                pg8::EpiSwiglu E{HID, FFH}; pg8::gemm_phase<pg8::EpiSwiglu, pg8::StaticOrder, true, true>((PG8_LAS unsigned char*)lds, g, S, E);
            }
            else if (ON(6) && op == 1) {
                if (kind == 0) {
                    const int rs = lane >> 4, l16 = lane & 15, hd = l16 >> 2, i0 = (l16 & 3) * 8;
#pragma nounroll
                    for (int m = gw * 4 + rs; m < MLAT; m += NGW * 4) { const int t = m & 2047; bf16* kp = QKV + (size_t)m * 1536 + 1024 + hd * 64 + i0;
                        const bf16x8 x1 = *(const bf16x8*)kp, x2 = *(const bf16x8*)(kp + 32);
                        const f32x4 c0 = *(const f32x4*)(cosA + t * 32 + i0), c1 = *(const f32x4*)(cosA + t * 32 + i0 + 4), s0 = *(const f32x4*)(sinA + t * 32 + i0), s1 = *(const f32x4*)(sinA + t * 32 + i0 + 4);
                        float o1[8], o2[8];
#pragma unroll
                        for (int j = 0; j < 8; ++j) { const float c = j < 4 ? c0[j & 3] : c1[j & 3], sn = j < 4 ? s0[j & 3] : s1[j & 3]; const float a = bf2f(x1[j]), b = bf2f(x2[j]); o1[j] = a * c - b * sn; o2[j] = b * c + a * sn; }
                        *(u32x4*)kp = (u32x4){cvtpk(o1[0], o1[1]), cvtpk(o1[2], o1[3]), cvtpk(o1[4], o1[5]), cvtpk(o1[6], o1[7])};
                        *(u32x4*)(kp + 32) = (u32x4){cvtpk(o2[0], o2[1]), cvtpk(o2[2], o2[3]), cvtpk(o2[4], o2[5]), cvtpk(o2[6], o2[7])}; }
                } else {
                    const float* kg = args.in[22]; const int rs = lane >> 5, l32 = lane & 31, hd = l32 >> 3, i0 = (l32 & 7) * 8;
                    const f32x4 ga0 = *(const f32x4*)(kg + i0), ga1 = *(const f32x4*)(kg + i0 + 4), gb0 = *(const f32x4*)(kg + 64 + i0), gb1 = *(const f32x4*)(kg + 64 + i0 + 4);
#pragma nounroll
                    for (int m = gw * 2 + rs; m < MTOT; m += NGW * 2) { bf16* kp = QKV + (size_t)m * 2048 + 1024 + hd * 128 + i0;
                        const bf16x8 x1 = *(const bf16x8*)kp, x2 = *(const bf16x8*)(kp + 64);
                        float a[8], b[8]; float ss = 0.f;
#pragma unroll
                        for (int j = 0; j < 8; ++j) { a[j] = bf2f(x1[j]); b[j] = bf2f(x2[j]); ss += a[j] * a[j] + b[j] * b[j]; }
                        ss += __shfl_xor(ss, 1); ss += __shfl_xor(ss, 2); ss += __shfl_xor(ss, 4);
                        const float rstd = rsqrtf(ss * (1.0f / 128.0f) + 1e-6f);
#pragma unroll
                        for (int j = 0; j < 8; ++j) { a[j] *= rstd * (j < 4 ? ga0[j & 3] : ga1[j & 3]); b[j] *= rstd * (j < 4 ? gb0[j & 3] : gb1[j & 3]); }
                        if (m < MLAT) { const int t = m & 2047;
                            const f32x4 c0 = *(const f32x4*)(cosC + t * 64 + i0), c1 = *(const f32x4*)(cosC + t * 64 + i0 + 4), s0 = *(const f32x4*)(sinC + t * 64 + i0), s1 = *(const f32x4*)(sinC + t * 64 + i0 + 4);
#pragma unroll
                            for (int j = 0; j < 8; ++j) { const float c = j < 4 ? c0[j & 3] : c1[j & 3], sn = j < 4 ? s0[j & 3] : s1[j & 3]; const float x1v = a[j], x2v = b[j]; a[j] = x1v * c - x2v * sn; b[j] = x2v * c + x1v * sn; } }
                        *(u32x4*)kp = (u32x4){cvtpk(a[0], a[1]), cvtpk(a[2], a[3]), cvtpk(a[4], a[5]), cvtpk(a[6], a[7])};
                        *(u32x4*)(kp + 64) = (u32x4){cvtpk(b[0], b[1]), cvtpk(b[2], b[3]), cvtpk(b[4], b[5]), cvtpk(b[6], b[7])}; }
                }
            }
            else if (ON(7) && op == 2 && kind != 1) {
                if (kind == 0) {
                    const float* sink = args.in[11] + ja * 16;
                    const int nlat = 4096, ntot = nlat + (ctx_out ? 512 : 0);
                    for (int u = bx; u < ntot; u += G) {
                        att::UnitDesc d; d.nctx = 4; d.cosT = cosA; d.sinT = sinA; d.qg = nullptr;
                        int b, h;
                        if (u < nlat) { const int x = u & 7, j = (u >> 3) & 31, gi = (u >> 8) * 8 + x; b = gi >> 2; const int kvh = gi & 3; h = kvh * 4 + (j >> 3); const int q0 = (((j & 7) + (u >> 8)) & 7) * 256;
                            d.Q = QKV + ((size_t)b * SEQ + q0) * 1536 + h * 64; d.O = Ob + ((size_t)b * SEQ + q0) * DM + h * 64; d.qpos0 = q0;
                            const int klo = q0 - 128 < 0 ? 0 : q0 - 128, khi = q0 + 384 > SEQ ? SEQ : q0 + 384; d.band_kp0 = klo; d.NT = 4 + (khi - klo) / 64; }
                        else { const int cu = u - nlat; b = cu >> 4; h = cu & 15;
                            d.Q = QKV + ((size_t)MLAT + b * CTXL) * 1536 + h * 64; d.O = Ob + ((size_t)MLAT + b * CTXL) * DM + h * 64; d.qpos0 = -1; d.band_kp0 = 0; d.NT = 4; }
                        d.Kc = QKV + 1024 + (h >> 2) * 64; d.Vc = QKV + 1280 + (h >> 2) * 64; d.ctx_row0 = MLAT + b * CTXL; d.lat_row0 = (long)b * SEQ;
                        d.sink_l2 = sink[h] * 1.4426950408889634f;
                        att::attn_unit<64, 1536, false, true>(d, (char*)lds);
                    }
                } else {
                    const int nlat = 2048, ntot = nlat + (ctx_out ? 256 : 0);
                    for (int u = bx; u < ntot; u += G) {
                        att::UnitDesc d; d.nctx = 4; d.cosT = cosC; d.sinT = sinC; d.qg = args.in[21]; d.band_kp0 = 0;
                        int b, h;
                        if (u < nlat) { const int x = u & 7, j = (u >> 3) & 31, gi = ((u >> 8) * 8 + x) * 2 + (j >> 4); b = gi >> 2; const int kvh = gi & 3; h = kvh * 2 + ((j & 15) >> 3); const int q0 = (j & 7) * 256;
                            d.Q = QKV + ((size_t)b * SEQ + q0) * 2048 + h * 128; d.O = Ob + ((size_t)b * SEQ + q0) * DM + h * 128; d.qpos0 = q0; d.NT = 36; }
                        else { const int cu = u - nlat; b = cu >> 3; h = cu & 7;
                            d.Q = QKV + ((size_t)MLAT + b * CTXL) * 2048 + h * 128; d.O = Ob + ((size_t)MLAT + b * CTXL) * DM + h * 128; d.qpos0 = -1; d.NT = 4; }
                        d.Kc = QKV + 1024 + (h >> 1) * 128; d.Vc = QKV + 1536 + (h >> 1) * 128; d.ctx_row0 = MLAT + b * CTXL; d.lat_row0 = (long)b * SEQ;
                        d.sink_l2 = -INFINITY;
                        att::attn_unit<128, 2048, true, false>(d, (char*)lds);
                    }
                }

            }
            else if (ON(8) && op == 2) {
                constexpr int TB = 16384;
                char* V_lds = (char*)lds; f32x2* stat = (f32x2*)((char*)lds + 4 * TB);
                const float* lng = args.in[14]; const float* lnb = args.in[15]; const float* bsb = args.in[17];
                const int r32 = lane & 31, hh = lane >> 5, rb = wave & 3, half = wave >> 2;
                const int ht = tid & 255, sr = ht >> 4, sc = (ht & 15) * 8;
                const int vb0 = (int)(uintptr_t)V_lds + half * 2 * TB + att::v_rd_base(lane);
                bf16* stg = (bf16*)((char*)lds + 4 * TB + 1024) + wave * 4096;
                for (int u = bx; u < (MTOT / 128) * 2; u += G) {
                    const int ux = u & 7, uj = (u >> 3) & 31, ur = u >> 8; const int chunk = ur * 128 + ux * (ur < 4 ? 16 : 8) + (uj >> 1), gh = uj & 1;
                    if (chunk >= MTOT / 128) continue;
                    const size_t row0 = (size_t)chunk * 128;
#pragma nounroll
                    for (int rb8 = 0; rb8 < 16; rb8 += 8) {
                        bf16x8 v0[8], v1[8];
#pragma unroll
                        for (int rr = 0; rr < 8; ++rr) { const bf16* vp = QKV + (row0 + wave * 16 + rb8 + rr) * 2048 + 1024 + lane * 16; v0[rr] = *(const bf16x8*)vp; v1[rr] = *(const bf16x8*)(vp + 8); }
#pragma unroll
                        for (int rr = 0; rr < 8; ++rr) { float f[16];
#pragma unroll
                            for (int j = 0; j < 8; ++j) { f[j] = bf2f(v0[rr][j]); f[8 + j] = bf2f(v1[rr][j]); }
                            float sm = 0.f;
#pragma unroll
                            for (int j = 0; j < 16; ++j) sm += f[j];
                            const float mean = wave_sum(sm) * (1.0f / 1024.0f); float q = 0.f;
#pragma unroll
                            for (int j = 0; j < 16; ++j) { const float dd = f[j] - mean; q += dd * dd; }
                            const float rstd = rsqrtf(wave_sum(q) * (1.0f / 1024.0f) + 1e-5f);
                            if (lane == 0) stat[wave * 16 + rb8 + rr] = (f32x2){mean, rstd}; }
                    }
                    __syncthreads();
#pragma nounroll
                    for (int st2 = 0; st2 < 2; ++st2) {
                        const int g = gh * 4 + st2 * 2 + half;
                        bf16x8 raw[8], pa[2][4], uv[8];
#pragma unroll
                        for (int l = 0; l < 8; ++l) raw[l] = *(const bf16x8*)(QKV + (row0 + sr + 16 * l) * 2048 + 1024 + g * 128 + sc);
#pragma unroll
                        for (int T = 0; T < 2; ++T)
#pragma unroll
                            for (int ks = 0; ks < 4; ++ks) pa[T][ks] = *(const bf16x8*)(Wsb + (size_t)g * 16384 + (32 * rb + r32) * 128 + 64 * T + 16 * ks + 8 * hh);
#pragma unroll
                        for (int i = 0; i < 8; ++i) uv[i] = *(const bf16x8*)(QKV + (row0 + 32 * rb + i * 4 + (lane >> 4)) * 2048 + g * 128 + (lane & 15) * 8);
                        const f32x4 lg0 = *(const f32x4*)(lng + g * 128 + sc), lg1 = *(const f32x4*)(lng + g * 128 + sc + 4), lb0 = *(const f32x4*)(lnb + g * 128 + sc), lb1 = *(const f32x4*)(lnb + g * 128 + sc + 4);
#pragma unroll
                        for (int l = 0; l < 8; ++l) { const int rl = sr + 16 * l;
                            const f32x2 st = stat[rl]; float f[8];
#pragma unroll
                            for (int j = 0; j < 8; ++j) f[j] = (bf2f(raw[l][j]) - st.x) * st.y * (j < 4 ? lg0[j & 3] : lg1[j & 3]) + (j < 4 ? lb0[j & 3] : lb1[j & 3]);
                            u32x4 w = {cvtpk(f[0], f[1]), cvtpk(f[2], f[3]), cvtpk(f[4], f[5]), cvtpk(f[6], f[7])};
                            *(u32x4*)(V_lds + half * 2 * TB + (rl >> 6) * TB + att::v_st<128>(rl & 63, sc)) = w; }
                        __syncthreads();
                        f32x16 o[4]; o[0] = f32x16{}; o[1] = f32x16{}; o[2] = f32x16{}; o[3] = f32x16{};
                        att::pv_all<128>(o, vb0, pa[0][0], pa[0][1], pa[0][2], pa[0][3]);
                        att::pv_all<128>(o, vb0 + TB, pa[1][0], pa[1][1], pa[1][2], pa[1][3]);
#pragma unroll
                        for (int r = 0; r < 16; ++r) { const int pr = att::crow(r, hh); const float bias = bsb[g * 128 + 32 * rb + pr];
#pragma unroll
                            for (int d = 0; d < 4; ++d) { const float v = o[d][r] + bias; stg[pr * 128 + d * 32 + r32] = (bf16)(cvtpk(v, v) & 0xffffu); } }
                        asm volatile("s_waitcnt lgkmcnt(0)" ::: "memory");
#pragma unroll
                        for (int i = 0; i < 8; ++i) { const int row = i * 4 + (lane >> 4), ch = lane & 15; const bf16x8 mv = *(const bf16x8*)(stg + row * 128 + ch * 8);
                            float f[8];
#pragma unroll
                            for (int e = 0; e < 8; ++e) f[e] = bf2f(uv[i][e]) * bf2f(mv[e]);
                            u32x4 w = {cvtpk(f[0], f[1]), cvtpk(f[2], f[3]), cvtpk(f[4], f[5]), cvtpk(f[6], f[7])};
                            *(u32x4*)(Ob + (row0 + 32 * rb + row) * DM + g * 128 + ch * 8) = w; }
                        __syncthreads();
                    }
                }
            }
            if (ON(9) && (op == 4 || op == 5 || op == 8 || op == 9)) {
                const bool c2 = op >= 8, last = li == DEPTH - 1, first = li == 0 && !c2 && !rep;
                const int rbase = (op == 5 || op == 9) ? MLAT : 0, nrows = rbase ? MCTX : MLAT;
                const float* ml = mods + (size_t)li * NMODROW * MODW; const float* mn = ml + (size_t)NMODROW * MODW;
                int mb, me;
                if (ctx_out && !rbase && G == 256) {
                    const int F = c2 ? CMB_F2 : CMB_F1; int r0, nr;
                    if (bx >= 128) { nr = F * 64; r0 = (bx - 128) * nr; } else { nr = (8 - F) * 64; r0 = 128 * F * 64 + bx * nr; }
                    mb = r0 + wave * (nr >> 3); me = mb + (nr >> 3);
                } else { const int rpw = (nrows + NGW - 1) / NGW; mb = gw * rpw; me = mb + rpw < nrows ? mb + rpw : nrows; mb += rbase; me += rbase; }
                {
                    if (!c2) {
                        if (first) combine_span<true, true, true, !XBF16>(mb, me, x_in, ctx_in, XL, XC, Yb, Hb, ml + 2 * DM, ng + DM, ml + 3 * DM, ml + 4 * DM, ng + 2 * DM, lane, 1.0f);
                        else combine_span<true, true, !XBF16, !XBF16>(mb, me, XL, XC, XL, XC, Yb, Hb, ml + 2 * DM, ng + DM, ml + 3 * DM, ml + 4 * DM, ng + 2 * DM, lane, rep ? 0.0f : 1.0f);
                    } else {
                        if (last) combine_span<true, false, !XBF16, true>(mb, me, XL, XC, args.out, XC, Yb, Hb, ml + 5 * DM, ng + 3 * DM, nullptr, nullptr, nullptr, lane, rep ? 0.0f : 1.0f);
                        else combine_span<true, true, !XBF16, !XBF16>(mb, me, XL, XC, XL, XC, Yb, Hb, ml + 5 * DM, ng + 3 * DM, mn, mn + DM, ng + 4 * DM, lane, rep ? 0.0f : 1.0f);
                    }
                }
            }
        }
        if (!noop && step + 1 < 3 + NOPS * DEPTH) { if (RUN(ph) && RUN(ph + 1)) GSYNC(); }
#ifdef REP_MASK
        if ((((unsigned long long)(REP_MASK) >> (step - 3)) & 1ull) && rep == 0) { rep = 1; continue; }
        rep = 0;
#endif
        ++step; ++ph;
    }
#undef RUN
#undef SEAM
}

#ifndef MK_MULTI
#define MK_MULTI 0
#endif
extern "C" void kernel_launch(void* const* d_in, const int* in_sizes, int n_in, void* d_out, int out_size, void* d_ws, size_t ws_size, hipStream_t stream) {
    static int grid = 0;
    if (grid == 0) {
        if (n_in != 23 || ws_size < WS_END) { fprintf(stderr, "kernel_launch: unexpected n_in %d / ws_size %zu (need %zu)\n", n_in, ws_size, (size_t)WS_END); grid = -1; return; }
        int dev = 0, cus = 0, per_cu = 0;
        hipGetDevice(&dev); hipDeviceGetAttribute(&cus, hipDeviceAttributeMultiprocessorCount, dev);
        if (hipFuncSetAttribute((const void*)mega, hipFuncAttributeMaxDynamicSharedMemorySize, LDS_BYTES) != hipSuccess) { fprintf(stderr, "kernel_launch: hipFuncSetAttribute failed\n"); grid = -1; return; }
        if (hipOccupancyMaxActiveBlocksPerMultiprocessor(&per_cu, (const void*)mega, 512, LDS_BYTES) != hipSuccess || per_cu < 1) { fprintf(stderr, "kernel_launch: occupancy query says %d\n", per_cu); per_cu = 1; }
        (void)hipGetLastError();
        grid = cus * per_cu;
        fprintf(stderr, "kernel_launch: grid %d (cus %d x %d)\n", grid, cus, per_cu);
    }
    if (grid < 0) return;
    if (hipMemsetAsync((char*)d_ws + OFF_CTL, 0, CTL_BYTES, stream) != hipSuccess) { fprintf(stderr, "kernel_launch: memset failed\n"); return; }
    Args a{};
    for (int i = 0; i < 23; ++i) a.in[i] = (const float*)d_in[i];
    a.out = (float*)d_out; a.ws = (unsigned char*)d_ws;
#if MK_MULTI
    const int nph = 3 + 10 * DEPTH;
    for (int p = 0; p < nph; ++p) { a.ph_lo = p; a.ph_hi = p + 1; hipLaunchKernelGGL(mega, dim3(grid), dim3(512), LDS_BYTES, stream, a); }
#else
    a.ph_lo = 0; a.ph_hi = 1000;
    void* params[] = {&a};
    hipError_t e = hipLaunchCooperativeKernel((const void*)mega, dim3(grid), dim3(512), params, LDS_BYTES, stream);
    if (e != hipSuccess) fprintf(stderr, "kernel_launch: cooperative launch failed: %s (grid %d)\n", hipGetErrorString(e), grid);
#endif
}
```
